# Optimizing an MI355X kernel written in HIP

```python
import math
import jax, jax.numpy as jnp
from jax import lax
import numpy as np

D_MODEL = 1024
BATCH = 8
SEQ = 8192
DEPTH = 2

CHUNK = 64
D_MIX = D_MODEL
POOL_WIDTH = D_MIX // 4
DIFF_WIDTH = D_MIX // 2
GLA_WIDTH = D_MIX // 4
POOL_WINDOWS = (2, 4, 8, 16)
POOL_GROUPS = len(POOL_WINDOWS)
POOL_GDIM = POOL_WIDTH // POOL_GROUPS
DIFF_HEADS = 4
DIFF_VDIM = DIFF_WIDTH // DIFF_HEADS
DIFF_QKDIM = DIFF_VDIM // 2
GLA_HEADS = 4
GLA_VDIM = GLA_WIDTH // GLA_HEADS
GLA_KDIM = GLA_VDIM // 2
GLA_GATE_RANK = 16
GLA_GATE_TAU = 16.0
D_FF = 4 * D_MODEL
Q_BLOCK = 128
EPS = 1e-6

SIZES = (
    POOL_WIDTH,
    DIFF_HEADS * 2 * DIFF_QKDIM,
    DIFF_HEADS * 2 * DIFF_QKDIM,
    DIFF_HEADS * DIFF_VDIM,
    GLA_HEADS * GLA_KDIM,
    GLA_HEADS * GLA_KDIM,
    GLA_WIDTH,
    GLA_WIDTH,
    GLA_GATE_RANK,
)
D_IN_PROJ = sum(SIZES)
SPLIT_POINTS = tuple(sum(SIZES[:i + 1]) for i in range(len(SIZES) - 1))

kernel_name = "hybrid_pool_diffattn_gla_trunk"


def rms_norm(x, g):
    xf = x.astype(jnp.float32)
    y = xf * lax.rsqrt(jnp.mean(xf * xf, axis=-1, keepdims=True) + EPS)
    return (y * g.astype(jnp.float32)).astype(x.dtype)


def pool_mixer(u, w_pool, pool_scale):
    B, S, _ = u.shape
    uf = u.astype(jnp.float32).reshape(B, S, POOL_GROUPS, POOL_GDIM)
    csum = jnp.cumsum(uf, axis=1)
    t = jnp.arange(S)
    means = []
    for g, win in enumerate(POOL_WINDOWS):
        c = csum[:, :, g]
        c_prev = jnp.pad(c, ((0, 0), (win, 0), (0, 0)))[:, :S]
        cnt = jnp.minimum(t + 1, win).astype(jnp.float32)[None, :, None]
        means.append((c - c_prev) / cnt)
    pooled = jnp.stack(means, axis=2) - uf
    mixed = jnp.einsum('bsgc,gcd->bsgd', pooled, w_pool.astype(jnp.float32))
    return (mixed.reshape(B, S, POOL_WIDTH) * pool_scale.astype(jnp.float32)).astype(u.dtype)


def diff_attention(q, k, v, lq1, lk1, lq2, lk2, norm_g, lambda_init):
    B, S = q.shape[:2]
    nqb = S // Q_BLOCK
    f32 = jnp.float32
    lam = (jnp.exp(jnp.sum(lq1.astype(f32) * lk1.astype(f32)))
           - jnp.exp(jnp.sum(lq2.astype(f32) * lk2.astype(f32))) + lambda_init)
    scale = DIFF_QKDIM ** -0.5
    k_chunk = jnp.arange(S) // CHUNK
    qb = q.reshape(B, nqb, Q_BLOCK, DIFF_HEADS, 2, DIFF_QKDIM).transpose(1, 0, 2, 3, 4, 5)

    def one_block(args):
        q_blk, blk = args
        s = jnp.einsum('bqhmd,bkhmd->bhmqk', q_blk, k).astype(f32) * scale
        q_chunk = (blk * Q_BLOCK + jnp.arange(Q_BLOCK)) // CHUNK
        mask = k_chunk[None, :] <= q_chunk[:, None]
        s = jnp.where(mask, s, -jnp.inf)
        p = jax.nn.softmax(s, axis=-1)
        a = p[:, :, 0] - lam * p[:, :, 1]
        return jnp.einsum('bhqk,bkhd->bqhd', a.astype(v.dtype), v)

    o = lax.map(one_block, (qb, jnp.arange(nqb)))
    o = o.transpose(1, 0, 2, 3, 4).reshape(B, S, DIFF_HEADS, DIFF_VDIM)
    o = rms_norm(o, norm_g.reshape(DIFF_HEADS, DIFF_VDIM)) * (1.0 - lambda_init)
    return o.reshape(B, S, DIFF_WIDTH)


def gla_mixer(q, k, v, r, g_lr, w_gate2, b_gate, norm_g):
    B, S = q.shape[:2]
    nc = S // CHUNK
    f32 = jnp.float32
    log_a = jax.nn.log_sigmoid((g_lr @ w_gate2 + b_gate).astype(f32)) / GLA_GATE_TAU
    log_a = log_a.reshape(B, S, GLA_HEADS, GLA_KDIM)

    def to_chunks(t):
        return t.astype(f32).reshape(B, nc, CHUNK, GLA_HEADS, t.shape[-1]).transpose(1, 0, 3, 2, 4)

    qc = to_chunks(q) * (GLA_KDIM ** -0.5)
    kc, vc, lc = to_chunks(k), to_chunks(v), to_chunks(log_a)
    bcum = jnp.cumsum(lc, axis=3)
    b_last = bcum[:, :, :, -1, :]
    q_dec = qc * jnp.exp(bcum)
    k_inv = kc * jnp.exp(-bcum)
    k_end = kc * jnp.exp(b_last[:, :, :, None, :] - bcum)
    causal = jnp.tril(jnp.ones((CHUNK, CHUNK), dtype=bool))
    att = jnp.where(causal, jnp.einsum('nbhid,nbhjd->nbhij', q_dec, k_inv), 0.0)
    o_intra = jnp.einsum('nbhij,nbhje->nbhie', att, vc)

    def step(state, xs):
        q_d, k_e, v_c, decay = xs
        o_inter = jnp.einsum('bhid,bhde->bhie', q_d, state)
        state = state * jnp.exp(decay)[..., None] + jnp.einsum('bhjd,bhje->bhde', k_e, v_c)
        return state, o_inter

    state0 = jnp.zeros((B, GLA_HEADS, GLA_KDIM, GLA_VDIM), f32)
    _, o_inter = lax.scan(step, state0, (q_dec, k_end, vc, b_last))
    o = (o_intra + o_inter).transpose(1, 0, 3, 2, 4).reshape(B, S, GLA_HEADS, GLA_VDIM)
    o = rms_norm(o, norm_g.reshape(GLA_HEADS, GLA_VDIM)).reshape(B, S, GLA_WIDTH)
    return (o * jax.nn.silu(r.astype(f32))).astype(r.dtype)


def setup_inputs(seed: int = 0) -> dict:
    key = jax.random.key(seed)
    ks = jax.random.split(key, 24)
    nrm = jax.random.normal
    f32 = jnp.float32
    L = DEPTH
    return {
        "x": nrm(ks[0], (BATCH, SEQ, D_MODEL), f32),
        "norm1_g": 1.0 + 0.05 * nrm(ks[1], (L, D_MODEL), f32),
        "w_in": nrm(ks[2], (L, D_MODEL, D_IN_PROJ), f32) * D_MODEL ** -0.5,
        "pool_w": nrm(ks[3], (L, POOL_GROUPS, POOL_GDIM, POOL_GDIM), f32) * POOL_GDIM ** -0.5,
        "pool_scale": 1.0 + 0.1 * nrm(ks[4], (L, POOL_WIDTH), f32),
        "diff_lq1": 0.1 * nrm(ks[5], (L, DIFF_QKDIM), f32),
        "diff_lk1": 0.1 * nrm(ks[6], (L, DIFF_QKDIM), f32),
        "diff_lq2": 0.1 * nrm(ks[7], (L, DIFF_QKDIM), f32),
        "diff_lk2": 0.1 * nrm(ks[8], (L, DIFF_QKDIM), f32),
        "diff_norm_g": 1.0 + 0.05 * nrm(ks[9], (L, DIFF_WIDTH), f32),
        "gla_w_gate2": nrm(ks[10], (L, GLA_GATE_RANK, GLA_HEADS * GLA_KDIM), f32) * GLA_GATE_RANK ** -0.5,
        "gla_b_gate": 0.1 * nrm(ks[11], (L, GLA_HEADS * GLA_KDIM), f32),
        "gla_norm_g": 1.0 + 0.05 * nrm(ks[12], (L, GLA_WIDTH), f32),
        "w_out": nrm(ks[13], (L, D_MIX, D_MODEL), f32) * D_MIX ** -0.5,
        "norm2_g": 1.0 + 0.05 * nrm(ks[14], (L, D_MODEL), f32),
        "w_mlp1": nrm(ks[15], (L, D_MODEL, D_FF), f32) * D_MODEL ** -0.5,
        "w_mlp2": nrm(ks[16], (L, D_FF, D_MODEL), f32) * D_FF ** -0.5,
        "final_norm_g": 1.0 + 0.05 * nrm(ks[17], (D_MODEL,), f32),
    }


def reference(x, norm1_g, w_in, pool_w, pool_scale, diff_lq1, diff_lk1, diff_lq2, diff_lk2,
              diff_norm_g, gla_w_gate2, gla_b_gate, gla_norm_g, w_out, norm2_g, w_mlp1,
              w_mlp2, final_norm_g):
    B, S, _ = x.shape
    h = x
    for l in range(DEPTH):
        u = rms_norm(h, norm1_g[l])
        proj = u @ w_in[l]
        p_in, dq, dk, dv, gq, gk, gv, gr, gg = jnp.split(proj, SPLIT_POINTS, axis=-1)
        y_pool = pool_mixer(p_in, pool_w[l], pool_scale[l])
        lambda_init = 0.8 - 0.6 * math.exp(-0.3 * l)
        y_diff = diff_attention(
            dq.reshape(B, S, DIFF_HEADS, 2, DIFF_QKDIM),
            dk.reshape(B, S, DIFF_HEADS, 2, DIFF_QKDIM),
            dv.reshape(B, S, DIFF_HEADS, DIFF_VDIM),
            diff_lq1[l], diff_lk1[l], diff_lq2[l], diff_lk2[l], diff_norm_g[l], lambda_init)
        y_gla = gla_mixer(
            gq.reshape(B, S, GLA_HEADS, GLA_KDIM),
            gk.reshape(B, S, GLA_HEADS, GLA_KDIM),
            gv.reshape(B, S, GLA_HEADS, GLA_VDIM),
            gr, gg, gla_w_gate2[l], gla_b_gate[l], gla_norm_g[l])
        mix = jnp.concatenate([y_pool, y_diff.astype(y_pool.dtype), y_gla.astype(y_pool.dtype)], axis=-1)
        h = h + (mix @ w_out[l]).astype(h.dtype)
        z = rms_norm(h, norm2_g[l])
        h = h + jnp.square(jax.nn.relu(z @ w_mlp1[l])) @ w_mlp2[l]
    return rms_norm(h, final_norm_g)
```

```cpp
#include <hip/hip_runtime.h>
#include <cstdio>
#include <cstdint>
namespace pg8 {
#define PG8_LAS __attribute__((address_space(3)))
typedef unsigned short bf16_t;
typedef short bf16x8 __attribute__((ext_vector_type(8)));
typedef float f32x4 __attribute__((ext_vector_type(4)));
typedef unsigned u32x4 __attribute__((ext_vector_type(4)));
constexpr int BM = 256, BK = 64, HALF = 128, HTB = HALF * BK * 2  , STAGE_BYTES = 8 * HTB, NXCD = 8, WGM = 8;

__host__ __device__ __forceinline__ int lds_byte(int r, int c) { const int st = (r >> 4) * 2 + (c >> 5), rr = r & 15, cc = c & 31, ob = rr * 64 + cc * 2; return st * 1024 + (ob ^ (((ob >> 9) & 1) << 5)); }
__host__ __device__ __forceinline__ void stage_rc(int b, int& R, int& C) { const int st = b / 1024, sb = b % 1024, swz = sb ^ (((sb >> 9) & 1) << 5); R = (st >> 1) * 16 + swz / 64; C = (st & 1) * 32 + (swz % 64) / 2; }
__host__ __device__ __forceinline__ int perm32(int rho) { const int n = rho >> 4, i = rho & 15; return 8 * (i >> 2) + 4 * n + (i & 3); }

struct Unit { int pm, pn; };
struct Gemm { const bf16_t* A; const bf16_t* Bt; int M, N, K; };

struct StaticOrder {
    int nM, nN, nwg, G, c;
    __host__ __device__ void init(int M, int N, int G_, int c_) { nM = M / BM; nN = N / BM; nwg = nM * nN; G = G_; c = c_; }
    __host__ __device__ bool next(int i, Unit& u) const {
        const long L = (long)i * G + c; if (L >= nwg) return false;
        int wgid = (int)L; { const int q = nwg / NXCD, r = nwg % NXCD, xcd = wgid % NXCD, off = wgid / NXCD; wgid = (xcd < r ? xcd * (q + 1) : r * (q + 1) + (xcd - r) * q) + off; }
        const int nig = WGM * nN, gid = wgid / nig, fm = gid * WGM, gsz = (nM - fm) < WGM ? (nM - fm) : WGM;
        u.pm = fm + ((wgid % nig) % gsz); u.pn = (wgid % nig) / gsz; return true;
    }
    __device__ __forceinline__ void a_ready(const Unit&) const {}
    __device__ __forceinline__ void done(const Unit&) const {}
};

__device__ __forceinline__ unsigned cvt_pk_bf16(float lo, float hi) { unsigned r; asm volatile("v_cvt_pk_bf16_f32 %0, %1, %2" : "=v"(r) : "v"(lo), "v"(hi)); return r; }
typedef float f32x2 __attribute__((ext_vector_type(2)));
typedef float f32x2 __attribute__((ext_vector_type(2)));
typedef unsigned u32x2 __attribute__((ext_vector_type(2)));
__device__ __forceinline__ float row_rs(const float* ss, int row, int fq, float eps) {
    const f32x4 p = *(const f32x4*)(ss + (size_t)row * 16 + fq * 4);
    float s = (p[0] + p[1]) + (p[2] + p[3]);
    s += __shfl_xor(s, 16); s += __shfl_xor(s, 32);
    return __builtin_amdgcn_rsqf(s * (1.0f / 1024.0f) + eps);
}
template <int ACT> struct EpiRs {
    static constexpr bool PERM = true, AFTER_DRAIN = false;
    bf16_t* O; int ldc; const float* ss; float eps; int sc_lo, sc_hi; float tile_scale;
    __device__ __forceinline__ void operator()(const f32x4 (&acc)[2][2][4][2], const Unit& u, int wr, int wc, int fr, int fq) const {
        const int row0 = u.pm * BM + wr * 64 + fr; const int col0 = u.pn * BM + wc * 32 + 8 * fq;
        const float sc = (u.pn >= sc_lo && u.pn < sc_hi) ? tile_scale : 1.f;
        float rs[2][4];
#pragma unroll
        for (int ai = 0; ai < 2; ++ai)
#pragma unroll
            for (int m = 0; m < 4; ++m) rs[ai][m] = row_rs(ss, row0 + ai * HALF + m * 16, fq, eps) * sc;
#pragma unroll
        for (int ai = 0; ai < 2; ++ai)
#pragma unroll
            for (int m = 0; m < 4; ++m) { bf16_t* rowp = O + (size_t)(row0 + ai * HALF + m * 16) * ldc + col0; const float r = rs[ai][m];
#pragma unroll
                for (int bj = 0; bj < 2; ++bj) { f32x4 v0 = acc[ai][bj][m][0] * r, v1 = acc[ai][bj][m][1] * r;
                    if (ACT == 2) {
#pragma unroll
                        for (int e = 0; e < 4; ++e) { const float a = __builtin_fmaxf(v0[e], 0.f), b = __builtin_fmaxf(v1[e], 0.f); v0[e] = a * a; v1[e] = b * b; } }
                    u32x4 w; w.x = cvt_pk_bf16(v0[0], v0[1]); w.y = cvt_pk_bf16(v0[2], v0[3]); w.z = cvt_pk_bf16(v1[0], v1[1]); w.w = cvt_pk_bf16(v1[2], v1[3]);
                    *(u32x4*)(rowp + bj * HALF) = w; } }
    }
};
struct EpiRes {
    static constexpr bool PERM = false, AFTER_DRAIN = false;
    const float* base; float* out; bf16_t* hb; float* ss; int ldc;
    __device__ __forceinline__ void operator()(const f32x4 (&acc)[2][2][4][2], const Unit& u, int wr, int wc, int fr, int fq) const {
        const int col0 = u.pn * BM + wc * 32 + 4 * fq;
#pragma unroll
        for (int ai = 0; ai < 2; ++ai)
#pragma unroll
            for (int m = 0; m < 4; ++m) { const int row = u.pm * BM + ai * HALF + wr * 64 + m * 16 + fr; const size_t off = (size_t)row * ldc + col0; float sq = 0.f;
#pragma unroll
                for (int bj = 0; bj < 2; ++bj)
#pragma unroll
                    for (int n = 0; n < 2; ++n) { const f32x4 bs = *(const f32x4*)(base + off + bj * HALF + n * 16); const f32x4 o = bs + acc[ai][bj][m][n];
                        *(f32x4*)(out + off + bj * HALF + n * 16) = o;
                        u32x2 w; w.x = cvt_pk_bf16(o[0], o[1]); w.y = cvt_pk_bf16(o[2], o[3]); *(u32x2*)(hb + off + bj * HALF + n * 16) = w;
                        sq += (o[0] * o[0] + o[1] * o[1]) + (o[2] * o[2] + o[3] * o[3]); }
                sq += __shfl_xor(sq, 16); sq += __shfl_xor(sq, 32);
                if (fq == 0) ss[(size_t)row * 16 + u.pn * 4 + wc] = sq;
                if (m & 1) asm volatile("" ::: "memory"); }
    }
};
template <class Epi, class Sched, bool ALIGN_EPI = false, bool SP2 = false>
__device__ __forceinline__ void gemm_phase(PG8_LAS unsigned char* lds, const Gemm g, const Sched& S, const Epi& E) {
    int tid_ = threadIdx.x; asm volatile("" : "+v"(tid_));
    const int tid = tid_, wid = __builtin_amdgcn_readfirstlane(tid >> 6), lane = tid & 63, wr = wid >> 2, wc = wid & 3, fr = lane & 15, fq = lane >> 4;
    const int K = g.K, nt = K / BK;
    unsigned voffA[2], voffB[2];
#pragma unroll
    for (int i = 0; i < 2; ++i) { int R, C; stage_rc(tid * 16 + i * 8192, R, C); const int Rb = Epi::PERM ? ((R & ~31) + perm32(R & 31)) : R;
        voffA[i] = (unsigned)(R * K + C) * 2u; voffB[i] = (unsigned)(Rb * K + C) * 2u; }
    const size_t kstep = (size_t)(BK * 2);
    const size_t hstep = (size_t)HALF * K * 2;
    const size_t tstep = 2 * hstep;
    const unsigned ldsw = (unsigned)wid * 1024u;
    const int aoff = lds_byte(wr * 64 + fr, fq * 8), boff = lds_byte(wc * 32 + fr, fq * 8);
#define PG8_SA(b, h) (((b) * 2 + (h)) * HTB)
#define PG8_SB(b, h) ((4 + (b) * 2 + (h)) * HTB)
#define PG8_STAGE(bufoff, gbase, voff) do { _Pragma("unroll") for (int _i = 0; _i < 2; ++_i) \
        __builtin_amdgcn_global_load_lds((const unsigned*)((const char*)(gbase) + (voff)[_i]), (PG8_LAS unsigned*)(lds + (bufoff) + ldsw + _i * 8192), 16, 0, 0); } while (0)
#define PG8_LDA(dst, b, h) do { _Pragma("unroll") for (int m = 0; m < 4; ++m) _Pragma("unroll") for (int k = 0; k < 2; ++k) dst[m][k] = *(const PG8_LAS bf16x8*)(lds + PG8_SA(b, h) + aoff + m * 2048 + k * 1024); } while (0)
#define PG8_LDB(dst, b, h) do { _Pragma("unroll") for (int n = 0; n < 2; ++n) _Pragma("unroll") for (int k = 0; k < 2; ++k) dst[n][k] = *(const PG8_LAS bf16x8*)(lds + PG8_SB(b, h) + boff + n * 2048 + k * 1024); } while (0)
#define PG8_MMA(ai, bj, At, Bt) do { __builtin_amdgcn_s_setprio(1); _Pragma("unroll") for (int m = 0; m < 4; ++m) _Pragma("unroll") for (int n = 0; n < 2; ++n) _Pragma("unroll") for (int k = 0; k < 2; ++k) \
        acc[ai][bj][m][n] = __builtin_amdgcn_mfma_f32_16x16x32_bf16(Bt[n][k], At[m][k], acc[ai][bj][m][n], 0, 0, 0); __builtin_amdgcn_s_setprio(0); } while (0)
#define PG8_WAIT_V(n) asm volatile("s_waitcnt vmcnt(" #n ")" ::: "memory")
#define PG8_WAIT_L(n) asm volatile("s_waitcnt lgkmcnt(" #n ")" ::: "memory")
#define PG8_BAR __builtin_amdgcn_s_barrier()
#define PG8_SCHED __builtin_amdgcn_sched_barrier(0)
    Unit cur, nxt; int ui = 0;
    if (!S.next(0, cur)) return;
    f32x4 acc[2][2][4][2];
#pragma unroll
    for (int a = 0; a < 2; ++a)
#pragma unroll
        for (int b = 0; b < 2; ++b)
#pragma unroll
            for (int m = 0; m < 4; ++m)
#pragma unroll
                for (int n = 0; n < 2; ++n) acc[a][b][m][n] = (f32x4){0.f, 0.f, 0.f, 0.f};
    bf16x8 At[4][2], B0[2][2], B1[2][2];
    const char* cA = (const char*)g.A + (size_t)cur.pm * tstep; const char* cB = (const char*)g.Bt + (size_t)cur.pn * tstep;
    S.a_ready(cur);
    if constexpr (SP2) {
        PG8_STAGE(PG8_SB(0, 0), cB, voffB); PG8_STAGE(PG8_SB(0, 1), cB + hstep, voffB); PG8_STAGE(PG8_SA(0, 0), cA, voffA); PG8_STAGE(PG8_SA(0, 1), cA + hstep, voffA);
        if (wr == 1) PG8_BAR;
        PG8_WAIT_V(2); PG8_BAR;
        PG8_STAGE(PG8_SB(1, 0), cB + kstep, voffB); PG8_STAGE(PG8_SA(1, 0), cA + kstep, voffA); PG8_STAGE(PG8_SB(1, 1), cB + hstep + kstep, voffB);
        PG8_WAIT_V(6); PG8_BAR;
    } else {
        PG8_STAGE(PG8_SB(0, 0), cB, voffB); PG8_STAGE(PG8_SA(0, 0), cA, voffA); PG8_STAGE(PG8_SB(0, 1), cB + hstep, voffB); PG8_STAGE(PG8_SA(0, 1), cA + hstep, voffA);
        if (wr == 1) PG8_BAR;
        PG8_WAIT_V(4); PG8_BAR;
        PG8_STAGE(PG8_SB(1, 0), cB + kstep, voffB); PG8_STAGE(PG8_SA(1, 0), cA + kstep, voffA); PG8_STAGE(PG8_SB(1, 1), cB + hstep + kstep, voffB);
        PG8_WAIT_V(6); PG8_BAR;
    }
    for (;;) {
        const bool has_next = S.next(ui + 1, nxt);
        const char* nA = has_next ? (const char*)g.A + (size_t)nxt.pm * tstep : cA; const char* nB = has_next ? (const char*)g.Bt + (size_t)nxt.pn * tstep : cB;
        for (int t = 0; t < nt; t += 2) {
            const bool last = (t == nt - 2);
            const char* a1 = cA + (size_t)(t + 1) * kstep;
            const char* a2 = last ? nA : cA + (size_t)(t + 2) * kstep; const char* b2 = last ? nB : cB + (size_t)(t + 2) * kstep;
            const char* a3 = a2 + kstep; const char* b3 = b2 + kstep;
            if (last && has_next) S.a_ready(nxt);
            if constexpr (SP2) {
            PG8_LDB(B0, 0, 0); PG8_LDB(B1, 0, 1); PG8_SCHED; PG8_LDA(At, 0, 0); PG8_STAGE(PG8_SA(1, 1), a1 + hstep, voffA);
            PG8_WAIT_V(8); PG8_WAIT_L(0); PG8_BAR; PG8_MMA(0, 0, At, B0); PG8_MMA(0, 1, At, B1); PG8_BAR; PG8_SCHED;
            PG8_LDA(At, 0, 1); PG8_STAGE(PG8_SB(0, 0), b2, voffB); PG8_STAGE(PG8_SB(0, 1), b2 + hstep, voffB); PG8_STAGE(PG8_SA(0, 0), a2, voffA);
            PG8_WAIT_V(8); PG8_WAIT_L(0); PG8_BAR; PG8_MMA(1, 0, At, B0); PG8_MMA(1, 1, At, B1); PG8_BAR; PG8_SCHED;
            PG8_LDB(B0, 1, 0); PG8_LDB(B1, 1, 1); PG8_SCHED; PG8_LDA(At, 1, 0); PG8_STAGE(PG8_SA(0, 1), a2 + hstep, voffA);
            PG8_WAIT_V(8); PG8_WAIT_L(0); PG8_BAR; PG8_MMA(0, 0, At, B0); PG8_MMA(0, 1, At, B1); PG8_BAR; PG8_SCHED;
            PG8_LDA(At, 1, 1); PG8_STAGE(PG8_SB(1, 0), b3, voffB); PG8_STAGE(PG8_SB(1, 1), b3 + hstep, voffB); PG8_STAGE(PG8_SA(1, 0), a3, voffA);
            PG8_WAIT_V(8); PG8_WAIT_L(0); PG8_BAR; PG8_MMA(1, 0, At, B0); PG8_MMA(1, 1, At, B1); PG8_BAR; PG8_SCHED;
            } else {
            PG8_LDB(B0, 0, 0); PG8_SCHED; PG8_LDA(At, 0, 0); PG8_STAGE(PG8_SA(1, 1), a1 + hstep, voffA);
            PG8_WAIT_L(8); PG8_BAR; PG8_WAIT_L(0); PG8_MMA(0, 0, At, B0); PG8_BAR; PG8_SCHED;
            PG8_LDB(B1, 0, 1); PG8_STAGE(PG8_SB(0, 0), b2, voffB);
            PG8_BAR; PG8_WAIT_L(0); PG8_MMA(0, 1, At, B1); PG8_BAR;
            PG8_LDA(At, 0, 1); PG8_STAGE(PG8_SA(0, 0), a2, voffA);
            PG8_BAR; PG8_WAIT_L(0); PG8_MMA(1, 0, At, B0); PG8_BAR; PG8_SCHED;
            PG8_STAGE(PG8_SB(0, 1), b2 + hstep, voffB);
            PG8_WAIT_V(6); PG8_BAR; PG8_MMA(1, 1, At, B1); PG8_BAR;
            PG8_LDB(B0, 1, 0); PG8_SCHED; PG8_LDA(At, 1, 0); PG8_STAGE(PG8_SA(0, 1), a2 + hstep, voffA);
            PG8_WAIT_L(8); PG8_BAR; PG8_WAIT_L(0); PG8_MMA(0, 0, At, B0); PG8_BAR; PG8_SCHED;
            PG8_LDB(B1, 1, 1); PG8_STAGE(PG8_SB(1, 0), b3, voffB);
            PG8_BAR; PG8_WAIT_L(0); PG8_MMA(0, 1, At, B1); PG8_BAR;
            PG8_LDA(At, 1, 1); PG8_STAGE(PG8_SA(1, 0), a3, voffA);
            PG8_BAR; PG8_WAIT_L(0); PG8_MMA(1, 0, At, B0); PG8_BAR; PG8_SCHED;
            PG8_STAGE(PG8_SB(1, 1), b3 + hstep, voffB);
            PG8_WAIT_V(6); PG8_BAR; PG8_MMA(1, 1, At, B1); PG8_BAR;
            }
        }
        if constexpr (ALIGN_EPI) { if (wr == 0) PG8_BAR; }
        if constexpr (!Epi::AFTER_DRAIN) { E(acc, cur, wr, wc, fr, fq); S.done(cur); }
        if (!has_next) break;
#pragma unroll
        for (int a = 0; a < 2; ++a)
#pragma unroll
            for (int b = 0; b < 2; ++b)
#pragma unroll
                for (int m = 0; m < 4; ++m)
#pragma unroll
                    for (int n = 0; n < 2; ++n) acc[a][b][m][n] = (f32x4){0.f, 0.f, 0.f, 0.f};
        cur = nxt; cA = nA; cB = nB; ++ui;
        if constexpr (ALIGN_EPI) { if (wr == 1) PG8_BAR; }
    }
    PG8_WAIT_V(0);
    if constexpr (!ALIGN_EPI) { if (wr == 0) PG8_BAR; }
    PG8_BAR;
    if constexpr (Epi::AFTER_DRAIN) { E.fused(acc, cur, wr, wc, fr, fq, lds, wid, lane); S.done(cur); }
#undef PG8_SA
#undef PG8_SB
#undef PG8_STAGE
#undef PG8_LDA
#undef PG8_LDB
#undef PG8_MMA
#undef PG8_WAIT_V
#undef PG8_WAIT_L
#undef PG8_BAR
#undef PG8_SCHED
}
}

#ifndef PG8_SP2
#define PG8_SP2 true
#endif
#ifndef PG8_ALIGN
#define PG8_ALIGN true
#endif
#include <hip/hip_bf16.h>
#include <cmath>
namespace attn_body {
using bf16=__hip_bfloat16;
using bf16x8=__attribute__((ext_vector_type(8)))short;
using s16x4=__attribute__((ext_vector_type(4)))short;
using f32x16=__attribute__((ext_vector_type(16)))float;
using u32x4=__attribute__((ext_vector_type(4)))unsigned;
constexpr int SEQ=8192,D=64,PIN=2816,POUT=1024;
constexpr int NW=8,QBLK=32,QB=QBLK*NW,KVBLK=64,NQB=SEQ/QB;
constexpr int ATTN_UNIT_ROWS=QB;
__device__ __forceinline__ int crow(int r,int hi){return (r&3)+8*(r>>2)+4*hi;}
#define SBAR() __builtin_amdgcn_sched_barrier(0)
__device__ __forceinline__ void cmask(f32x16&p0,f32x16&p1,int jb,int qrel,int hi){
  const float NEG=-INFINITY; (void)hi;
  if(jb>(qrel>>6)){
    #pragma unroll
    for(int r=0;r<16;++r){p0[r]=NEG;p1[r]=NEG;}
  }
}
constexpr int NSLOT=3, SLOTB=8192;
constexpr int LDS_K=0, LDS_V=NSLOT*SLOTB, LDS_WS=2*NSLOT*SLOTB, LDS_OST=LDS_WS+NW*64*4, LDS_BYTES=LDS_OST+NW*4096;
constexpr float C2=0.125f*1.4426950408889634f;
__device__ __forceinline__ void glds16(const void*gsrc,unsigned lds_dst){unsigned keep;
  asm volatile("s_mov_b32 %0, m0\n\ts_mov_b32 m0, %2\n\ts_nop 0\n\tglobal_load_lds_dwordx4 %1, off\n\ts_mov_b32 m0, %0":"=&s"(keep):"v"(gsrc),"s"(lds_dst):"memory");}
__device__ __forceinline__ float max3f(float a,float b,float c){float r;asm("v_max3_f32 %0, %1, %2, %3":"=v"(r):"v"(a),"v"(b),"v"(c));return r;}
__device__ __forceinline__ float max2f(float a,float b){float r;asm("v_max_f32_e32 %0, %1, %2":"=v"(r):"v"(a),"v"(b));return r;}
__device__ __forceinline__ float fadd_s(float a,float b){float r;asm("v_add_f32_e32 %0, %1, %2":"=v"(r):"v"(a),"v"(b));return r;}
__device__ __forceinline__ float fsub_s(float a,float b){float r;asm("v_sub_f32_e32 %0, %1, %2":"=v"(r):"v"(a),"v"(b));return r;}
typedef float f32x2_t __attribute__((ext_vector_type(2))); typedef __bf16 bf16x2_t __attribute__((ext_vector_type(2)));
__device__ __forceinline__ unsigned cvtpk_s(float lo,float hi){f32x2_t v={lo,hi};bf16x2_t b=__builtin_convertvector(v,bf16x2_t);return __builtin_bit_cast(unsigned,b);}
#define WAIT_BAR(N) asm volatile("s_waitcnt vmcnt(" #N ") lgkmcnt(0)\n\ts_barrier":::"memory")

__device__ __forceinline__ void qkt(f32x16&p0,f32x16&p1,const char*Kslot,const bf16x8*qr,const f32x16&negm,int r32,int hi){
  const char*kb=Kslot+hi*1024+r32*16;
  #pragma unroll
  for(int d0=0;d0<4;++d0){
    const bf16x8 b0=*reinterpret_cast<const bf16x8*>(kb+d0*2048);
    const bf16x8 b1=*reinterpret_cast<const bf16x8*>(kb+d0*2048+512);
    if(d0==0){p0=__builtin_amdgcn_mfma_f32_32x32x16_bf16(b0,qr[0],negm,0,0,0);p1=__builtin_amdgcn_mfma_f32_32x32x16_bf16(b1,qr[0],negm,0,0,0);}
    else{p0=__builtin_amdgcn_mfma_f32_32x32x16_bf16(b0,qr[d0],p0,0,0,0);p1=__builtin_amdgcn_mfma_f32_32x32x16_bf16(b1,qr[d0],p1,0,0,0);}}
}
typedef __attribute__((address_space(3))) const char* lds_cptr;
typedef short v4i16_t __attribute__((ext_vector_type(4)));
__device__ __forceinline__ void kload8(bf16x8*kf,lds_cptr kp){
  kf[0]=*(const __attribute__((address_space(3))) bf16x8*)(kp);      kf[1]=*(const __attribute__((address_space(3))) bf16x8*)(kp+512);
  kf[2]=*(const __attribute__((address_space(3))) bf16x8*)(kp+2048); kf[3]=*(const __attribute__((address_space(3))) bf16x8*)(kp+2560);
  kf[4]=*(const __attribute__((address_space(3))) bf16x8*)(kp+4096); kf[5]=*(const __attribute__((address_space(3))) bf16x8*)(kp+4608);
  kf[6]=*(const __attribute__((address_space(3))) bf16x8*)(kp+6144); kf[7]=*(const __attribute__((address_space(3))) bf16x8*)(kp+6656);
}
__device__ __forceinline__ void kload2(bf16x8*kf,lds_cptr kp,int j){ kf[2*j]=*(const __attribute__((address_space(3))) bf16x8*)(kp+j*2048); kf[2*j+1]=*(const __attribute__((address_space(3))) bf16x8*)(kp+j*2048+512); }
__device__ __forceinline__ s16x4 vtr(lds_cptr p){ return __builtin_bit_cast(s16x4,__builtin_amdgcn_ds_read_tr16_b64_v4i16((__attribute__((address_space(3))) v4i16_t*)p)); }
__device__ __forceinline__ float rowmax(const f32x16&p0,const f32x16&p1){
  float a=max3f(p0[0],p0[1],p1[0]),b=max3f(p0[2],p0[3],p1[1]);a=max3f(a,p1[2],p1[3]);
  #pragma unroll
  for(int r=4;r<16;r+=4){a=max3f(a,p0[r],p0[r+1]);b=max3f(b,p0[r+2],p0[r+3]);a=max3f(a,p1[r],p1[r+1]);b=max3f(b,p1[r+2],p1[r+3]);}
  const float m=max2f(a,b);
  auto rr=__builtin_amdgcn_permlane32_swap(__float_as_uint(m),__float_as_uint(m),false,false);
  return max2f(__uint_as_float(rr[0]),__uint_as_float(rr[1]));
}
__device__ __forceinline__ void pv(f32x16*o,int vb,bf16x8 pa0,bf16x8 pa1,bf16x8 pa2,bf16x8 pa3){
  #pragma unroll
  for(int d0=0;d0<2;++d0){s16x4 lo[4],hi[4];
    #pragma unroll
    for(int ks=0;ks<4;++ks){
      asm volatile("ds_read_b64_tr_b16 %0,%1 offset:%c2":"=&v"(lo[ks]):"v"(vb),"i"(d0*4096+ks*1024):"memory");
      asm volatile("ds_read_b64_tr_b16 %0,%1 offset:%c2":"=&v"(hi[ks]):"v"(vb),"i"(d0*4096+ks*1024+512):"memory");}
    asm volatile("s_waitcnt lgkmcnt(0)":::"memory");SBAR();
    #define PK(k) (bf16x8){lo[k][0],lo[k][1],lo[k][2],lo[k][3],hi[k][0],hi[k][1],hi[k][2],hi[k][3]}
    o[d0]=__builtin_amdgcn_mfma_f32_32x32x16_bf16(pa0,PK(0),o[d0],0,0,0);
    o[d0]=__builtin_amdgcn_mfma_f32_32x32x16_bf16(pa1,PK(1),o[d0],0,0,0);
    o[d0]=__builtin_amdgcn_mfma_f32_32x32x16_bf16(pa2,PK(2),o[d0],0,0,0);
    o[d0]=__builtin_amdgcn_mfma_f32_32x32x16_bf16(pa3,PK(3),o[d0],0,0,0);
    #undef PK
  }
}

#ifndef ATTN_STORE16
#define ATTN_STORE16(p,v) (*(u32x4*)(p)=(v))
#endif
template<int THRL> __device__ __forceinline__ void attn_unit(int qb,const bf16*Qh,const bf16*__restrict__ Kh,const bf16*__restrict__ Vh,bf16*Oh,char*shm){
  int tid_=threadIdx.x; asm volatile("":"+v"(tid_)); const int tid=tid_,lane=tid&63,r32=lane&31,hi=lane>>5; const int wid=__builtin_amdgcn_readfirstlane(tid>>6);
  const int q0=qb*QB;
  const bf16*Qw=Qh+(long)(q0+wid*QBLK)*PIN;
  const unsigned lds0=(unsigned)(uintptr_t)shm;
  float*wsf=(float*)(shm+LDS_WS)+wid*64;
  const bf16*ksrc=Kh+(long)lane*PIN+wid*8;
  const bf16*vsrc=Vh+(long)(16*(wid&3)+(lane>>2))*PIN+(wid>>2)*32+(lane&3)*8;
  const unsigned kdst=lds0+LDS_K+wid*1024, vdst=lds0+LDS_V+wid*1024;
  #define DMA_K(t,slot) glds16(ksrc+(long)(t)*KVBLK*PIN,(unsigned)__builtin_amdgcn_readfirstlane(kdst+(slot)))
  #define DMA_V(t,slot) glds16(vsrc+(long)(t)*KVBLK*PIN,(unsigned)__builtin_amdgcn_readfirstlane(vdst+(slot)))
  const int vb0=(int)(lds0+LDS_V)+((lane>>4)&1)*32+(lane&3)*8+(4*hi+((lane&15)>>2))*64;
  const char*Kbase=shm+LDS_K; bf16x8 kf[8];
  const lds_cptr shm3=(lds_cptr)shm; const lds_cptr kp0=shm3+LDS_K+hi*1024+r32*16; const lds_cptr vp0=shm3+LDS_V+((lane>>4)&1)*32+(lane&3)*8+(4*hi+((lane&15)>>2))*64;
  const int NT=(q0+QB)/KVBLK;
  DMA_K(0,0);DMA_V(0,0);DMA_K(1,SLOTB);
  bf16x8 qr[4];
  #pragma unroll
  for(int d0=0;d0<4;++d0)qr[d0]=*reinterpret_cast<const bf16x8*>(&Qw[(long)r32*PIN+d0*16+hi*8]);
  float mhat=0.f,l_reg=0.f;f32x16 o[2];o[0]=f32x16{};o[1]=f32x16{};f32x16 negm=f32x16{};asm volatile("":"+v"(negm));
  const int qrel=wid*QBLK+r32;
  #define CMASK(P0,P1,t) do{int jb_=(t)-(NT-4); if(jb_>=0)cmask(P0,P1,jb_,qrel,hi);}while(0)
  bool resc=false;
  #define START(P0,P1) do{ const float rm=rowmax(P0,P1); resc=false; \
    { const float dl=rm; mhat=fadd_s(mhat,dl); \
      _Pragma("unroll") for(int r=0;r<16;++r){P0[r]=fsub_s(P0[r],dl);P1[r]=fsub_s(P1[r],dl);} \
      _Pragma("unroll") for(int r=0;r<16;++r)negm[r]=-mhat; asm volatile("":"+v"(negm)); } \
    _Pragma("unroll") for(int r=0;r<16;++r)P0[r]=__builtin_amdgcn_exp2f(P0[r]); }while(0)
  #define RESC() do{ if(resc){ asm volatile("s_waitcnt lgkmcnt(0)":::"memory"); \
      _Pragma("unroll") for(int d_=0;d_<2;++d_) _Pragma("unroll") for(int r=0;r<16;++r)o[d_][r]*=wsf[crow(r,hi)]; } }while(0)
  f32x16 pA0,pA1,pB0,pB1;
  int sl_prev=0,sl_cur=0,sl_next=SLOTB;
  #define ROT() do{sl_prev=sl_cur;sl_cur=sl_next;sl_next=(sl_next==(NSLOT-1)*SLOTB)?0:sl_next+SLOTB;}while(0)
  DMA_K(2,2*SLOTB);
  WAIT_BAR(3);
  qkt(pA0,pA1,Kbase,qr,negm,r32,hi);asm volatile("s_nop 15\n\ts_nop 7":"+v"(pA0),"+v"(pA1));CMASK(pA0,pA1,0);
  START(pA0,pA1);
  _Pragma("unroll") for(int r=0;r<16;++r)pA1[r]=__builtin_amdgcn_exp2f(pA1[r]);
  WAIT_BAR(0);
  DMA_K(3,0);DMA_V(1,SLOTB);
  ROT();
  kload8(kf,kp0+sl_cur);
  WAIT_BAR(2);
  s16x4 vlo[8],vhi[8]; u32x4 pw0,pw1,pw2,pw3;
  #define PKW(P,B) cvtpk_s(P[B],P[B+1])
  #define PAF(k) __builtin_bit_cast(bf16x8,pw##k)
  #define VFR(i) (bf16x8){vlo[i][0],vlo[i][1],vlo[i][2],vlo[i][3],vhi[i][0],vhi[i][1],vhi[i][2],vhi[i][3]}
  #define PIN(x) asm volatile("":"+v"(x))
  #define MX3(a,b,c) __builtin_fmaxf(__builtin_fmaxf((a),(b)),(c))
  #define GAPA(MF,A0,A1,A2,A3,W0,W1,PW) do{ MF; sacc+=A0; sacc+=A1; sacc+=A2; sacc+=A3; PIN(sacc); W0; W1; PIN(PW); SBAR(); }while(0)
  #define EX(v) __builtin_amdgcn_exp2f(v)
  #define GAPB(MF,X,B) do{ MF; X[B]=EX(X[B]); X[B+1]=EX(X[B+1]); X[B+2]=EX(X[B+2]); X[B+3]=EX(X[B+3]); PIN(X); SBAR(); }while(0)
  #define VRD(i) do{ vlo[i]=vtr(vp_+(((i)>>2)*4096+((i)&3)*1024)); vhi[i]=vtr(vp_+(((i)>>2)*4096+((i)&3)*1024+512)); }while(0)
  #define KRD(G,j) do{ if(G){ kload2(kf,kp0+sl_next,j); SBAR(); } }while(0)
  #define STEP(C0,C1,P0,P1,t,GK,GV,GL) do{ SBAR(); \
    const lds_cptr vp_=vp0+sl_prev; \
    VRD(0); SBAR(); float sacc=(P0[0]+P0[1]); \
    GAPA(C0=__builtin_amdgcn_mfma_f32_32x32x16_bf16(kf[0],qr[0],negm,0,0,0), P0[2],P0[3],P0[4],P0[5],     pw0[0]=PKW(P0,0), pw0[1]=PKW(P0,2), pw0); \
    VRD(4); SBAR(); GAPA(C1=__builtin_amdgcn_mfma_f32_32x32x16_bf16(kf[1],qr[0],negm,0,0,0), P0[6],P0[7],P0[8],P0[9],     pw0[2]=PKW(P0,4), pw0[3]=PKW(P0,6), pw0); \
    VRD(1); SBAR(); GAPA(C0=__builtin_amdgcn_mfma_f32_32x32x16_bf16(kf[2],qr[1],C0,0,0,0),   P0[10],P0[11],P0[12],P0[13], pw1[0]=PKW(P0,8), pw1[1]=PKW(P0,10), pw1); \
    VRD(5); SBAR(); GAPA(C1=__builtin_amdgcn_mfma_f32_32x32x16_bf16(kf[3],qr[1],C1,0,0,0),   P0[14],P0[15],P1[0],P1[1],   pw1[2]=PKW(P0,12),pw1[3]=PKW(P0,14), pw1); \
    VRD(2); SBAR(); GAPA(C0=__builtin_amdgcn_mfma_f32_32x32x16_bf16(kf[4],qr[2],C0,0,0,0),   P1[2],P1[3],P1[4],P1[5],     pw2[0]=PKW(P1,0), pw2[1]=PKW(P1,2), pw2); \
    VRD(6); SBAR(); GAPA(C1=__builtin_amdgcn_mfma_f32_32x32x16_bf16(kf[5],qr[2],C1,0,0,0),   P1[6],P1[7],P1[8],P1[9],     pw2[2]=PKW(P1,4), pw2[3]=PKW(P1,6), pw2); \
    VRD(3); SBAR(); GAPA(C0=__builtin_amdgcn_mfma_f32_32x32x16_bf16(kf[6],qr[3],C0,0,0,0),   P1[10],P1[11],P1[12],P1[13], pw3[0]=PKW(P1,8), pw3[1]=PKW(P1,10), pw3); \
    VRD(7); SBAR(); GAPA(C1=__builtin_amdgcn_mfma_f32_32x32x16_bf16(kf[7],qr[3],C1,0,0,0),   P1[14],P1[15],0.f,0.f,       pw3[2]=PKW(P1,12),pw3[3]=PKW(P1,14), pw3); \
    l_reg+=sacc; \
    if(GK){DMA_K((t)+3,sl_cur);} if(GV){DMA_V((t)+1,sl_next);} \
    CMASK(C0,C1,t); \
    { float a=MX3(C0[0],C0[1],C1[0]),b=MX3(C0[2],C0[3],C1[1]); a=MX3(a,C1[2],C1[3]); \
      _Pragma("unroll") for(int r=4;r<16;r+=4){a=MX3(a,C0[r],C0[r+1]);b=MX3(b,C0[r+2],C0[r+3]);a=MX3(a,C1[r],C1[r+1]);b=MX3(b,C1[r+2],C1[r+3]);} \
      float rm=__builtin_fmaxf(a,b); { auto rr=__builtin_amdgcn_permlane32_swap(__float_as_uint(rm),__float_as_uint(rm),false,false); rm=__builtin_fmaxf(__uint_as_float(rr[0]),__uint_as_float(rr[1])); } \
      resc=false; \
      if(__builtin_expect(__any(rm>(float)THRL),0)){ const float dl=__builtin_fmaxf(rm,0.f); mhat+=dl; \
        _Pragma("unroll") for(int r=0;r<16;++r){C0[r]-=dl;C1[r]-=dl;} \
        _Pragma("unroll") for(int r=0;r<16;++r)negm[r]=-mhat; asm volatile("":"+v"(negm)); \
        const float f=__builtin_amdgcn_exp2f(-dl); l_reg*=f; if(hi==0)wsf[r32]=f; resc=true; } } \
    SBAR(); \
    GAPB(o[0]=__builtin_amdgcn_mfma_f32_32x32x16_bf16(PAF(0),VFR(0),o[0],0,0,0), C0,0); \
    GAPB(o[1]=__builtin_amdgcn_mfma_f32_32x32x16_bf16(PAF(0),VFR(4),o[1],0,0,0), C0,4); \
    KRD(GL,0); GAPB(o[0]=__builtin_amdgcn_mfma_f32_32x32x16_bf16(PAF(1),VFR(1),o[0],0,0,0), C0,8); \
    KRD(GL,1); GAPB(o[1]=__builtin_amdgcn_mfma_f32_32x32x16_bf16(PAF(1),VFR(5),o[1],0,0,0), C0,12); \
    KRD(GL,2); GAPB(o[0]=__builtin_amdgcn_mfma_f32_32x32x16_bf16(PAF(2),VFR(2),o[0],0,0,0), C1,0); \
    KRD(GL,3); GAPB(o[1]=__builtin_amdgcn_mfma_f32_32x32x16_bf16(PAF(2),VFR(6),o[1],0,0,0), C1,4); \
    GAPB(o[0]=__builtin_amdgcn_mfma_f32_32x32x16_bf16(PAF(3),VFR(3),o[0],0,0,0), C1,8); \
    GAPB(o[1]=__builtin_amdgcn_mfma_f32_32x32x16_bf16(PAF(3),VFR(7),o[1],0,0,0), C1,12); \
    }while(0)
  int t=1;
  #undef CMASK
  #define CMASK(P0,P1,t) do{}while(0)
  for(;t+5<NT;t+=2){
    STEP(pB0,pB1,pA0,pA1,t,true,true,true);     WAIT_BAR(2); RESC(); ROT();
    STEP(pA0,pA1,pB0,pB1,t+1,true,true,true);   WAIT_BAR(2); RESC(); ROT();
  }
  #undef CMASK
  #define CMASK(P0,P1,t) do{int jb_=(t)-(NT-4); if(jb_>=0)cmask(P0,P1,jb_,qrel,hi);}while(0)
  #define ENDW(tt) do{ if((tt)+3<NT){WAIT_BAR(2);} else if((tt)+2<NT){WAIT_BAR(1);} else {WAIT_BAR(0);} }while(0)
  for(;t+1<NT;t+=2){
    STEP(pB0,pB1,pA0,pA1,t,(t+3<NT),(t+1<NT),(t+1<NT));       ENDW(t);   RESC(); ROT();
    STEP(pA0,pA1,pB0,pB1,t+1,(t+4<NT),(t+2<NT),(t+2<NT));     ENDW(t+1); RESC(); ROT();
  }
  STEP(pB0,pB1,pA0,pA1,NT-1,false,false,false); RESC();
  { float sacc=pB0[0]+pB0[1]; _Pragma("unroll") for(int r=2;r<16;++r)sacc+=pB0[r]; _Pragma("unroll") for(int r=0;r<16;++r)sacc+=pB1[r]; l_reg+=sacc;
    pw0=(u32x4){PKW(pB0,0),PKW(pB0,2),PKW(pB0,4),PKW(pB0,6)};pw1=(u32x4){PKW(pB0,8),PKW(pB0,10),PKW(pB0,12),PKW(pB0,14)};pw2=(u32x4){PKW(pB1,0),PKW(pB1,2),PKW(pB1,4),PKW(pB1,6)};pw3=(u32x4){PKW(pB1,8),PKW(pB1,10),PKW(pB1,12),PKW(pB1,14)};
    SBAR(); pv(o,vb0+sl_cur,PAF(0),PAF(1),PAF(2),PAF(3)); }
  #undef PKW
  #undef PAF
  #undef VFR
  #undef PIN
  #undef MX3
  #undef GAPA
  #undef GAPB
  #undef EX
  #undef VRD
  #undef KRD
  #undef STEP
  #undef ENDW
  {auto rr=__builtin_amdgcn_permlane32_swap(__float_as_uint(l_reg),__float_as_uint(l_reg),false,false);l_reg=__uint_as_float(rr[0])+__uint_as_float(rr[1]);}
  if(hi==0)wsf[32+r32]=l_reg;asm volatile("s_waitcnt lgkmcnt(0)":::"memory");
  float rli[16];
  #pragma unroll
  for(int r=0;r<16;++r)rli[r]=__builtin_amdgcn_rcpf(wsf[32+crow(r,hi)]);
  bf16*Ow=Oh+(long)(q0+wid*QBLK)*POUT;
  { bf16*stg=(bf16*)(shm+LDS_OST)+wid*2048;
    #pragma unroll
    for(int r=0;r<16;++r){const int orow=crow(r,hi);
      #pragma unroll
      for(int d0=0;d0<2;++d0)stg[orow*64+d0*32+r32]=__float2bfloat16(o[d0][r]*rli[r]);}
    asm volatile("s_waitcnt lgkmcnt(0)":::"memory");
    #pragma unroll
    for(int i=0;i<4;++i){const int row=i*8+(lane>>3),ch=lane&7; const u32x4 v=*(const u32x4*)(stg+row*64+ch*8); ATTN_STORE16(Ow+(long)row*POUT+ch*8,v);} }
  asm volatile("s_waitcnt lgkmcnt(0)\n\ts_barrier":::"memory");
  #undef DMA_K
  #undef DMA_V
  #undef CMASK
  #undef START
  #undef RESC
  #undef ROT
}
struct AttnTensors { const bf16* P; bf16* O; };
struct AttnUnit { int hd; int qb; };
struct StaticOrder {
  int vcu;
  __device__ __forceinline__ explicit StaticOrder(int grid,int block):vcu((grid%8==0)?((block%8)*(grid/8)+block/8):block){}
  __device__ __forceinline__ bool next(int i,AttnUnit&u)const{ if(i>=16)return false; const int s=vcu&7,hs=i>>2,k=i&3; u.hd=(vcu>>3)+32*hs; u.qb=(k==0)?s:(k==1)?15-s:(k==2)?16+s:31-s; return true; }
  __device__ __forceinline__ void a_ready(const AttnUnit&)const{}
  __device__ __forceinline__ void done(const AttnUnit&)const{}
};
template<class Sched,int THRL=8> __device__ __forceinline__ void attn_phase(char*lds,const AttnTensors&T,const Sched&S,int cq,int ck,int cv){
  AttnUnit u;
  for(int i=0;S.next(i,u);++i){ S.a_ready(u);
    const int j=u.hd&1,m=(u.hd>>1)&1,h=(u.hd>>2)&3,b=u.hd>>4;
    const bf16*base=T.P+(long)b*SEQ*PIN;
    attn_unit<THRL>(u.qb,base+cq+(2*h+m)*64,base+ck+(2*h+m)*64,base+cv+h*128+j*64,T.O+(long)b*SEQ*POUT+h*256+m*128+j*64,lds);
    S.done(u); }
}
constexpr int ATTN_LDS_BYTES=LDS_BYTES;
#undef SBAR
#undef WAIT_BAR
}
#define GAS __attribute__((address_space(1)))
#define LAS __attribute__((address_space(3)))
typedef unsigned short bf16;
typedef unsigned v4u __attribute__((ext_vector_type(4)));
typedef float f32x4 __attribute__((ext_vector_type(4)));
typedef short bf16x8 __attribute__((ext_vector_type(8)));
typedef GAS unsigned gu32;
typedef GAS unsigned long long gu64;
#define RLX_AGENT __ATOMIC_RELAXED, __HIP_MEMORY_SCOPE_AGENT
#define LDS_WAIT() asm volatile("s_waitcnt lgkmcnt(0)" ::: "memory")
#define VM_WAIT() asm volatile("s_waitcnt vmcnt(0)" ::: "memory")
__device__ __forceinline__ unsigned long long rt() { return __builtin_amdgcn_s_memrealtime(); }
__device__ __forceinline__ unsigned f2bf(float f) { unsigned u = __builtin_bit_cast(unsigned, f); return (u + 0x7fffu + ((u >> 16) & 1u)) >> 16; }
__device__ __forceinline__ unsigned pk2(float lo, float hi) { return f2bf(lo) | (f2bf(hi) << 16); }

#define XB_TMO      128
#define XB_XCNT(j)  (256  + 64 * (j))
#define XB_XSUB(j)  (1280 + 64 * (j))
#define XB_XGEN(j)  (2304 + 64 * (j))
#define XB_TOP      3328
#define XB_TOPGEN   3392
#define XCD_BAR_WORDS 3456
#define XB_SPIN_CAP (1u << 18)

__device__ __forceinline__ unsigned xb_ld(unsigned* p)              { return __hip_atomic_load(p, __ATOMIC_RELAXED, __HIP_MEMORY_SCOPE_AGENT); }
__device__ __forceinline__ unsigned xb_add(unsigned* p, unsigned v) { return __hip_atomic_fetch_add(p, v, __ATOMIC_RELAXED, __HIP_MEMORY_SCOPE_AGENT); }
__device__ __forceinline__ unsigned xb_xcc_id() { return (unsigned)__builtin_amdgcn_s_getreg((3 << 11) | 20) & 0xFu; }
#define XB_SPIN(cond, bar) do { unsigned _sp = 0; while (cond) { __builtin_amdgcn_s_sleep(1); \
    if ((++_sp & 255u) == 0u) { if (xb_ld(&(bar)[XB_TMO])) break; if (_sp > XB_SPIN_CAP) { atomicAdd(&(bar)[XB_TMO], 1u); break; } } } } while (0)

struct XcdBarrier {
    unsigned* bar; unsigned x;
    volatile LAS unsigned* st;
};

__device__ __forceinline__ XcdBarrier xcd_barrier_post(unsigned* bar, volatile LAS unsigned* st) {
    XcdBarrier b; b.bar = bar; b.x = xb_xcc_id(); b.st = st;
    if (threadIdx.x == 0) (void)xb_add(&bar[XB_XCNT(b.x)], 1u);
    return b;
}
__device__ __forceinline__ void xcd_barrier_complete(unsigned* bar, unsigned x, unsigned& nloc, unsigned& nx) {
    const unsigned G = gridDim.x * gridDim.y * gridDim.z;
    unsigned sum, cnt, mine, sp = 0u;
    for (;;) {
        sum = 0u; cnt = 0u; mine = 0u;
#pragma unroll
        for (unsigned j = 0; j < 16; ++j) { const unsigned c = xb_ld(&bar[XB_XCNT(j)]); sum += c; cnt += (c > 0u) ? 1u : 0u; mine = (j == x) ? c : mine; }
        if (sum == G) break;
        __builtin_amdgcn_s_sleep(1);
        if ((++sp & 255u) == 0u) { if (xb_ld(&bar[XB_TMO])) break; if (sp > XB_SPIN_CAP) { atomicAdd(&bar[XB_TMO], 1u); break; } }
    }
    nloc = mine > 0u ? mine : 1u; nx = cnt > 0u ? cnt : 1u;
}

__device__ __forceinline__ void xcd_barrier(const XcdBarrier& b) {
    asm volatile("s_waitcnt vmcnt(0)" ::: "memory");
    __syncthreads();
    if (threadIdx.x == 0) {
        unsigned* bar = b.bar;
        __builtin_amdgcn_s_waitcnt(0);
        unsigned nloc = b.st[0], nx = b.st[1];
        if (nloc == 0u) { xcd_barrier_complete(bar, b.x, nloc, nx); b.st[0] = nloc; b.st[1] = nx; }
        const unsigned old = xb_add(&bar[XB_XSUB(b.x)], 1u);
        const unsigned gen = old / nloc;
        if (old + 1u == (gen + 1u) * nloc) {
            __builtin_amdgcn_fence(__ATOMIC_RELEASE, "agent");
            asm volatile("s_waitcnt vmcnt(0)" ::: "memory");
            const unsigned og = xb_add(&bar[XB_TOP], 1u);
            const unsigned tg = og / nx;
            if (og + 1u == (tg + 1u) * nx) xb_add(&bar[XB_TOPGEN], 1u);
            else XB_SPIN(xb_ld(&bar[XB_TOPGEN]) == tg, bar);
            __builtin_amdgcn_fence(__ATOMIC_ACQUIRE, "agent");
            xb_add(&bar[XB_XGEN(b.x)], 1u);
            asm volatile("s_waitcnt vmcnt(0)" ::: "memory");
        } else {
            XB_SPIN(xb_ld(&bar[XB_XGEN(b.x)]) == gen, bar);
            __builtin_amdgcn_fence(__ATOMIC_ACQUIRE, "agent");
            asm volatile("s_waitcnt vmcnt(0)" ::: "memory");
        }
    }
    __syncthreads();
}

constexpr int NWAVES = 8;
#ifndef PHMASK
#define PHMASK 0xFFFF
#endif
#define PHON(k) (((PHMASK) >> (k)) & 1)
#ifndef MK_PER_PHASE
#define MK_PER_PHASE 0
#endif

constexpr int BATCH = 8, SEQ = 8192, D = 1024, FF = 4096, DEPTH = 2;
constexpr int M = BATCH * SEQ;
constexpr int CHUNK = 64, NCH = SEQ / CHUNK;
constexpr int NP_SRC = 2576;
constexpr int NP = 2816;
constexpr int C_POOL = 0, C_DQ = 256, C_DK = 768, C_DV = 1280, C_GQ = 1792, C_GK = 1920, C_GV = 2048, C_GR = 2304, C_GG = 2560;
constexpr float EPS = 1e-6f;
static_assert(NP == attn_body::PIN && D == attn_body::POUT, "pitches");

constexpr size_t MiB = 1u << 20;
constexpr size_t WS_CTL = 0, CTL_ZERO_BYTES = 1 * MiB;
constexpr size_t WS_WPOOL = 1 * MiB;
constexpr size_t WS_W = 2 * MiB, W_LAYER = 24 * MiB;
constexpr size_t WO_IN = 0, WO_OUT = 6 * MiB, WO_1 = 8 * MiB, WO_2 = 16 * MiB;
constexpr size_t WS_SSA = 50 * MiB, WS_SSB = 54 * MiB;
constexpr size_t WS_GDEC = 58 * MiB;
constexpr size_t WS_GKV = 60 * MiB;
constexpr size_t WS_HB = 96 * MiB;
constexpr size_t WS_PROJ = 224 * MiB;
constexpr size_t WS_OATT = 576 * MiB;
constexpr size_t WS_MIX = 704 * MiB;
constexpr size_t WS_HID = 224 * MiB;
constexpr size_t WS_END = 832 * MiB;
static_assert(WS_W + DEPTH * W_LAYER <= WS_SSA && WS_GKV + (size_t)BATCH * 4 * NCH * 2048 * 4 <= WS_HB && WS_HB + (size_t)M * D * 2 <= WS_PROJ && WS_PROJ + (size_t)M * NP * 2 <= WS_OATT && WS_HID + (size_t)M * FF * 2 <= WS_END, "d_ws map");
constexpr int CW_TMO = 0, CW_CODE = 1;
constexpr int CW_BAR = 4096;

constexpr int RING_OFF = 0, RING_BYTES = 131072;
constexpr int LDSCTL_OFF = RING_BYTES, MISC_OFF = LDSCTL_OFF + 320;
constexpr int LDS_BYTES = 147456;
static_assert(MISC_OFF + 128 <= LDS_BYTES, "LDS map");

struct Frame {
    LAS unsigned char* lds;
    volatile LAS unsigned* MISC;
    gu32* ctl;
    int tid, lane, wave;
    int vcu, G;
};
typedef float f32x16 __attribute__((ext_vector_type(16)));
typedef unsigned u32x2v __attribute__((ext_vector_type(2)));
__device__ __forceinline__ float wave_sum(float v) {
#pragma unroll
    for (int o = 1; o < 64; o <<= 1) v += __shfl_xor(v, o);
    return v;
}
__device__ __forceinline__ float bf2f(unsigned short b) { return __uint_as_float((unsigned)b << 16); }
typedef float f32x2_c __attribute__((ext_vector_type(2))); typedef __bf16 bf16x2_c __attribute__((ext_vector_type(2)));
__device__ __forceinline__ unsigned cvtpk(float lo, float hi) { f32x2_c v = {lo, hi}; bf16x2_c b = __builtin_convertvector(v, bf16x2_c); return __builtin_bit_cast(unsigned, b); }
__device__ __forceinline__ bf16x8 pack8(const float (&v)[8]) { v4u w; w.x = cvtpk(v[0], v[1]); w.y = cvtpk(v[2], v[3]); w.z = cvtpk(v[4], v[5]); w.w = cvtpk(v[6], v[7]); return __builtin_bit_cast(bf16x8, w); }
__device__ __forceinline__ void unpack8(v4u w, float (&v)[8]) {
    v[0] = __uint_as_float(w.x << 16); v[1] = __uint_as_float(w.x & 0xffff0000u); v[2] = __uint_as_float(w.y << 16); v[3] = __uint_as_float(w.y & 0xffff0000u);
    v[4] = __uint_as_float(w.z << 16); v[5] = __uint_as_float(w.z & 0xffff0000u); v[6] = __uint_as_float(w.w << 16); v[7] = __uint_as_float(w.w & 0xffff0000u); }
__device__ __forceinline__ int crow(int r, int hi) { return (r & 3) + 8 * (r >> 2) + 4 * hi; }
__device__ __forceinline__ float logsig(float x) { return __builtin_fminf(x, 0.f) - __logf(1.f + __expf(-__builtin_fabsf(x))); }

__device__ __forceinline__ void p0_item_out(bf16* WT, int K, int row_off, int k0, int n0, LAS float* scr, int lane) {
    LDS_WAIT(); asm volatile("" ::: "memory");
    const int c = lane & 7;
#pragma unroll
    for (int j = 0; j < 4; ++j) { const int n = (lane >> 3) + 8 * j; const LAS float* s = scr + (8 * c) * 33 + n;
        v4u o; o.x = pk2(s[0 * 33], s[1 * 33]); o.y = pk2(s[2 * 33], s[3 * 33]); o.z = pk2(s[4 * 33], s[5 * 33]); o.w = pk2(s[6 * 33], s[7 * 33]);
        *(GAS v4u*)(WT + (size_t)(row_off + n0 + n) * K + k0 + 8 * c) = o; }
    LDS_WAIT(); asm volatile("" ::: "memory");
}
__device__ __forceinline__ void p0_transpose_item(const float* W, int K, int ldw, int col_off, int ncols, const float* gk, bf16* WT, int row_off, LAS float* scr, int item, int lane) {
    const int nblk = ncols / 32, kb = item / nblk, nb = item % nblk, k0 = 64 * kb, n0 = 32 * nb;
#pragma unroll 8
    for (int i = 0; i < 32; ++i) { const int kk = 2 * i + (lane >> 5); const float g = gk ? gk[k0 + kk] : 1.f; scr[kk * 33 + (lane & 31)] = W[(size_t)(k0 + kk) * ldw + col_off + n0 + (lane & 31)] * g; }
    p0_item_out(WT, K, row_off, k0, n0, scr, lane);
}
__device__ __forceinline__ void p0_gate_item(const float* Win, const float* wg2, const float* gk, bf16* WT, int row_off, LAS float* scr, int item, int lane) {
    const int kb = item / 4, nb = item % 4, k0 = 64 * kb, n0 = 32 * nb; const int c = n0 + (lane & 31);
    float w2[16];
#pragma unroll
    for (int r = 0; r < 16; ++r) w2[r] = wg2[r * 128 + c];
#pragma unroll 4
    for (int i = 0; i < 32; ++i) { const int kk = 2 * i + (lane >> 5); const float* wr_ = Win + (size_t)(k0 + kk) * NP_SRC + C_GG; float a = 0.f;
#pragma unroll
        for (int r = 0; r < 16; ++r) a += wr_[r] * w2[r];
        scr[kk * 33 + (lane & 31)] = a * gk[k0 + kk]; }
    p0_item_out(WT, D, row_off, k0, n0, scr, lane);
}
__device__ __forceinline__ void x_row_to_bf16(const float* xrow, bf16* orow, float* ssrow, int lane) {
    const GAS f32x4* xr = (const GAS f32x4*)xrow + lane;
    f32x4 v[4]; float s2 = 0.f;
#pragma unroll
    for (int j = 0; j < 4; ++j) { v[j] = xr[64 * j]; s2 += (v[j].x * v[j].x + v[j].y * v[j].y) + (v[j].z * v[j].z + v[j].w * v[j].w); }
    s2 = wave_sum(s2);
    GAS unsigned long long* o8 = (GAS unsigned long long*)orow + lane;
#pragma unroll
    for (int j = 0; j < 4; ++j) o8[64 * j] = (unsigned long long)pk2(v[j].x, v[j].y) | ((unsigned long long)pk2(v[j].z, v[j].w) << 32);
    if (lane < 16) ssrow[lane] = (lane == 0) ? s2 : 0.f;
}

struct Inputs {
    const float *x, *norm1_g, *w_in, *pool_w, *pool_scale, *lq1, *lk1, *lq2, *lk2, *diff_norm_g, *w_gate2, *b_gate, *gla_norm_g, *w_out, *norm2_g, *w_mlp1, *w_mlp2, *final_g;
};

__device__ __forceinline__ void p0_prologue(Frame& F, const Inputs& I, unsigned char* ws) {
    LAS float* scr = (LAS float*)(F.lds + RING_OFF + F.wave * 16384);
    const int gw = F.vcu * NWAVES + F.wave, NGW = F.G * NWAVES;
    constexpr int I_IN = (D / 64) * (2560 / 32), I_G = (D / 64) * 4, I_O = (D / 64) * (D / 32), I_1 = (D / 64) * (FF / 32), I_2 = (FF / 64) * (D / 32);
    constexpr int NIT = I_IN + I_G + I_O + I_1 + I_2;
    for (int it = gw; it < DEPTH * NIT; it += NGW) {
        const int l = it / NIT; int r = it % NIT;
        unsigned char* wl = ws + WS_W + (size_t)l * W_LAYER;
        const float* win = I.w_in + (size_t)l * D * NP_SRC; const float* g1 = I.norm1_g + l * D; const float* g2 = I.norm2_g + l * D;
        if (r < I_IN) { p0_transpose_item(win, D, NP_SRC, 0, 2560, g1, (bf16*)(wl + WO_IN), 0, scr, r, F.lane); continue; } r -= I_IN;
        if (r < I_G) { p0_gate_item(win, I.w_gate2 + (size_t)l * 16 * 128, g1, (bf16*)(wl + WO_IN), C_GG, scr, r, F.lane); continue; } r -= I_G;
        if (r < I_O) { p0_transpose_item(I.w_out + (size_t)l * D * D, D, D, 0, D, nullptr, (bf16*)(wl + WO_OUT), 0, scr, r, F.lane); continue; } r -= I_O;
        if (r < I_1) { p0_transpose_item(I.w_mlp1 + (size_t)l * D * FF, D, FF, 0, FF, g2, (bf16*)(wl + WO_1), 0, scr, r, F.lane); continue; } r -= I_1;
        p0_transpose_item(I.w_mlp2 + (size_t)l * FF * D, FF, D, 0, D, nullptr, (bf16*)(wl + WO_2), 0, scr, r, F.lane);
    }
    { const int gt = F.vcu * (NWAVES * 64) + F.tid, NT_ = F.G * NWAVES * 64;
      for (int i = gt; i < DEPTH * 16384; i += NT_) { const int l = i / 16384, o = i % 16384;
          *(GAS v4u*)(ws + WS_W + (size_t)l * W_LAYER + WO_IN + (size_t)2688 * D * 2 + (size_t)o * 16) = (v4u){0u, 0u, 0u, 0u}; }
      for (int i = gt; i < DEPTH * 4 * 64 * 64; i += NT_) { const int ch = i & 63, d = (i >> 6) & 63, lg = i >> 12;
          ((bf16*)(ws + WS_WPOOL))[i] = (bf16)f2bf(I.pool_w[(size_t)lg * 4096 + ch * 64 + d]); } }
    for (int m = gw; m < M; m += NGW) x_row_to_bf16(I.x + (size_t)m * D, (bf16*)(ws + WS_HB) + (size_t)m * D, (float*)(ws + WS_SSB) + (size_t)m * 16, F.lane);
}

__device__ __forceinline__ void pool_task(const bf16* PROJ, const bf16* WpT  , const float* pscale, bf16* MIX, int ck, int g, int lane) {
    const int c = lane & 31, hh = lane >> 5; const int tb = ck * CHUNK, sb = (ck % NCH) * CHUNK; const int w = 2 << g;
    const bf16* P = PROJ + C_POOL + g * 64;
    bf16x8 Bf[2][4];
#pragma unroll
    for (int tbk = 0; tbk < 2; ++tbk) {
        const int t = tb + 32 * tbk + c, s = sb + 32 * tbk + c; const int cnt = (s + 1 < w) ? (s + 1) : w; const float inv = 1.0f / (float)cnt;
        const bf16* rp = P + (size_t)t * NP + 8 * hh;
        float cur[4][8], acc[4][8];
#pragma unroll
        for (int ks = 0; ks < 4; ++ks) { unpack8(*(const GAS v4u*)(rp + 16 * ks), cur[ks]);
#pragma unroll
            for (int j = 0; j < 8; ++j) acc[ks][j] = cur[ks][j]; }
#pragma unroll 1
        for (int i = 1; i < w; ++i) {
            if (s - i >= 0) {
#pragma unroll
                for (int ks = 0; ks < 4; ++ks) { float v[8]; unpack8(*(const GAS v4u*)(rp - (size_t)i * NP + 16 * ks), v);
#pragma unroll
                    for (int j = 0; j < 8; ++j) acc[ks][j] += v[j]; }
            }
        }
#pragma unroll
        for (int ks = 0; ks < 4; ++ks) { float p[8];
#pragma unroll
            for (int j = 0; j < 8; ++j) p[j] = acc[ks][j] * inv - cur[ks][j];
            Bf[tbk][ks] = pack8(p); }
    }
    const bf16* Wg = WpT + (size_t)g * 4096;
#pragma unroll
    for (int db = 0; db < 2; ++db) {
        bf16x8 Af[4];
#pragma unroll
        for (int ks = 0; ks < 4; ++ks) Af[ks] = *(const GAS bf16x8*)(Wg + (size_t)(32 * db + c) * 64 + 16 * ks + 8 * hh);
#pragma unroll
        for (int tbk = 0; tbk < 2; ++tbk) {
            f32x16 dacc = {};
#pragma unroll
            for (int ks = 0; ks < 4; ++ks) dacc = __builtin_amdgcn_mfma_f32_32x32x16_bf16(Af[ks], Bf[tbk][ks], dacc, 0, 0, 0);
            bf16* op = MIX + (size_t)(tb + 32 * tbk + c) * D + g * 64 + 32 * db + 4 * hh;
            const float* sp = pscale + g * 64 + 32 * db + 4 * hh;
#pragma unroll
            for (int q = 0; q < 4; ++q) { const f32x4 sc = *(const f32x4*)(sp + 8 * q);
                u32x2v o; o.x = cvtpk(dacc[4 * q] * sc[0], dacc[4 * q + 1] * sc[1]); o.y = cvtpk(dacc[4 * q + 2] * sc[2], dacc[4 * q + 3] * sc[3]);
                *(GAS u32x2v*)(op + 8 * q) = o; }
        }
    }
}
__device__ __forceinline__ void gla_kv_task(const bf16* PROJ, const float* bgate, float* GKV, float* GDEC, int ck, int h, int lane) {
    const int d = lane & 31, hh = lane >> 5; const int tb = ck * CHUNK; const int b = ck / NCH, n = ck % NCH; const int bhn = (b * 4 + h) * NCH + n;
    const float bg = bgate[h * 32 + d];
    const bf16* Gp = PROJ + (size_t)tb * NP + C_GG + h * 32 + d;
    const bf16* Kp = PROJ + (size_t)tb * NP + C_GK + h * 32 + d;
    float bc[4][8], gt[4];
#pragma unroll
    for (int ks = 0; ks < 4; ++ks) { float run = 0.f;
#pragma unroll
        for (int j = 0; j < 8; ++j) { const int t = 16 * ks + 8 * hh + j; run += logsig(bf2f(Gp[(size_t)t * NP]) + bg) * (1.0f / 16.0f); bc[ks][j] = run; }
        gt[ks] = run; }
    float base = 0.f, blast;
    {
        float pt[4];
#pragma unroll
        for (int ks = 0; ks < 4; ++ks) pt[ks] = __shfl_xor(gt[ks], 32);
#pragma unroll
        for (int ks = 0; ks < 4; ++ks) { const float lo = hh ? pt[ks] : gt[ks], hi_ = hh ? gt[ks] : pt[ks];
            const float off = base + (hh ? lo : 0.f);
#pragma unroll
            for (int j = 0; j < 8; ++j) bc[ks][j] += off;
            base += lo + hi_; }
        blast = base;
    }
    bf16x8 Af[4];
#pragma unroll
    for (int ks = 0; ks < 4; ++ks) { float v[8];
#pragma unroll
        for (int j = 0; j < 8; ++j) { const int t = 16 * ks + 8 * hh + j; v[j] = bf2f(Kp[(size_t)t * NP]) * __expf(blast - bc[ks][j]); }
        Af[ks] = pack8(v); }
    const bf16* Vp = PROJ + (size_t)tb * NP + C_GV + h * 64 + d;
#pragma unroll
    for (int nb = 0; nb < 2; ++nb) {
        f32x16 dacc = {};
#pragma unroll
        for (int ks = 0; ks < 4; ++ks) { v4u w;
            unsigned short e[8];
#pragma unroll
            for (int j = 0; j < 8; ++j) e[j] = Vp[(size_t)(16 * ks + 8 * hh + j) * NP + 32 * nb];
            w.x = e[0] | ((unsigned)e[1] << 16); w.y = e[2] | ((unsigned)e[3] << 16); w.z = e[4] | ((unsigned)e[5] << 16); w.w = e[6] | ((unsigned)e[7] << 16);
            dacc = __builtin_amdgcn_mfma_f32_32x32x16_bf16(Af[ks], __builtin_bit_cast(bf16x8, w), dacc, 0, 0, 0); }
        float* op = GKV + ((size_t)bhn * 64 + 32 * nb + d) * 32 + 4 * hh;
#pragma unroll
        for (int q = 0; q < 4; ++q) *(GAS f32x4*)(op + 8 * q) = (f32x4){dacc[4 * q], dacc[4 * q + 1], dacc[4 * q + 2], dacc[4 * q + 3]};
    }
    if (hh == 0) GDEC[(size_t)bhn * 32 + d] = __expf(blast);
}
__device__ __forceinline__ void gla_scan(float* GKV, const float* GDEC, int gtid, int nthreads) {
    for (int id = gtid; id < BATCH * 4 * 2048; id += nthreads) {
        const int bh = id >> 11, ed = id & 2047;
        float* p = GKV + (size_t)bh * NCH * 2048 + ed; const float* dp = GDEC + (size_t)bh * NCH * 32 + (ed & 31);
        float s = 0.f;
#pragma unroll 1
        for (int n0 = 0; n0 < NCH; n0 += 16) {
            float kv[16], dc[16];
#pragma unroll
            for (int i = 0; i < 16; ++i) { kv[i] = p[(size_t)(n0 + i) * 2048]; dc[i] = dp[(n0 + i) * 32]; }
#pragma unroll
            for (int i = 0; i < 16; ++i) { p[(size_t)(n0 + i) * 2048] = s; s = s * dc[i] + kv[i]; }
        }
    }
}
__device__ __forceinline__ void gla_out_task(const bf16* PROJ, const float* bgate, const float* gnorm, const float* GKV, bf16* MIX, LAS float* scr, int ck, int h, int lane) {
    const int c = lane & 31, hh = lane >> 5; const int tb = ck * CHUNK; const int b = ck / NCH, n = ck % NCH; const int bhn = (b * 4 + h) * NCH + n;
    {
        const float bg = bgate[h * 32 + c];
        const bf16* Gp = PROJ + (size_t)(tb + 32 * hh) * NP + C_GG + h * 32 + c;
        float bc[32]; float run = 0.f;
#pragma unroll
        for (int i = 0; i < 32; ++i) { run += logsig(bf2f(Gp[(size_t)i * NP]) + bg) * (1.0f / 16.0f); bc[i] = run; }
        const float tot0 = __shfl(run, c);
        const float off = hh ? tot0 : 0.f;
#pragma unroll
        for (int i = 0; i < 32; ++i) scr[(32 * hh + i) * 33 + c] = bc[i] + off;
        LDS_WAIT(); asm volatile("" ::: "memory");
    }
    bf16x8 Qf[2][2], Kf[2][2];
    const float qs = 0.17677669529663687f;
#pragma unroll
    for (int tbk = 0; tbk < 2; ++tbk)
#pragma unroll
        for (int ks = 0; ks < 2; ++ks) { const int i = 32 * tbk + c, d0 = 16 * ks + 8 * hh;
            float q[8], k[8], qd[8], ki[8];
            unpack8(*(const GAS v4u*)(PROJ + (size_t)(tb + i) * NP + C_GQ + h * 32 + d0), q);
            unpack8(*(const GAS v4u*)(PROJ + (size_t)(tb + i) * NP + C_GK + h * 32 + d0), k);
#pragma unroll
            for (int j = 0; j < 8; ++j) { const float bcv = scr[i * 33 + d0 + j]; qd[j] = q[j] * qs * __expf(bcv); ki[j] = k[j] * __expf(-bcv); }
            Qf[tbk][ks] = pack8(qd); Kf[tbk][ks] = pack8(ki); }
    const bf16* Vp = PROJ + (size_t)tb * NP + C_GV + h * 64;
    const float* Sp = GKV + (size_t)bhn * 2048;
    const float* gn = gnorm + h * 64;
#pragma unroll
    for (int ib = 0; ib < 2; ++ib) {
        f32x16 o[2]; o[0] = f32x16{}; o[1] = f32x16{};
#pragma unroll
        for (int eb = 0; eb < 2; ++eb)
#pragma unroll
            for (int ks = 0; ks < 2; ++ks) { const float* sp = Sp + (size_t)(32 * eb + c) * 32 + 16 * ks + 8 * hh;
                const f32x4 s0 = *(const GAS f32x4*)sp, s1 = *(const GAS f32x4*)(sp + 4);
                const float sv[8] = {s0[0], s0[1], s0[2], s0[3], s1[0], s1[1], s1[2], s1[3]};
                o[eb] = __builtin_amdgcn_mfma_f32_32x32x16_bf16(pack8(sv), Qf[ib][ks], o[eb], 0, 0, 0); }
#pragma unroll
        for (int jb = 0; jb <= ib; ++jb) {
            f32x16 at = {};
#pragma unroll
            for (int ks = 0; ks < 2; ++ks) at = __builtin_amdgcn_mfma_f32_32x32x16_bf16(Kf[jb][ks], Qf[ib][ks], at, 0, 0, 0);
            if (jb == ib) {
#pragma unroll
                for (int r = 0; r < 16; ++r) if (crow(r, hh) > c) at[r] = 0.f;
            }
#pragma unroll
            for (int s = 0; s < 2; ++s) {
                float pv_[8];
#pragma unroll
                for (int jj = 0; jj < 8; ++jj) pv_[jj] = at[8 * s + jj];
                const bf16x8 Pf = pack8(pv_);
#pragma unroll
                for (int eb = 0; eb < 2; ++eb) { unsigned short e[8];
#pragma unroll
                    for (int jj = 0; jj < 8; ++jj) { const int j = 32 * jb + 16 * s + 8 * (jj >> 2) + 4 * hh + (jj & 3); e[jj] = Vp[(size_t)j * NP + 32 * eb + c]; }
                    v4u w; w.x = e[0] | ((unsigned)e[1] << 16); w.y = e[2] | ((unsigned)e[3] << 16); w.z = e[4] | ((unsigned)e[5] << 16); w.w = e[6] | ((unsigned)e[7] << 16);
                    o[eb] = __builtin_amdgcn_mfma_f32_32x32x16_bf16(__builtin_bit_cast(bf16x8, w), Pf, o[eb], 0, 0, 0); }
            }
        }
        float ssq = 0.f;
#pragma unroll
        for (int eb = 0; eb < 2; ++eb)
#pragma unroll
            for (int r = 0; r < 16; ++r) ssq += o[eb][r] * o[eb][r];
        ssq += __shfl_xor(ssq, 32);
        const float rstd = __builtin_amdgcn_rsqf(ssq * (1.0f / 64.0f) + EPS);
        const int tok = tb + 32 * ib + c;
        const bf16* rp = PROJ + (size_t)tok * NP + C_GR + h * 64 + 4 * hh;
        bf16* op = MIX + (size_t)tok * D + 768 + h * 64 + 4 * hh;
#pragma unroll
        for (int eb = 0; eb < 2; ++eb)
#pragma unroll
            for (int q = 0; q < 4; ++q) { const int e0 = 32 * eb + 8 * q;
                const u32x2v rw = *(const GAS u32x2v*)(rp + e0); const f32x4 g4 = *(const f32x4*)(gn + e0 + 4 * hh);
                const float rg[4] = {__uint_as_float(rw.x << 16), __uint_as_float(rw.x & 0xffff0000u), __uint_as_float(rw.y << 16), __uint_as_float(rw.y & 0xffff0000u)};
                float y[4];
#pragma unroll
                for (int k = 0; k < 4; ++k) { const float sil = rg[k] / (1.f + __expf(-rg[k])); y[k] = o[eb][4 * q + k] * rstd * g4[k] * sil; }
                u32x2v ow; ow.x = cvtpk(y[0], y[1]); ow.y = cvtpk(y[2], y[3]); *(GAS u32x2v*)(op + e0) = ow; }
    }
    LDS_WAIT(); asm volatile("" ::: "memory");
}
__device__ __forceinline__ void diff_fin_row(const bf16* OATT, const float* dng, bf16* MIX, int tok, float lam, float oml, int lane) {
    const int hd = lane >> 4, e0 = (lane & 15) * 8;
    float a1[8], a2[8], a[8];
    unpack8(*(const GAS v4u*)(OATT + (size_t)tok * D + hd * 256 + e0), a1);
    unpack8(*(const GAS v4u*)(OATT + (size_t)tok * D + hd * 256 + 128 + e0), a2);
    float ss = 0.f;
#pragma unroll
    for (int j = 0; j < 8; ++j) { a[j] = a1[j] - lam * a2[j]; ss += a[j] * a[j]; }
    ss += __shfl_xor(ss, 1); ss += __shfl_xor(ss, 2); ss += __shfl_xor(ss, 4); ss += __shfl_xor(ss, 8);
    const float rstd = __builtin_amdgcn_rsqf(ss * (1.0f / 128.0f) + EPS) * oml;
    const f32x4 g0 = *(const f32x4*)(dng + hd * 128 + e0), g1 = *(const f32x4*)(dng + hd * 128 + e0 + 4);
    float y[8];
#pragma unroll
    for (int j = 0; j < 4; ++j) { y[j] = a[j] * rstd * g0[j]; y[4 + j] = a[4 + j] * rstd * g1[j]; }
    *(GAS bf16x8*)(MIX + (size_t)tok * D + 256 + hd * 128 + e0) = pack8(y);
}
__device__ __forceinline__ void final_norm_row(float* row, const float* g, int lane) {
    GAS f32x4* xr = (GAS f32x4*)row + lane;
    f32x4 v[4]; float s2 = 0.f;
#pragma unroll
    for (int j = 0; j < 4; ++j) { v[j] = xr[64 * j]; s2 += (v[j].x * v[j].x + v[j].y * v[j].y) + (v[j].z * v[j].z + v[j].w * v[j].w); }
    const float rstd = __builtin_amdgcn_rsqf(wave_sum(s2) * (1.0f / D) + EPS);
#pragma unroll
    for (int j = 0; j < 4; ++j) { const f32x4 gg = *((const f32x4*)g + lane + 64 * j); xr[64 * j] = v[j] * rstd * gg; }
}

constexpr int PH_PER_LAYER = 7, N_PHASES = 1 + DEPTH * PH_PER_LAYER + 1;
struct Args { const float* in[18]; float* out; unsigned char* ws; int ph_lo, ph_hi; };
__global__ void __launch_bounds__(NWAVES * 64, 2) fwd_kernel(Args args) {
    extern __shared__ __attribute__((aligned(16))) unsigned char lds[];
    Frame F;
    F.lds = (LAS unsigned char*)lds;
    F.MISC = (volatile LAS unsigned*)(F.lds + MISC_OFF);
    F.tid = threadIdx.x; F.lane = F.tid & 63; F.wave = __builtin_amdgcn_readfirstlane(F.tid >> 6);
    F.G = gridDim.x; { const int bx = blockIdx.x; F.vcu = (F.G % 8 == 0) ? (bx % 8) * (F.G / 8) + bx / 8 : bx; }
    unsigned char* ws = args.ws;
    F.ctl = (gu32*)(ws + WS_CTL);
    Inputs I;
    I.x = args.in[0]; I.norm1_g = args.in[1]; I.w_in = args.in[2]; I.pool_w = args.in[3]; I.pool_scale = args.in[4]; I.lq1 = args.in[5]; I.lk1 = args.in[6]; I.lq2 = args.in[7]; I.lk2 = args.in[8];
    I.diff_norm_g = args.in[9]; I.w_gate2 = args.in[10]; I.b_gate = args.in[11]; I.gla_norm_g = args.in[12]; I.w_out = args.in[13]; I.norm2_g = args.in[14]; I.w_mlp1 = args.in[15]; I.w_mlp2 = args.in[16]; I.final_g = args.in[17];
    for (int u = F.tid; u < (LDS_BYTES - LDSCTL_OFF) / 4; u += NWAVES * 64) ((LAS unsigned*)(F.lds + LDSCTL_OFF))[u] = 0u;
    __syncthreads();
    XcdBarrier bar; bar.bar = (unsigned*)(F.ctl + CW_BAR); bar.x = 0; bar.st = nullptr;
    if (!MK_PER_PHASE) bar = xcd_barrier_post((unsigned*)(F.ctl + CW_BAR), F.MISC + 8);
#define GRID_BAR() do { if (!MK_PER_PHASE) xcd_barrier(bar); } while (0)
    const int lo = args.ph_lo, hi = args.ph_hi;
#define IN(k) (lo <= (k) && (k) < hi)
#define BOTH(k) (IN(k) && IN((k) + 1))
    bf16* const HB = (bf16*)(ws + WS_HB); bf16* const PROJ = (bf16*)(ws + WS_PROJ); bf16* const OATT = (bf16*)(ws + WS_OATT); bf16* const MIX = (bf16*)(ws + WS_MIX); bf16* const HID = (bf16*)(ws + WS_HID);
    float* const SSA = (float*)(ws + WS_SSA); float* const SSB = (float*)(ws + WS_SSB); float* const GKV = (float*)(ws + WS_GKV); float* const GDEC = (float*)(ws + WS_GDEC);
#define REFRESH() do { int t_ = threadIdx.x; asm volatile("" : "+v"(t_)); F.tid = t_; F.lane = t_ & 63; F.wave = __builtin_amdgcn_readfirstlane(t_ >> 6); } while (0)
    const int NGW = F.G * NWAVES;

    if (PHON(0) && IN(0)) { p0_prologue(F, I, ws); if (BOTH(0)) GRID_BAR(); }

#pragma unroll 1
    for (int l = 0; l < DEPTH; ++l) {
        const int pb = 1 + l * PH_PER_LAYER;
        unsigned char* wl = ws + WS_W + (size_t)l * W_LAYER;
        const float lambda_init = (l == 0) ? 0.2f : 0.35550906759096927f;
        if (PHON(1) && IN(pb + 0)) {
            pg8::Gemm g{HB, (const bf16*)(wl + WO_IN), M, NP, D}; pg8::StaticOrder S; S.init(M, NP, F.G, (int)blockIdx.x);
            pg8::EpiRs<0> E{PROJ, NP, SSB, EPS, 1, 3, attn_body::C2};
            pg8::gemm_phase<pg8::EpiRs<0>, pg8::StaticOrder, true, true>(F.lds + RING_OFF, g, S, E);
            if (BOTH(pb + 0)) GRID_BAR();
        }
        if (PHON(2) && IN(pb + 1)) {
            REFRESH();
            for (int ck = F.vcu; ck < M / CHUNK; ck += F.G) {
                if (F.wave < 4) pool_task(PROJ, (const bf16*)(ws + WS_WPOOL) + (size_t)l * 4 * 4096, I.pool_scale + l * 256, MIX, ck, F.wave, F.lane);
                else gla_kv_task(PROJ, I.b_gate + l * 128, GKV, GDEC, ck, F.wave - 4, F.lane);
            }
            if (BOTH(pb + 1)) GRID_BAR();
        }
        if (PHON(3) && IN(pb + 2)) {
            REFRESH();
            if (F.tid < 256) gla_scan(GKV, GDEC, F.vcu * 256 + F.tid, F.G * 256);
            __syncthreads();
            const attn_body::AttnTensors AT{(const attn_body::bf16*)PROJ, (attn_body::bf16*)OATT};
            const attn_body::StaticOrder S((int)F.G, (int)blockIdx.x);
            attn_body::attn_phase<attn_body::StaticOrder>((char*)lds + RING_OFF, AT, S, C_DQ, C_DK, C_DV);
            if (BOTH(pb + 2)) GRID_BAR();
        }
        if (PHON(4) && IN(pb + 3)) {
            REFRESH(); const int gw = F.vcu * NWAVES + F.wave;
            LAS float* scr = (LAS float*)(F.lds + RING_OFF + F.wave * 12288);
            for (int c2 = F.vcu; c2 < M / CHUNK / 2; c2 += F.G)
                gla_out_task(PROJ, I.b_gate + l * 128, I.gla_norm_g + l * 256, GKV, MIX, scr, 2 * c2 + (F.wave >> 2), F.wave & 3, F.lane);
            const float s1 = wave_sum(I.lq1[l * 64 + F.lane] * I.lk1[l * 64 + F.lane]), s2 = wave_sum(I.lq2[l * 64 + F.lane] * I.lk2[l * 64 + F.lane]);
            const float lam = __expf(s1) - __expf(s2) + lambda_init;
            for (int tok = gw; tok < M; tok += NGW) diff_fin_row(OATT, I.diff_norm_g + l * 512, MIX, tok, lam, 1.0f - lambda_init, F.lane);
            if (BOTH(pb + 3)) GRID_BAR();
        }
        if (PHON(5) && IN(pb + 4)) {
            pg8::Gemm g{MIX, (const bf16*)(wl + WO_OUT), M, D, D}; pg8::StaticOrder S; S.init(M, D, F.G, (int)blockIdx.x);
            pg8::EpiRes E{(l == 0) ? I.x : (const float*)args.out, args.out, HB, SSA, D};
            pg8::gemm_phase<pg8::EpiRes, pg8::StaticOrder, true, true>(F.lds + RING_OFF, g, S, E);
            if (BOTH(pb + 4)) GRID_BAR();
        }
        if (PHON(6) && IN(pb + 5)) {
            pg8::Gemm g{HB, (const bf16*)(wl + WO_1), M, FF, D}; pg8::StaticOrder S; S.init(M, FF, F.G, (int)blockIdx.x);
            pg8::EpiRs<2> E{HID, FF, SSA, EPS, 0, 0, 1.f};
            pg8::gemm_phase<pg8::EpiRs<2>, pg8::StaticOrder, true, true>(F.lds + RING_OFF, g, S, E);
            if (BOTH(pb + 5)) GRID_BAR();
        }
        if (PHON(7) && IN(pb + 6)) {
            pg8::Gemm g{HID, (const bf16*)(wl + WO_2), M, D, FF}; pg8::StaticOrder S; S.init(M, D, F.G, (int)blockIdx.x);
            pg8::EpiRes E{(const float*)args.out, args.out, HB, SSB, D};
            pg8::gemm_phase<pg8::EpiRes, pg8::StaticOrder, true, true>(F.lds + RING_OFF, g, S, E);
            if (BOTH(pb + 6)) GRID_BAR();
        }
    }
    if (PHON(8) && IN(N_PHASES - 1)) { REFRESH(); const int gw = F.vcu * NWAVES + F.wave; for (int m = gw; m < M; m += NGW) final_norm_row(args.out + (size_t)m * D, I.final_g, F.lane); }
#undef IN
#undef BOTH
#undef GRID_BAR
#undef REFRESH
}

extern "C" void kernel_launch(void* const* d_in, const int* in_sizes, int n_in, void* d_out, int out_size, void* d_ws, size_t ws_size, hipStream_t stream) {
    static int grid = 0;
    if (grid == 0) {
        if (n_in != 18 || in_sizes[0] != M * D || out_size != M * D || ws_size < WS_END) { fprintf(stderr, "kernel_launch: unexpected shapes: n_in %d, in0 %d, out %d, ws %zu (need %zu); nothing launched\n", n_in, n_in > 0 ? in_sizes[0] : -1, out_size, ws_size, (size_t)WS_END); grid = -1; return; }
        int dev = 0, cus = 0, per_cu = 0;
        if (hipGetDevice(&dev) != hipSuccess || hipDeviceGetAttribute(&cus, hipDeviceAttributeMultiprocessorCount, dev) != hipSuccess) { grid = -1; return; }
        if (hipFuncSetAttribute((const void*)fwd_kernel, hipFuncAttributeMaxDynamicSharedMemorySize, LDS_BYTES) != hipSuccess) { fprintf(stderr, "kernel_launch: hipFuncSetAttribute failed\n"); grid = -1; return; }
        if (hipOccupancyMaxActiveBlocksPerMultiprocessor(&per_cu, (const void*)fwd_kernel, NWAVES * 64, LDS_BYTES) != hipSuccess || per_cu < 1) { fprintf(stderr, "kernel_launch: occupancy query reports %d workgroups per CU\n", per_cu); }
        (void)hipGetLastError();
        grid = cus;
    }
    if (grid < 0) return;
    if (hipMemsetAsync((char*)d_ws + WS_CTL, 0, CTL_ZERO_BYTES, stream) != hipSuccess) return;
    Args a{};
    for (int i = 0; i < 18; ++i) a.in[i] = (const float*)d_in[i];
    a.out = (float*)d_out; a.ws = (unsigned char*)d_ws;
#if MK_PER_PHASE
    for (int p = 0; p < N_PHASES; ++p) { a.ph_lo = p; a.ph_hi = p + 1; hipLaunchKernelGGL(fwd_kernel, dim3(grid), dim3(NWAVES * 64), LDS_BYTES, stream, a); }
#else
    a.ph_lo = 0; a.ph_hi = N_PHASES;
    hipLaunchKernelGGL(fwd_kernel, dim3(grid), dim3(NWAVES * 64), LDS_BYTES, stream, a);
#endif
}
```

```cpp
#include <hip/hip_runtime.h>
#include <cstdio>
#include <cstdint>
namespace pg8 {
#define PG8_LAS __attribute__((address_space(3)))
typedef unsigned short bf16_t;
typedef short bf16x8 __attribute__((ext_vector_type(8)));
typedef float f32x4 __attribute__((ext_vector_type(4)));
typedef unsigned u32x4 __attribute__((ext_vector_type(4)));
constexpr int BM = 256, BK = 64, HALF = 128, HTB = HALF * BK * 2  , STAGE_BYTES = 8 * HTB, NXCD = 8, WGM = 8;

__host__ __device__ __forceinline__ int lds_byte(int r, int c) { const int st = (r >> 4) * 2 + (c >> 5), rr = r & 15, cc = c & 31, ob = rr * 64 + cc * 2; return st * 1024 + (ob ^ (((ob >> 9) & 1) << 5)); }
__host__ __device__ __forceinline__ void stage_rc(int b, int& R, int& C) { const int st = b / 1024, sb = b % 1024, swz = sb ^ (((sb >> 9) & 1) << 5); R = (st >> 1) * 16 + swz / 64; C = (st & 1) * 32 + (swz % 64) / 2; }
__host__ __device__ __forceinline__ int perm32(int rho) { const int n = rho >> 4, i = rho & 15; return 8 * (i >> 2) + 4 * n + (i & 3); }

struct Unit { int pm, pn; };
struct Gemm { const bf16_t* A; const bf16_t* Bt; int M, N, K; };

struct StaticOrder {
    int nM, nN, nwg, G, c;
    __host__ __device__ void init(int M, int N, int G_, int c_) { nM = M / BM; nN = N / BM; nwg = nM * nN; G = G_; c = c_; }
    __host__ __device__ bool next(int i, Unit& u) const {
        const long L = (long)i * G + c; if (L >= nwg) return false;
        int wgid = (int)L; { const int q = nwg / NXCD, r = nwg % NXCD, xcd = wgid % NXCD, off = wgid / NXCD; wgid = (xcd < r ? xcd * (q + 1) : r * (q + 1) + (xcd - r) * q) + off; }
        const int nig = WGM * nN, gid = wgid / nig, fm = gid * WGM, gsz = (nM - fm) < WGM ? (nM - fm) : WGM;
        u.pm = fm + ((wgid % nig) % gsz); u.pn = (wgid % nig) / gsz; return true;
    }
    __device__ __forceinline__ void a_ready(const Unit&) const {}
    __device__ __forceinline__ void done(const Unit&) const {}
};
struct BatchOrder {
    int nN, nwg, G, c;
    __host__ __device__ void init(int Mb, int N, int G_, int c_) { nN = N / BM; nwg = (Mb / BM) * nN; G = G_; c = c_; }
    __host__ __device__ bool next(int i, Unit& u) const {
        const int L = i * G + c; if (L >= nwg) return false;
        const int nig = WGM * nN, gid = (L >= nig) + (L >= 2 * nig) + (L >= 3 * nig), w = L - gid * nig;
        u.pm = gid * WGM + (w & (WGM - 1)); u.pn = w >> 3; return true;
    }
    __device__ __forceinline__ void a_ready(const Unit&) const {}
    __device__ __forceinline__ void done(const Unit&) const {}
};

__device__ __forceinline__ unsigned cvt_pk_bf16(float lo, float hi) { unsigned r; asm volatile("v_cvt_pk_bf16_f32 %0, %1, %2" : "=v"(r) : "v"(lo), "v"(hi)); return r; }
typedef float f32x2 __attribute__((ext_vector_type(2)));
typedef float f32x2 __attribute__((ext_vector_type(2)));
typedef unsigned u32x2 __attribute__((ext_vector_type(2)));
__device__ __forceinline__ float row_rs(const float* ss, int row, int fq, float eps) {
    const f32x4 p = *(const f32x4*)(ss + (size_t)row * 16 + fq * 4);
    float s = (p[0] + p[1]) + (p[2] + p[3]);
    s += __shfl_xor(s, 16); s += __shfl_xor(s, 32);
    return __builtin_amdgcn_rsqf(s * (1.0f / 1024.0f) + eps);
}
template <int ACT> struct EpiRs {
    static constexpr bool PERM = true, AFTER_DRAIN = false;
    bf16_t* O; int ldc; const PG8_LAS float* rst; const float* ss; int sc_lo, sc_hi; float tile_scale;
    __device__ __forceinline__ void operator()(const f32x4 (&acc)[2][2][4][2], const Unit& u, int ui, int wr, int wc, int fr, int fq) const {
        const int row0 = u.pm * BM + wr * 64 + fr; const int col0 = u.pn * BM + wc * 32 + 8 * fq;
        const float sc = (u.pn >= sc_lo && u.pn < sc_hi) ? tile_scale : 1.f;
        float rs[2][4];
#pragma unroll
        for (int ai = 0; ai < 2; ++ai)
#pragma unroll
            for (int m = 0; m < 4; ++m) rs[ai][m] = ((ui < 16) ? rst[ui * BM + wr * 64 + fr + ai * HALF + m * 16] : row_rs(ss, row0 + ai * HALF + m * 16, fq, 1e-6f)) * sc;
#pragma unroll
        for (int ai = 0; ai < 2; ++ai)
#pragma unroll
            for (int m = 0; m < 4; ++m) { bf16_t* rowp = O + (size_t)(row0 + ai * HALF + m * 16) * ldc + col0; const float r = rs[ai][m];
#pragma unroll
                for (int bj = 0; bj < 2; ++bj) { f32x4 v0 = acc[ai][bj][m][0] * r, v1 = acc[ai][bj][m][1] * r;
                    if (ACT == 2) {
#pragma unroll
                        for (int e = 0; e < 4; ++e) { const float a = __builtin_fmaxf(v0[e], 0.f), b = __builtin_fmaxf(v1[e], 0.f); v0[e] = a * a; v1[e] = b * b; } }
                    u32x4 w; w.x = cvt_pk_bf16(v0[0], v0[1]); w.y = cvt_pk_bf16(v0[2], v0[3]); w.z = cvt_pk_bf16(v1[0], v1[1]); w.w = cvt_pk_bf16(v1[2], v1[3]);
                    __builtin_nontemporal_store(w, (u32x4*)(rowp + bj * HALF)); } }
    }
};
struct EpiRes {
    static constexpr bool PERM = true, AFTER_DRAIN = false;
    bf16_t* hb; float* ss; int ldc;
    __device__ __forceinline__ void operator()(const f32x4 (&acc)[2][2][4][2], const Unit& u, int ui, int wr, int wc, int fr, int fq) const {
        const int row0 = u.pm * BM + wr * 64 + fr; const int col0 = u.pn * BM + wc * 32 + 8 * fq;
        u32x4 b[2][4][2];
#pragma unroll
        for (int ai = 0; ai < 2; ++ai)
#pragma unroll
            for (int m = 0; m < 4; ++m)
#pragma unroll
                for (int bj = 0; bj < 2; ++bj) b[ai][m][bj] = *(const u32x4*)(hb + (size_t)(row0 + ai * HALF + m * 16) * ldc + col0 + bj * HALF);
#pragma unroll
        for (int ai = 0; ai < 2; ++ai)
#pragma unroll
            for (int m = 0; m < 4; ++m) { const int row = row0 + ai * HALF + m * 16; bf16_t* rowp = hb + (size_t)row * ldc + col0; float sq = 0.f;
#pragma unroll
                for (int bj = 0; bj < 2; ++bj) { const u32x4 bb = b[ai][m][bj];
                    f32x4 o0, o1;
                    o0[0] = __uint_as_float(bb.x << 16) + acc[ai][bj][m][0][0]; o0[1] = __uint_as_float(bb.x & 0xffff0000u) + acc[ai][bj][m][0][1];
                    o0[2] = __uint_as_float(bb.y << 16) + acc[ai][bj][m][0][2]; o0[3] = __uint_as_float(bb.y & 0xffff0000u) + acc[ai][bj][m][0][3];
                    o1[0] = __uint_as_float(bb.z << 16) + acc[ai][bj][m][1][0]; o1[1] = __uint_as_float(bb.z & 0xffff0000u) + acc[ai][bj][m][1][1];
                    o1[2] = __uint_as_float(bb.w << 16) + acc[ai][bj][m][1][2]; o1[3] = __uint_as_float(bb.w & 0xffff0000u) + acc[ai][bj][m][1][3];
                    u32x4 w; w.x = cvt_pk_bf16(o0[0], o0[1]); w.y = cvt_pk_bf16(o0[2], o0[3]); w.z = cvt_pk_bf16(o1[0], o1[1]); w.w = cvt_pk_bf16(o1[2], o1[3]);
                    *(u32x4*)(rowp + bj * HALF) = w;
                    sq += ((o0[0] * o0[0] + o0[1] * o0[1]) + (o0[2] * o0[2] + o0[3] * o0[3])) + ((o1[0] * o1[0] + o1[1] * o1[1]) + (o1[2] * o1[2] + o1[3] * o1[3])); }
                sq += __shfl_xor(sq, 16); sq += __shfl_xor(sq, 32);
                if (fq == 0) ss[(size_t)row * 16 + u.pn * 4 + wc] = sq; }
    }
};
template <class Epi, class Sched, bool ALIGN_EPI = false, bool SP2 = false>
__device__ __forceinline__ void gemm_phase(PG8_LAS unsigned char* lds, const Gemm g, const Sched& S, const Epi& E) {
    int tid_ = threadIdx.x; asm volatile("" : "+v"(tid_));
    const int tid = tid_, wid = __builtin_amdgcn_readfirstlane(tid >> 6), lane = tid & 63, wr = wid >> 2, wc = wid & 3, fr = lane & 15, fq = lane >> 4;
    const int K = g.K, nt = K / BK;
    unsigned voffA[2], voffB[2];
#pragma unroll
    for (int i = 0; i < 2; ++i) { int R, C; stage_rc(tid * 16 + i * 8192, R, C); const int Rb = Epi::PERM ? ((R & ~31) + perm32(R & 31)) : R;
        voffA[i] = (unsigned)(R * K + C) * 2u; voffB[i] = (unsigned)(Rb * K + C) * 2u; }
    const size_t kstep = (size_t)(BK * 2);
    const size_t hstep = (size_t)HALF * K * 2;
    const size_t tstep = 2 * hstep;
    const unsigned ldsw = (unsigned)wid * 1024u;
    const int aoff = lds_byte(wr * 64 + fr, fq * 8), boff = lds_byte(wc * 32 + fr, fq * 8);
#define PG8_SA(b, h) (((b) * 2 + (h)) * HTB)
#define PG8_SB(b, h) ((4 + (b) * 2 + (h)) * HTB)
#define PG8_STAGE(bufoff, gbase, voff) do { _Pragma("unroll") for (int _i = 0; _i < 2; ++_i) \
        __builtin_amdgcn_global_load_lds((const unsigned*)((const char*)(gbase) + (voff)[_i]), (PG8_LAS unsigned*)(lds + (bufoff) + ldsw + _i * 8192), 16, 0, 0); } while (0)
#define PG8_LDA(dst, b, h) do { _Pragma("unroll") for (int m = 0; m < 4; ++m) _Pragma("unroll") for (int k = 0; k < 2; ++k) dst[m][k] = *(const PG8_LAS bf16x8*)(lds + PG8_SA(b, h) + aoff + m * 2048 + k * 1024); } while (0)
#define PG8_LDB(dst, b, h) do { _Pragma("unroll") for (int n = 0; n < 2; ++n) _Pragma("unroll") for (int k = 0; k < 2; ++k) dst[n][k] = *(const PG8_LAS bf16x8*)(lds + PG8_SB(b, h) + boff + n * 2048 + k * 1024); } while (0)
#define PG8_MMA(ai, bj, At, Bt) do { __builtin_amdgcn_s_setprio(1); _Pragma("unroll") for (int m = 0; m < 4; ++m) _Pragma("unroll") for (int n = 0; n < 2; ++n) _Pragma("unroll") for (int k = 0; k < 2; ++k) \
        acc[ai][bj][m][n] = __builtin_amdgcn_mfma_f32_16x16x32_bf16(Bt[n][k], At[m][k], acc[ai][bj][m][n], 0, 0, 0); __builtin_amdgcn_s_setprio(0); } while (0)
#define PG8_WAIT_V(n) asm volatile("s_waitcnt vmcnt(" #n ")" ::: "memory")
#define PG8_WAIT_L(n) asm volatile("s_waitcnt lgkmcnt(" #n ")" ::: "memory")
#define PG8_BAR __builtin_amdgcn_s_barrier()
#define PG8_SCHED __builtin_amdgcn_sched_barrier(0)
    Unit cur, nxt; int ui = 0;
    if (!S.next(0, cur)) return;
    f32x4 acc[2][2][4][2];
#pragma unroll
    for (int a = 0; a < 2; ++a)
#pragma unroll
        for (int b = 0; b < 2; ++b)
#pragma unroll
            for (int m = 0; m < 4; ++m)
#pragma unroll
                for (int n = 0; n < 2; ++n) acc[a][b][m][n] = (f32x4){0.f, 0.f, 0.f, 0.f};
    bf16x8 At[4][2], B0[2][2], B1[2][2];
    const char* cA = (const char*)g.A + (size_t)cur.pm * tstep; const char* cB = (const char*)g.Bt + (size_t)cur.pn * tstep;
    S.a_ready(cur);
    if constexpr (SP2) {
        PG8_STAGE(PG8_SB(0, 0), cB, voffB); PG8_STAGE(PG8_SB(0, 1), cB + hstep, voffB); PG8_STAGE(PG8_SA(0, 0), cA, voffA); PG8_STAGE(PG8_SA(0, 1), cA + hstep, voffA);
        if (wr == 1) PG8_BAR;
        PG8_WAIT_V(2); PG8_BAR;
        PG8_STAGE(PG8_SB(1, 0), cB + kstep, voffB); PG8_STAGE(PG8_SA(1, 0), cA + kstep, voffA); PG8_STAGE(PG8_SB(1, 1), cB + hstep + kstep, voffB);
        PG8_WAIT_V(6); PG8_BAR;
    } else {
        PG8_STAGE(PG8_SB(0, 0), cB, voffB); PG8_STAGE(PG8_SA(0, 0), cA, voffA); PG8_STAGE(PG8_SB(0, 1), cB + hstep, voffB); PG8_STAGE(PG8_SA(0, 1), cA + hstep, voffA);
        if (wr == 1) PG8_BAR;
        PG8_WAIT_V(4); PG8_BAR;
        PG8_STAGE(PG8_SB(1, 0), cB + kstep, voffB); PG8_STAGE(PG8_SA(1, 0), cA + kstep, voffA); PG8_STAGE(PG8_SB(1, 1), cB + hstep + kstep, voffB);
        PG8_WAIT_V(6); PG8_BAR;
    }
    for (;;) {
        const bool has_next = S.next(ui + 1, nxt);
        const char* nA = has_next ? (const char*)g.A + (size_t)nxt.pm * tstep : cA; const char* nB = has_next ? (const char*)g.Bt + (size_t)nxt.pn * tstep : cB;
        for (int t = 0; t < nt; t += 2) {
            const bool last = (t == nt - 2);
            const char* a1 = cA + (size_t)(t + 1) * kstep;
            const char* a2 = last ? nA : cA + (size_t)(t + 2) * kstep; const char* b2 = last ? nB : cB + (size_t)(t + 2) * kstep;
            const char* a3 = a2 + kstep; const char* b3 = b2 + kstep;
            if (last && has_next) S.a_ready(nxt);
            if constexpr (SP2) {
            PG8_LDB(B0, 0, 0); PG8_LDB(B1, 0, 1); PG8_SCHED; PG8_LDA(At, 0, 0); PG8_STAGE(PG8_SA(1, 1), a1 + hstep, voffA);
            PG8_WAIT_V(8); PG8_WAIT_L(0); PG8_BAR; PG8_MMA(0, 0, At, B0); PG8_MMA(0, 1, At, B1); PG8_BAR; PG8_SCHED;
            PG8_LDA(At, 0, 1); PG8_STAGE(PG8_SB(0, 0), b2, voffB); PG8_STAGE(PG8_SB(0, 1), b2 + hstep, voffB); PG8_STAGE(PG8_SA(0, 0), a2, voffA);
            PG8_WAIT_V(8); PG8_WAIT_L(0); PG8_BAR; PG8_MMA(1, 0, At, B0); PG8_MMA(1, 1, At, B1); PG8_BAR; PG8_SCHED;
            PG8_LDB(B0, 1, 0); PG8_LDB(B1, 1, 1); PG8_SCHED; PG8_LDA(At, 1, 0); PG8_STAGE(PG8_SA(0, 1), a2 + hstep, voffA);
            PG8_WAIT_V(8); PG8_WAIT_L(0); PG8_BAR; PG8_MMA(0, 0, At, B0); PG8_MMA(0, 1, At, B1); PG8_BAR; PG8_SCHED;
            PG8_LDA(At, 1, 1); PG8_STAGE(PG8_SB(1, 0), b3, voffB); PG8_STAGE(PG8_SB(1, 1), b3 + hstep, voffB); PG8_STAGE(PG8_SA(1, 0), a3, voffA);
            PG8_WAIT_V(8); PG8_WAIT_L(0); PG8_BAR; PG8_MMA(1, 0, At, B0); PG8_MMA(1, 1, At, B1); PG8_BAR; PG8_SCHED;
            } else {
            PG8_LDB(B0, 0, 0); PG8_SCHED; PG8_LDA(At, 0, 0); PG8_STAGE(PG8_SA(1, 1), a1 + hstep, voffA);
            PG8_WAIT_L(8); PG8_BAR; PG8_WAIT_L(0); PG8_MMA(0, 0, At, B0); PG8_BAR; PG8_SCHED;
            PG8_LDB(B1, 0, 1); PG8_STAGE(PG8_SB(0, 0), b2, voffB);
            PG8_BAR; PG8_WAIT_L(0); PG8_MMA(0, 1, At, B1); PG8_BAR;
            PG8_LDA(At, 0, 1); PG8_STAGE(PG8_SA(0, 0), a2, voffA);
            PG8_BAR; PG8_WAIT_L(0); PG8_MMA(1, 0, At, B0); PG8_BAR; PG8_SCHED;
            PG8_STAGE(PG8_SB(0, 1), b2 + hstep, voffB);
            PG8_WAIT_V(6); PG8_BAR; PG8_MMA(1, 1, At, B1); PG8_BAR;
            PG8_LDB(B0, 1, 0); PG8_SCHED; PG8_LDA(At, 1, 0); PG8_STAGE(PG8_SA(0, 1), a2 + hstep, voffA);
            PG8_WAIT_L(8); PG8_BAR; PG8_WAIT_L(0); PG8_MMA(0, 0, At, B0); PG8_BAR; PG8_SCHED;
            PG8_LDB(B1, 1, 1); PG8_STAGE(PG8_SB(1, 0), b3, voffB);
            PG8_BAR; PG8_WAIT_L(0); PG8_MMA(0, 1, At, B1); PG8_BAR;
            PG8_LDA(At, 1, 1); PG8_STAGE(PG8_SA(1, 0), a3, voffA);
            PG8_BAR; PG8_WAIT_L(0); PG8_MMA(1, 0, At, B0); PG8_BAR; PG8_SCHED;
            PG8_STAGE(PG8_SB(1, 1), b3 + hstep, voffB);
            PG8_WAIT_V(6); PG8_BAR; PG8_MMA(1, 1, At, B1); PG8_BAR;
            }
        }
        if constexpr (ALIGN_EPI) { if (wr == 0) PG8_BAR; }
        if constexpr (!Epi::AFTER_DRAIN) { E(acc, cur, ui, wr, wc, fr, fq); S.done(cur); }
        if (!has_next) break;
#pragma unroll
        for (int a = 0; a < 2; ++a)
#pragma unroll
            for (int b = 0; b < 2; ++b)
#pragma unroll
                for (int m = 0; m < 4; ++m)
#pragma unroll
                    for (int n = 0; n < 2; ++n) acc[a][b][m][n] = (f32x4){0.f, 0.f, 0.f, 0.f};
        cur = nxt; cA = nA; cB = nB; ++ui;
        if constexpr (ALIGN_EPI) { if (wr == 1) PG8_BAR; }
    }
    PG8_WAIT_V(0);
    if constexpr (!ALIGN_EPI) { if (wr == 0) PG8_BAR; }
    PG8_BAR;
    if constexpr (Epi::AFTER_DRAIN) { E.fused(acc, cur, wr, wc, fr, fq, lds, wid, lane); S.done(cur); }
#undef PG8_SA
#undef PG8_SB
#undef PG8_STAGE
#undef PG8_LDA
#undef PG8_LDB
#undef PG8_MMA
#undef PG8_WAIT_V
#undef PG8_WAIT_L
#undef PG8_BAR
#undef PG8_SCHED
}
}

#ifndef PG8_SP2
#define PG8_SP2 true
#endif
#ifndef PG8_ALIGN
#define PG8_ALIGN true
#endif
namespace attn2 {
using bf16 = unsigned short;
typedef short bf16x8 __attribute__((ext_vector_type(8)));
typedef short s16x4 __attribute__((ext_vector_type(4)));
typedef float f32x16 __attribute__((ext_vector_type(16)));
typedef unsigned u32x4 __attribute__((ext_vector_type(4)));
constexpr int SEQ = 8192, DQ = 64, DV = 128, PIN = 2816, POUT = 1024;
constexpr int NW = 8, QBLK = 32, KVBLK = 64, QB = NW * QBLK;
constexpr int SHM_V = KVBLK * DV * 2, SHM_K = KVBLK * DQ * 2;
constexpr int LDS_BYTES = 2 * SHM_V + 2 * SHM_K + NW * 64 * 4;
#ifndef A2_ILV
#define A2_ILV 1
#endif
constexpr float THR = 8.f;
constexpr float C2 = 0.125f * 1.4426950408889634f;
#define A2_KSWZ(row, colB) ((row) * 128 + ((colB) ^ ((((row) >> 1) & 7) << 4)))
#define A2_SBAR() __builtin_amdgcn_sched_barrier(0)
__device__ __forceinline__ int v_rd_base(int lane) { return ((lane & 3) << 3) | (((lane >> 2) & 3) << 6) | (((lane >> 4) & 1) << 5) | (((lane >> 5) & 1) << 8); }
constexpr int v_rd_off(int d0, int ks, int half) { return d0 * 512 + ks * 4096 + half * 2048; }
__device__ __forceinline__ int crow(int r, int hi) { return (r & 3) + 8 * (r >> 2) + 4 * hi; }
typedef float f32x2_a __attribute__((ext_vector_type(2))); typedef __bf16 bf16x2_a __attribute__((ext_vector_type(2)));
__device__ __forceinline__ unsigned cvtpk(float lo, float hi) { f32x2_a v = {lo, hi}; bf16x2_a b = __builtin_convertvector(v, bf16x2_a); return __builtin_bit_cast(unsigned, b); }
typedef short v4i16_t __attribute__((ext_vector_type(4)));
typedef __attribute__((address_space(3))) const char* lds_cptr;
__device__ __forceinline__ s16x4 vtr(lds_cptr p) { return __builtin_bit_cast(s16x4, __builtin_amdgcn_ds_read_tr16_b64_v4i16((__attribute__((address_space(3))) v4i16_t*)p)); }
template <int VB>
__device__ __forceinline__ void pv_tile(f32x16* o, int vb0, bf16x8 pa0, bf16x8 pa1, bf16x8 pa2, bf16x8 pa3, bool act) {
    if (!act) return;
#define A2_TRRD(dst, off) asm volatile("ds_read_b64_tr_b16 %0, %1 offset:%2" : "=&v"(dst) : "v"(vb0), "i"(off) : "memory")
#define A2_PV_D0(d0) do { s16x4 l0, l1, l2, l3, h0, h1, h2, h3; constexpr int b_ = VB * SHM_V + v_rd_off(d0, 0, 0); \
        A2_TRRD(l0, b_); A2_TRRD(h0, b_ + 2048); A2_TRRD(l1, b_ + 4096); A2_TRRD(h1, b_ + 6144); A2_TRRD(l2, b_ + 8192); A2_TRRD(h2, b_ + 10240); A2_TRRD(l3, b_ + 12288); A2_TRRD(h3, b_ + 14336); \
        asm volatile("s_waitcnt lgkmcnt(0)" ::: "memory"); A2_SBAR();   \
        o[d0] = __builtin_amdgcn_mfma_f32_32x32x16_bf16(pa0, (bf16x8){l0[0], l0[1], l0[2], l0[3], h0[0], h0[1], h0[2], h0[3]}, o[d0], 0, 0, 0);   \
        o[d0] = __builtin_amdgcn_mfma_f32_32x32x16_bf16(pa1, (bf16x8){l1[0], l1[1], l1[2], l1[3], h1[0], h1[1], h1[2], h1[3]}, o[d0], 0, 0, 0);   \
        o[d0] = __builtin_amdgcn_mfma_f32_32x32x16_bf16(pa2, (bf16x8){l2[0], l2[1], l2[2], l2[3], h2[0], h2[1], h2[2], h2[3]}, o[d0], 0, 0, 0);   \
        o[d0] = __builtin_amdgcn_mfma_f32_32x32x16_bf16(pa3, (bf16x8){l3[0], l3[1], l3[2], l3[3], h3[0], h3[1], h3[2], h3[3]}, o[d0], 0, 0, 0); } while (0)
    A2_PV_D0(0); A2_PV_D0(1); A2_PV_D0(2); A2_PV_D0(3);
#undef A2_PV_D0
#undef A2_TRRD
}
struct BlockRef { const bf16* Q; const bf16* K; const bf16* V; bf16* O; int P0; };
__device__ __forceinline__ BlockRef unit_ref(int r, int nloc, int i, const bf16* P, bf16* O, int cq, int ck, int cv) {
    int hm, qb;
    if (nloc == 32) { const int s = r & 7, hs = i >> 2, k = i & 3; hm = (r >> 3) + 4 * hs; qb = (k == 0) ? s : (k == 1) ? 15 - s : (k == 2) ? 16 + s : 31 - s; }
    else { const int u = r + i * nloc; hm = u & 7; qb = 31 - (u >> 3); }
    const int m = hm & 1, h = hm >> 1;
    BlockRef rf; rf.Q = P + (size_t)qb * QB * PIN + cq + (2 * h + m) * 64; rf.K = P + ck + (2 * h + m) * 64; rf.V = P + cv + h * 128;
    rf.O = O + (size_t)qb * QB * POUT + h * 256 + m * 128; rf.P0 = qb * QB; return rf;
}
template <int KB>
__device__ __forceinline__ void qkt_rel(f32x16& p0, f32x16& p1, const char* K_lds, int r32, int hi, const bf16x8* qr, const f32x16& negm, bool act) {
    if (!act) { const float NEG = -__builtin_inff();
#pragma unroll
        for (int r = 0; r < 16; ++r) { p0[r] = NEG; p1[r] = NEG; } return; }
#pragma unroll
    for (int d0 = 0; d0 < 4; ++d0) { const char* a = K_lds + KB * SHM_K + A2_KSWZ(r32, (d0 * 16 + hi * 8) * 2);
        bf16x8 b0 = *reinterpret_cast<const bf16x8*>(a);
        bf16x8 b1 = *reinterpret_cast<const bf16x8*>(a + 32 * 128);
        if (d0 == 0) { p0 = __builtin_amdgcn_mfma_f32_32x32x16_bf16(b0, qr[0], negm, 0, 0, 0); p1 = __builtin_amdgcn_mfma_f32_32x32x16_bf16(b1, qr[0], negm, 0, 0, 0); }
        else { p0 = __builtin_amdgcn_mfma_f32_32x32x16_bf16(b0, qr[d0], p0, 0, 0, 0); p1 = __builtin_amdgcn_mfma_f32_32x32x16_bf16(b1, qr[d0], p1, 0, 0, 0); } }
}
__device__ __forceinline__ void partialSM_rel(f32x16& p0, f32x16& p1, float& mhat, f32x16& negm, float& alpha, bool first) {
    float pmax = p0[0];
#pragma unroll
    for (int r = 1; r < 16; ++r) pmax = fmaxf(pmax, p0[r]);
#pragma unroll
    for (int r = 0; r < 16; ++r) pmax = fmaxf(pmax, p1[r]);
    { auto rr = __builtin_amdgcn_permlane32_swap(__float_as_uint(pmax), __float_as_uint(pmax), false, false);
      pmax = fmaxf(__uint_as_float(rr[0]), __uint_as_float(rr[1])); }
    alpha = 1.f;
    if (first || __any(pmax > THR)) { const float dl = first ? pmax : fmaxf(pmax, 0.f); mhat += dl;
#pragma unroll
        for (int r = 0; r < 16; ++r) { p0[r] -= dl; p1[r] -= dl; }
#pragma unroll
        for (int r = 0; r < 16; ++r) negm[r] = -mhat;
        asm volatile("" : "+v"(negm));
        if (!first) alpha = __builtin_amdgcn_exp2f(-dl); }
#pragma unroll
    for (int r = 0; r < 16; ++r) p0[r] = __builtin_amdgcn_exp2f(p0[r]);
}
typedef float f32x2_s __attribute__((ext_vector_type(2)));
__device__ __forceinline__ void finishSM2(f32x16& p0, f32x16& p1, float alpha, float& l_reg, bf16x8& pa0, bf16x8& pa1, bf16x8& pa2, bf16x8& pa3) {
#pragma unroll
    for (int r = 0; r < 16; ++r) p1[r] = __builtin_amdgcn_exp2f(p1[r]);
    f32x2_s sa = {p0[0], p0[1]}, sb = {p0[2], p0[3]};
#pragma unroll
    for (int r = 4; r < 16; r += 4) { sa += (f32x2_s){p0[r], p0[r + 1]}; sb += (f32x2_s){p0[r + 2], p0[r + 3]}; }
#pragma unroll
    for (int r = 0; r < 16; r += 4) { sa += (f32x2_s){p1[r], p1[r + 1]}; sb += (f32x2_s){p1[r + 2], p1[r + 3]}; }
    sa += sb; float ps = sa[0] + sa[1];
    { auto rr = __builtin_amdgcn_permlane32_swap(__float_as_uint(ps), __float_as_uint(ps), false, false);
      ps = __uint_as_float(rr[0]) + __uint_as_float(rr[1]); }
    l_reg = l_reg * alpha + ps;
#define A2_PK4(P, B_, OUT) do { u32x4 w = {cvtpk(P[B_+0], P[B_+1]), cvtpk(P[B_+2], P[B_+3]), cvtpk(P[B_+4], P[B_+5]), cvtpk(P[B_+6], P[B_+7])}; OUT = *reinterpret_cast<bf16x8*>(&w); } while (0)
    A2_PK4(p0, 0, pa0); A2_PK4(p0, 8, pa1); A2_PK4(p1, 0, pa2); A2_PK4(p1, 8, pa3);
#undef A2_PK4
}
constexpr int R_V = 0, R_K = 3 * SHM_V, R_WS = R_K + 3 * SHM_K, LDS3_BYTES = R_WS + NW * 64 * 4;
typedef __attribute__((address_space(3))) unsigned char* lds_ptr;
#define A3_WAITBAR(N) asm volatile("s_waitcnt vmcnt(" #N ") lgkmcnt(0)\n\ts_barrier" ::: "memory")
struct Dma { const bf16* ks; const bf16* va; const bf16* vb; };
__device__ __forceinline__ Dma dma_src(const bf16* Kh, const bf16* Vh, int wid, int lane) {
    Dma d;
    { const int p = wid * 64 + lane, row = p >> 3, slot = p & 7, c = slot ^ ((row >> 1) & 7); d.ks = Kh + (size_t)row * PIN + c * 8; }
#pragma unroll
    for (int j = 0; j < 2; ++j) { const int st = (2 * wid + j) * 2 + (lane >> 5), kk = (st >> 2) * 8 + ((lane & 31) >> 2), c = (st & 3) * 32 + (lane & 3) * 8;
        const int key = kk;
        const bf16* p_ = Vh + (size_t)key * PIN + c; if (j == 0) d.va = p_; else d.vb = p_; }
    return d;
}
__device__ __forceinline__ void glds16(const void* gsrc, unsigned lds_dst) { unsigned keep;
    asm volatile("s_mov_b32 %0, m0\n\ts_mov_b32 m0, %2\n\ts_nop 0\n\tglobal_load_lds_dwordx4 %1, off\n\ts_mov_b32 m0, %0" : "=&s"(keep) : "v"(gsrc), "s"(lds_dst) : "memory"); }
#define A3_DMA_K(D, t, slot) glds16((D).ks + (size_t)(t) * KVBLK * PIN, (unsigned)__builtin_amdgcn_readfirstlane(lds0 + R_K + (slot) * SHM_K + wid * 1024))
#define A3_DMA_V(D, t, slot) do { glds16((D).va + (size_t)(t) * KVBLK * PIN, (unsigned)__builtin_amdgcn_readfirstlane(lds0 + R_V + (slot) * SHM_V + wid * 2048)); \
                                  glds16((D).vb + (size_t)(t) * KVBLK * PIN, (unsigned)__builtin_amdgcn_readfirstlane(lds0 + R_V + (slot) * SHM_V + wid * 2048 + 1024)); } while (0)
struct Seam3 { bf16x8 qr[4]; };
__device__ __forceinline__ void prime3(const BlockRef& cur, char* lds, Seam3& S) {
    int tid_ = threadIdx.x; asm volatile("" : "+v"(tid_));
    const int tid = tid_, wid = __builtin_amdgcn_readfirstlane(tid >> 6), lane = tid & 63, r32 = lane & 31, hi = lane >> 5;
    const unsigned lds0 = (unsigned)(uintptr_t)lds;
    const Dma D = dma_src(cur.K, cur.V, wid, lane);
    A3_DMA_K(D, 0, 0); A3_DMA_K(D, 1, 1); A2_SBAR();
#pragma unroll
    for (int d0 = 0; d0 < 4; ++d0) S.qr[d0] = *(const bf16x8*)(cur.Q + (size_t)(wid * QBLK + r32) * PIN + d0 * 16 + hi * 8);
    A2_SBAR();
    A3_WAITBAR(5);
    A3_DMA_V(D, 0, 0);
}
__device__ __forceinline__ void block3(const BlockRef& cur, const BlockRef& nxt, char* lds, Seam3& S) {
    int tid_ = threadIdx.x; asm volatile("" : "+v"(tid_));
    const int tid = tid_, wid = __builtin_amdgcn_readfirstlane(tid >> 6), lane = tid & 63, r32 = lane & 31, hi = lane >> 5;
    const int NT = (cur.P0 + QB) / KVBLK;
    const int wchunk = (cur.P0 + wid * QBLK) >> 6;
    const unsigned lds0 = (unsigned)(uintptr_t)lds;
    char* V_lds = lds + R_V; char* K_lds = lds + R_K;
    float* ws = (float*)(lds + R_WS) + wid * 64; float* li_l = ws, * al_l = ws + 32;
    float mhat = 0.f, l_reg = 0; f32x16 o[4] = {}; f32x16 negm = {}; asm volatile("" : "+v"(negm));
    const int vb0 = (int)(uintptr_t)V_lds + v_rd_base(lane);
    const lds_cptr vb3 = (lds_cptr)V_lds + v_rd_base(lane);
    const Dma D = dma_src(cur.K, cur.V, wid, lane);
    int s0 = 0, s1 = 1, s2 = 2;
#define A3_ROT() do { const int t_ = s0; s0 = s1; s1 = s2; s2 = t_; } while (0)
#define A2_RESC(a) do { if (__any((a) < 1.f)) { if (hi == 0) al_l[r32] = (a); asm volatile("s_waitcnt lgkmcnt(0)" ::: "memory");              \
                     _Pragma("unroll") for (int d_ = 0; d_ < 4; ++d_) _Pragma("unroll") for (int r = 0; r < 16; ++r) o[d_][r] *= al_l[crow(r, hi)]; } } while (0)
#define A2_ACT(t) ((t) <= wchunk)
    f32x16 pA0, pA1, pB0, pB1; float mnA, mnB, alA, alB; bf16x8 pa0, pa1, pa2, pa3;
    A2_SBAR(); qkt_rel<0>(pA0, pA1, K_lds, r32, hi, S.qr, negm, true);
    A3_DMA_K(D, 2, 2); A3_DMA_V(D, 1, 1);
    partialSM_rel(pA0, pA1, mhat, negm, alA, true);
    A2_SBAR(); A3_WAITBAR(3);
#define A2_VFR(i) (bf16x8){vl[(i) & 3][0], vl[(i) & 3][1], vl[(i) & 3][2], vl[(i) & 3][3], vh[(i) & 3][0], vh[(i) & 3][1], vh[(i) & 3][2], vh[(i) & 3][3]}
#define A2_VRD(i, VBP) do { vl[(i) & 3] = vtr((VBP) + ((i) & 3) * 512 + ((i) >> 2) * 4096); vh[(i) & 3] = vtr((VBP) + ((i) & 3) * 512 + ((i) >> 2) * 4096 + 2048); } while (0)
#define A2_PAK(i) (((i) >> 2) == 0 ? pa0 : ((i) >> 2) == 1 ? pa1 : ((i) >> 2) == 2 ? pa2 : pa3)
#define A2_GAP(i, PX0, PX1, mnX, alX, VBP) do {                                                                               \
        if ((i) + 2 < 16) A2_VRD((i) + 2, VBP);                                                                               \
        o[(i) & 3] = __builtin_amdgcn_mfma_f32_32x32x16_bf16(A2_PAK(i), A2_VFR(i), o[(i) & 3], 0, 0, 0);                     \
        if ((i) < 4) { const int j_ = 4 * (i);                                                                               \
            if ((i) == 0) { mxa = __builtin_fmaxf(PX0[0], PX0[1]); mxb = __builtin_fmaxf(PX0[2], PX0[3]); }                  \
            else { mxa = __builtin_fmaxf(__builtin_fmaxf(mxa, PX0[j_]), PX0[j_ + 1]); mxb = __builtin_fmaxf(__builtin_fmaxf(mxb, PX0[j_ + 2]), PX0[j_ + 3]); } \
            mxa = __builtin_fmaxf(__builtin_fmaxf(mxa, PX1[j_]), PX1[j_ + 1]); mxb = __builtin_fmaxf(__builtin_fmaxf(mxb, PX1[j_ + 2]), PX1[j_ + 3]);         \
            asm volatile("" : "+v"(mxa), "+v"(mxb)); }                                                                       \
        else if ((i) == 4) { float pmax = __builtin_fmaxf(mxa, mxb);                                                         \
            { auto rr = __builtin_amdgcn_permlane32_swap(__float_as_uint(pmax), __float_as_uint(pmax), false, false); pmax = __builtin_fmaxf(__uint_as_float(rr[0]), __uint_as_float(rr[1])); } \
            alX = 1.f;                                                                                                       \
            if (__builtin_expect(__any(pmax > THR), 0)) { const float dl_ = __builtin_fmaxf(pmax, 0.f); mhat += dl_;          \
                _Pragma("unroll") for (int r_ = 0; r_ < 16; ++r_) { PX0[r_] -= dl_; PX1[r_] -= dl_; }                         \
                _Pragma("unroll") for (int r_ = 0; r_ < 16; ++r_) negm[r_] = -mhat;                                           \
                asm volatile("" : "+v"(negm)); alX = __builtin_amdgcn_exp2f(-dl_); }                                          \
            asm volatile("" : "+v"(alX), "+v"(PX0), "+v"(PX1)); }                                                            \
        else if ((i) < 13) { const int k_ = 2 * ((i) - 5);                                                                   \
            PX0[k_] = __builtin_amdgcn_exp2f(PX0[k_]); PX0[k_ + 1] = __builtin_amdgcn_exp2f(PX0[k_ + 1]);                     \
            asm volatile("" : "+v"(PX0)); }                                                                                  \
        A2_SBAR(); } while (0)
#define A2_PVSM(PX0, PX1, mnX, alX, VBP) do { s16x4 vl[4], vh[4]; float mxa, mxb;                                             \
        A2_VRD(0, VBP); A2_VRD(1, VBP); A2_SBAR();                                                                             \
        A2_GAP(0, PX0, PX1, mnX, alX, VBP); A2_GAP(1, PX0, PX1, mnX, alX, VBP); A2_GAP(2, PX0, PX1, mnX, alX, VBP); A2_GAP(3, PX0, PX1, mnX, alX, VBP);       \
        A2_GAP(4, PX0, PX1, mnX, alX, VBP); A2_GAP(5, PX0, PX1, mnX, alX, VBP); A2_GAP(6, PX0, PX1, mnX, alX, VBP); A2_GAP(7, PX0, PX1, mnX, alX, VBP);       \
        A2_GAP(8, PX0, PX1, mnX, alX, VBP); A2_GAP(9, PX0, PX1, mnX, alX, VBP); A2_GAP(10, PX0, PX1, mnX, alX, VBP); A2_GAP(11, PX0, PX1, mnX, alX, VBP);     \
        A2_GAP(12, PX0, PX1, mnX, alX, VBP); A2_GAP(13, PX0, PX1, mnX, alX, VBP); A2_GAP(14, PX0, PX1, mnX, alX, VBP); A2_GAP(15, PX0, PX1, mnX, alX, VBP);   \
    } while (0)
#define A2_SG(mask, n) __builtin_amdgcn_sched_group_barrier(mask, n, 0)
#define A3_FAST_STEP(PX0, PX1, mnX, alX, PY0, PY1, alY, t) do {                                                      \
        A2_SBAR(); qkt_rel<0>(PX0, PX1, K_lds + s1 * SHM_K, r32, hi, S.qr, negm, true);                                             \
        finishSM2(PY0, PY1, alY, l_reg, pa0, pa1, pa2, pa3);                                                           \
        A3_DMA_K(D, (t) + 2, s0); A3_DMA_V(D, (t) + 1, s2);                                               \
        asm volatile("" : "+v"(pa0), "+v"(pa1), "+v"(pa2), "+v"(pa3), "+v"(l_reg)); asm volatile("" : "+v"(PX0), "+v"(PX1));         \
        A2_SG(0x100, 4); _Pragma("unroll") for (int g_ = 0; g_ < 8; ++g_) { A2_SG(0x008, 1); A2_SG(0x002, 5); A2_SG(0x400, 2); A2_SG(0x100, 1); }      \
        A2_SBAR();                                                                                                            \
        { const lds_cptr vbs_ = vb3 + s0 * SHM_V; A2_PVSM(PX0, PX1, mnX, alX, vbs_); }                                        \
        A2_SBAR(); A2_RESC(alX);                                                                                              \
        A3_WAITBAR(3); A3_ROT(); } while (0)
#define A3_BAND_STEP(PX0, PX1, mnX, alX, PY0, PY1, alY, t) do {                                                      \
        f32x16 cn_ = negm; if (!A2_ACT(t)) { _Pragma("unroll") for (int r_ = 0; r_ < 16; ++r_) cn_[r_] = -__builtin_inff(); }   \
        A2_SBAR(); qkt_rel<0>(PX0, PX1, K_lds + s1 * SHM_K, r32, hi, S.qr, cn_, true);                                             \
        finishSM2(PY0, PY1, alY, l_reg, pa0, pa1, pa2, pa3);                                                           \
        if ((t) + 2 < NT) A3_DMA_K(D, (t) + 2, s0);                                                                           \
        if ((t) + 1 < NT) A3_DMA_V(D, (t) + 1, s2);                                                                           \
        asm volatile("" : "+v"(pa0), "+v"(pa1), "+v"(pa2), "+v"(pa3), "+v"(l_reg)); asm volatile("" : "+v"(PX0), "+v"(PX1));         \
        A2_SBAR();                                                                                                            \
        { const lds_cptr vbs_ = vb3 + s0 * SHM_V; A2_PVSM(PX0, PX1, mnX, alX, vbs_); }                                        \
        A2_SBAR(); A2_RESC(alX);                                                                                              \
        if ((t) + 2 < NT) A3_WAITBAR(3); else if ((t) + 1 < NT) A3_WAITBAR(2); else A3_WAITBAR(0);                            \
        A3_ROT(); } while (0)
    int t = 1;
    for (; t + 1 < NT - 4; t += 2) {
        A3_FAST_STEP(pB0, pB1, mnB, alB, pA0, pA1, alA, t);
        A3_FAST_STEP(pA0, pA1, mnA, alA, pB0, pB1, alB, t + 1);
    }
    for (; t + 1 < NT; t += 2) {
        A3_BAND_STEP(pB0, pB1, mnB, alB, pA0, pA1, alA, t);
        A3_BAND_STEP(pA0, pA1, mnA, alA, pB0, pB1, alB, t + 1);
    }
    A2_SBAR(); qkt_rel<0>(pB0, pB1, K_lds + s1 * SHM_K, r32, hi, S.qr, negm, A2_ACT(NT - 1));
    finishSM2(pA0, pA1, alA, l_reg, pa0, pa1, pa2, pa3); A2_SBAR();
    pv_tile<0>(o, vb0 + s0 * SHM_V, pa0, pa1, pa2, pa3, A2_ACT(NT - 2)); partialSM_rel(pB0, pB1, mhat, negm, alB, false);
    A2_SBAR(); A2_RESC(alB);
    A3_WAITBAR(0);
    const Dma Dn = dma_src(nxt.K, nxt.V, wid, lane);
    A3_DMA_K(Dn, 0, 0); A3_DMA_K(Dn, 1, 1); A2_SBAR();
#pragma unroll
    for (int d0 = 0; d0 < 4; ++d0) S.qr[d0] = *(const bf16x8*)(nxt.Q + (size_t)(wid * QBLK + r32) * PIN + d0 * 16 + hi * 8);
    A2_SBAR();
    finishSM2(pB0, pB1, alB, l_reg, pa0, pa1, pa2, pa3); A2_SBAR(); pv_tile<0>(o, vb0 + s1 * SHM_V, pa0, pa1, pa2, pa3, A2_ACT(NT - 1));
    A2_SBAR();
    if (hi == 0) li_l[r32] = l_reg; asm volatile("s_waitcnt lgkmcnt(0)" ::: "memory");
    float rli[16];
#pragma unroll
    for (int r = 0; r < 16; ++r) rli[r] = __builtin_amdgcn_rcpf(li_l[crow(r, hi)]);
    A2_SBAR();
    asm volatile("s_waitcnt vmcnt(5)" ::: "memory");
    A2_SBAR();
    bf16* Ow = cur.O + (size_t)(wid * QBLK) * POUT;
#pragma unroll
    for (int r = 0; r < 16; ++r) { const int orow = crow(r, hi);
#pragma unroll
        for (int d0 = 0; d0 < 4; ++d0) { const float v = o[d0][r] * rli[r];
            const float vn = __shfl_xor(v, 1);
            if ((r32 & 1) == 0) *(unsigned*)(Ow + (size_t)orow * POUT + d0 * 32 + r32) = cvtpk(v, vn); } }
    A2_SBAR();
    asm volatile("s_waitcnt lgkmcnt(0)\n\ts_barrier" ::: "memory");
    A3_DMA_V(Dn, 0, 0);
#undef A3_ROT
#undef A2_RESC
#undef A2_ACT
#undef A2_VFR
#undef A2_VRD
#undef A2_PAK
#undef A2_GAP
#undef A2_PVSM
#undef A2_SG
#undef A3_FAST_STEP
#undef A3_BAND_STEP
}
__device__ __forceinline__ void attn_phase3(char* lds, const bf16* P, bf16* O, int r, int nloc, int cq, int ck, int cv) {
    int nun = 8; if (nloc != 32) { nun = 0; for (int u_ = r; u_ < 256; u_ += nloc) ++nun; }
    if (nun > 0) {
        Seam3 S; BlockRef cur = unit_ref(r, nloc, 0, P, O, cq, ck, cv);
        prime3(cur, lds, S);
        for (int i = 0; i < nun; ++i) { const BlockRef nxt = (i + 1 < nun) ? unit_ref(r, nloc, i + 1, P, O, cq, ck, cv) : cur;
            block3(cur, nxt, lds, S); cur = nxt; }
    }
    asm volatile("s_waitcnt vmcnt(0)\n\ts_barrier" ::: "memory");
}
#undef A2_KSWZ
#undef A2_SBAR
#undef A2_VMW
#undef A2_VMWN
#undef A2_SLOAD
#undef A2_SWRITE_K
#undef A2_SWRITE_V
}
#define GAS __attribute__((address_space(1)))
#define LAS __attribute__((address_space(3)))
typedef unsigned short bf16;
typedef unsigned v4u __attribute__((ext_vector_type(4)));
typedef float f32x4 __attribute__((ext_vector_type(4)));
typedef short bf16x8 __attribute__((ext_vector_type(8)));
typedef GAS unsigned gu32;
typedef GAS unsigned long long gu64;
#define RLX_AGENT __ATOMIC_RELAXED, __HIP_MEMORY_SCOPE_AGENT
#define LDS_WAIT() asm volatile("s_waitcnt lgkmcnt(0)" ::: "memory")
#define VM_WAIT() asm volatile("s_waitcnt vmcnt(0)" ::: "memory")
__device__ __forceinline__ unsigned long long rt() { return __builtin_amdgcn_s_memrealtime(); }
__device__ __forceinline__ unsigned f2bf(float f) { unsigned u = __builtin_bit_cast(unsigned, f); return (u + 0x7fffu + ((u >> 16) & 1u)) >> 16; }
__device__ __forceinline__ unsigned pk2(float lo, float hi) { return f2bf(lo) | (f2bf(hi) << 16); }

#define XB_TMO      128
#define XB_XCNT(j)  (256  + 64 * (j))
#define XB_XSUB(j)  (1280 + 64 * (j))
#define XB_XGEN(j)  (2304 + 64 * (j))
#define XB_TOP      3328
#define XB_TOPGEN   3392
#define XCD_BAR_WORDS 3456
#define XB_SPIN_CAP (1u << 18)

__device__ __forceinline__ unsigned xb_ld(unsigned* p)              { return __hip_atomic_load(p, __ATOMIC_RELAXED, __HIP_MEMORY_SCOPE_AGENT); }
__device__ __forceinline__ unsigned xb_add(unsigned* p, unsigned v) { return __hip_atomic_fetch_add(p, v, __ATOMIC_RELAXED, __HIP_MEMORY_SCOPE_AGENT); }
__device__ __forceinline__ unsigned xb_xcc_id() { return (unsigned)__builtin_amdgcn_s_getreg((3 << 11) | 20) & 0xFu; }
#define XB_SPIN(cond, bar) do { unsigned _sp = 0; while (cond) { __builtin_amdgcn_s_sleep(1); \
    if ((++_sp & 255u) == 0u) { if (xb_ld(&(bar)[XB_TMO])) break; if (_sp > XB_SPIN_CAP) { atomicAdd(&(bar)[XB_TMO], 1u); break; } } } } while (0)

struct XcdBarrier {
    unsigned* bar; unsigned x;
    volatile LAS unsigned* st;
};

__device__ __forceinline__ XcdBarrier xcd_barrier_post(unsigned* bar, volatile LAS unsigned* st) {
    XcdBarrier b; b.bar = bar; b.x = xb_xcc_id(); b.st = st;
    if (threadIdx.x == 0) (void)xb_add(&bar[XB_XCNT(b.x)], 1u);
    return b;
}
__device__ __forceinline__ void xcd_barrier_complete(unsigned* bar, unsigned x, unsigned& nloc, unsigned& nx) {
    const unsigned G = gridDim.x * gridDim.y * gridDim.z;
    unsigned sum, cnt, mine, sp = 0u;
    for (;;) {
        sum = 0u; cnt = 0u; mine = 0u;
#pragma unroll
        for (unsigned j = 0; j < 16; ++j) { const unsigned c = xb_ld(&bar[XB_XCNT(j)]); sum += c; cnt += (c > 0u) ? 1u : 0u; mine = (j == x) ? c : mine; }
        if (sum == G) break;
        __builtin_amdgcn_s_sleep(1);
        if ((++sp & 255u) == 0u) { if (xb_ld(&bar[XB_TMO])) break; if (sp > XB_SPIN_CAP) { atomicAdd(&bar[XB_TMO], 1u); break; } }
    }
    nloc = mine > 0u ? mine : 1u; nx = cnt > 0u ? cnt : 1u;
}

__device__ __forceinline__ void xcd_barrier(const XcdBarrier& b) {
    asm volatile("s_waitcnt vmcnt(0)" ::: "memory");
    __syncthreads();
    if (threadIdx.x == 0) {
        unsigned* bar = b.bar;
        __builtin_amdgcn_s_waitcnt(0);
        unsigned nloc = b.st[0], nx = b.st[1];
        if (nloc == 0u) { xcd_barrier_complete(bar, b.x, nloc, nx); b.st[0] = nloc; b.st[1] = nx; }
        const unsigned old = xb_add(&bar[XB_XSUB(b.x)], 1u);
        const unsigned gen = old / nloc;
        if (old + 1u == (gen + 1u) * nloc) {
            __builtin_amdgcn_fence(__ATOMIC_RELEASE, "agent");
            asm volatile("s_waitcnt vmcnt(0)" ::: "memory");
            const unsigned og = xb_add(&bar[XB_TOP], 1u);
            const unsigned tg = og / nx;
            if (og + 1u == (tg + 1u) * nx) xb_add(&bar[XB_TOPGEN], 1u);
            else XB_SPIN(xb_ld(&bar[XB_TOPGEN]) == tg, bar);
            __builtin_amdgcn_fence(__ATOMIC_ACQUIRE, "agent");
            xb_add(&bar[XB_XGEN(b.x)], 1u);
            asm volatile("s_waitcnt vmcnt(0)" ::: "memory");
        } else {
            XB_SPIN(xb_ld(&bar[XB_XGEN(b.x)]) == gen, bar);
            __builtin_amdgcn_fence(__ATOMIC_ACQUIRE, "agent");
            asm volatile("s_waitcnt vmcnt(0)" ::: "memory");
        }
    }
    __syncthreads();
}

constexpr int NWAVES = 8;

constexpr int BATCH = 8, SEQ = 8192, D = 1024, FF = 4096, DEPTH = 2;
constexpr int M = BATCH * SEQ;
constexpr int CHUNK = 64, NCH = SEQ / CHUNK;
constexpr int NP_SRC = 2576;
constexpr int NP = 2816;
constexpr int C_POOL = 0, C_DQ = 256, C_DK = 768, C_DV = 1280, C_GQ = 1792, C_GK = 1920, C_GV = 2048, C_GR = 2304, C_GG = 2560;
constexpr float EPS = 1e-6f;
static_assert(NP == attn2::PIN && D == attn2::POUT && attn2::LDS_BYTES <= 131072 && attn2::LDS3_BYTES <= 131072, "attention body geometry");

constexpr size_t MiB = 1u << 20;
constexpr size_t WS_CTL = 0, CTL_ZERO_BYTES = 1 * MiB;
constexpr size_t WS_WPOOL = 1 * MiB;
constexpr size_t WS_W = 2 * MiB, W_LAYER = 24 * MiB;
constexpr size_t WO_IN = 0, WO_OUT = 6 * MiB, WO_1 = 8 * MiB, WO_2 = 16 * MiB;
constexpr size_t WS_SSA = 50 * MiB, WS_SSB = 54 * MiB;
constexpr size_t WS_GDEC = 58 * MiB;
constexpr size_t WS_GKV = 60 * MiB;
constexpr size_t WS_HB = 96 * MiB;
constexpr size_t WS_REG = 224 * MiB, REG_B = 76 * MiB;
constexpr size_t RO_PROJ = 0, RO_OATT = 44 * MiB, RO_MIX = 60 * MiB, RO_HID = 0;
constexpr size_t WS_END = 832 * MiB;
static_assert(WS_W + DEPTH * W_LAYER <= WS_SSA && WS_GKV + (size_t)BATCH * 4 * NCH * 2048 * 4 <= WS_HB && WS_HB + (size_t)M * D * 2 <= WS_REG && (size_t)SEQ * NP * 2 <= RO_OATT && RO_OATT + (size_t)SEQ * D * 2 <= RO_MIX && RO_MIX + (size_t)SEQ * D * 2 <= REG_B && (size_t)SEQ * FF * 2 <= REG_B && WS_REG + BATCH * REG_B <= WS_END, "d_ws map");
constexpr int CW_TMO = 0, CW_CODE = 1;
constexpr int CW_BAR = 4096;

constexpr int RING_OFF = 0, RING_BYTES = 131072;
constexpr int LDSCTL_OFF = RING_BYTES, MISC_OFF = LDSCTL_OFF + 320;
constexpr int RST_OFF = MISC_OFF + 128, RST_MAXU = 16;
constexpr int LDS_BYTES = 155648;
static_assert(RST_OFF % 16 == 0 && RST_OFF + RST_MAXU * 256 * 4 <= LDS_BYTES, "LDS map");

#define XB_LSUB(j) (XCD_BAR_WORDS + 64 * (j))
#define XB_LGEN(j) (XCD_BAR_WORDS + 1024 + 64 * (j))
__device__ __forceinline__ void xcd_local_barrier(const XcdBarrier& b) {
    asm volatile("s_waitcnt vmcnt(0)" ::: "memory");
    __syncthreads();
    if (threadIdx.x == 0) {
        unsigned* bar = b.bar;
        __builtin_amdgcn_s_waitcnt(0);
        unsigned nloc = b.st[0]; if (nloc == 0u) nloc = 1u;
        const unsigned old = xb_add(&bar[XB_LSUB(b.x)], 1u);
        const unsigned gen = old / nloc;
        if (old + 1u == (gen + 1u) * nloc) xb_add(&bar[XB_LGEN(b.x)], 1u);
        else XB_SPIN(xb_ld(&bar[XB_LGEN(b.x)]) == gen, bar);
        __builtin_amdgcn_fence(__ATOMIC_ACQUIRE, "agent");
        asm volatile("s_waitcnt vmcnt(0)" ::: "memory");
    }
    __syncthreads();
}
struct Frame {
    LAS unsigned char* lds;
    volatile LAS unsigned* MISC;
    gu32* ctl;
    int tid, lane, wave;
    int vcu, G;
};
typedef float f32x16 __attribute__((ext_vector_type(16)));
typedef unsigned u32x2v __attribute__((ext_vector_type(2)));
__device__ __forceinline__ float wave_sum(float v) {
#pragma unroll
    for (int o = 1; o < 64; o <<= 1) v += __shfl_xor(v, o);
    return v;
}
__device__ __forceinline__ float bf2f(unsigned short b) { return __uint_as_float((unsigned)b << 16); }
typedef float f32x2_c __attribute__((ext_vector_type(2))); typedef __bf16 bf16x2_c __attribute__((ext_vector_type(2)));
__device__ __forceinline__ unsigned cvtpk(float lo, float hi) { f32x2_c v = {lo, hi}; bf16x2_c b = __builtin_convertvector(v, bf16x2_c); return __builtin_bit_cast(unsigned, b); }
__device__ __forceinline__ bf16x8 pack8(const float (&v)[8]) { v4u w; w.x = cvtpk(v[0], v[1]); w.y = cvtpk(v[2], v[3]); w.z = cvtpk(v[4], v[5]); w.w = cvtpk(v[6], v[7]); return __builtin_bit_cast(bf16x8, w); }
__device__ __forceinline__ void unpack8(v4u w, float (&v)[8]) {
    v[0] = __uint_as_float(w.x << 16); v[1] = __uint_as_float(w.x & 0xffff0000u); v[2] = __uint_as_float(w.y << 16); v[3] = __uint_as_float(w.y & 0xffff0000u);
    v[4] = __uint_as_float(w.z << 16); v[5] = __uint_as_float(w.z & 0xffff0000u); v[6] = __uint_as_float(w.w << 16); v[7] = __uint_as_float(w.w & 0xffff0000u); }
__device__ __forceinline__ int crow(int r, int hi) { return (r & 3) + 8 * (r >> 2) + 4 * hi; }
__device__ __forceinline__ float logsig(float x) { return __builtin_fminf(x, 0.f) - __logf(1.f + __expf(-__builtin_fabsf(x))); }

__device__ __forceinline__ void p0_item_out(bf16* WT, int K, int row_off, int k0, int n0, LAS float* scr, int lane) {
    LDS_WAIT(); asm volatile("" ::: "memory");
    const int c = lane & 7;
#pragma unroll
    for (int j = 0; j < 4; ++j) { const int n = (lane >> 3) + 8 * j; const LAS float* s = scr + (8 * c) * 33 + n;
        v4u o; o.x = pk2(s[0 * 33], s[1 * 33]); o.y = pk2(s[2 * 33], s[3 * 33]); o.z = pk2(s[4 * 33], s[5 * 33]); o.w = pk2(s[6 * 33], s[7 * 33]);
        *(GAS v4u*)(WT + (size_t)(row_off + n0 + n) * K + k0 + 8 * c) = o; }
    LDS_WAIT(); asm volatile("" ::: "memory");
}
__device__ __forceinline__ void p0_transpose_item(const float* W, int K, int ldw, int col_off, int ncols, const float* gk, bf16* WT, int row_off, LAS float* scr, int item, int lane) {
    const int nblk = ncols / 32, kb = item / nblk, nb = item % nblk, k0 = 64 * kb, n0 = 32 * nb;
    const int kr = lane >> 3, nc = (lane & 7) * 4;
    f32x4 v[8]; float g[8];
#pragma unroll
    for (int j = 0; j < 8; ++j) { v[j] = *(const GAS f32x4*)(W + (size_t)(k0 + 8 * j + kr) * ldw + col_off + n0 + nc); g[j] = gk ? gk[k0 + 8 * j + kr] : 1.f; }
#pragma unroll
    for (int j = 0; j < 8; ++j) { LAS float* d = scr + (8 * j + kr) * 33 + nc; d[0] = v[j][0] * g[j]; d[1] = v[j][1] * g[j]; d[2] = v[j][2] * g[j]; d[3] = v[j][3] * g[j]; }
    p0_item_out(WT, K, row_off, k0, n0, scr, lane);
}
__device__ __forceinline__ void p0_gate_item(const float* Win, const float* wg2, const float* gk, bf16* WT, int row_off, LAS float* scr, int item, int lane) {
    const int kb = item / 4, nb = item % 4, k0 = 64 * kb, n0 = 32 * nb; const int c = n0 + (lane & 31);
    float w2[16];
#pragma unroll
    for (int r = 0; r < 16; ++r) w2[r] = wg2[r * 128 + c];
#pragma unroll 4
    for (int i = 0; i < 32; ++i) { const int kk = 2 * i + (lane >> 5); const float* wr_ = Win + (size_t)(k0 + kk) * NP_SRC + C_GG; float a = 0.f;
#pragma unroll
        for (int r = 0; r < 16; ++r) a += wr_[r] * w2[r];
        scr[kk * 33 + (lane & 31)] = a * gk[k0 + kk]; }
    p0_item_out(WT, D, row_off, k0, n0, scr, lane);
}
template <int R> __device__ __forceinline__ void x_rows_to_bf16(const float* x, bf16* hb, float* ss, int row0, int rstride, int lane) {
    f32x4 v[R][4];
#pragma unroll
    for (int r = 0; r < R; ++r) { const GAS f32x4* xr = (const GAS f32x4*)(x + (size_t)(row0 + r * rstride) * D) + lane;
#pragma unroll
        for (int j = 0; j < 4; ++j) v[r][j] = xr[64 * j]; }
#pragma unroll
    for (int r = 0; r < R; ++r) { float s2 = 0.f;
#pragma unroll
        for (int j = 0; j < 4; ++j) s2 += (v[r][j].x * v[r][j].x + v[r][j].y * v[r][j].y) + (v[r][j].z * v[r][j].z + v[r][j].w * v[r][j].w);
        s2 = wave_sum(s2);
        GAS unsigned long long* o8 = (GAS unsigned long long*)(hb + (size_t)(row0 + r * rstride) * D) + lane;
#pragma unroll
        for (int j = 0; j < 4; ++j) o8[64 * j] = (unsigned long long)pk2(v[r][j].x, v[r][j].y) | ((unsigned long long)pk2(v[r][j].z, v[r][j].w) << 32);
        if (lane < 16) ss[(size_t)(row0 + r * rstride) * 16 + lane] = (lane == 0) ? s2 : 0.f; }
}

struct Inputs {
    const float *x, *norm1_g, *w_in, *pool_w, *pool_scale, *lq1, *lk1, *lq2, *lk2, *diff_norm_g, *w_gate2, *b_gate, *gla_norm_g, *w_out, *norm2_g, *w_mlp1, *w_mlp2, *final_g;
};

__device__ __forceinline__ void p0_prologue(Frame& F, const Inputs& I, unsigned char* ws) {
    LAS float* scr = (LAS float*)(F.lds + RING_OFF + F.wave * 16384);
    const int gw = F.vcu * NWAVES + F.wave, NGW = F.G * NWAVES;
    constexpr int I_IN = (D / 64) * (2560 / 32), I_G = (D / 64) * 4, I_O = (D / 64) * (D / 32), I_1 = (D / 64) * (FF / 32), I_2 = (FF / 64) * (D / 32);
    constexpr int NIT = I_IN + I_G + I_O + I_1 + I_2;
    for (int it = gw; it < DEPTH * NIT; it += NGW) {
        const int l = it / NIT; int r = it % NIT;
        unsigned char* wl = ws + WS_W + (size_t)l * W_LAYER;
        const float* win = I.w_in + (size_t)l * D * NP_SRC; const float* g1 = I.norm1_g + l * D; const float* g2 = I.norm2_g + l * D;
        if (r < I_IN) { p0_transpose_item(win, D, NP_SRC, 0, 2560, g1, (bf16*)(wl + WO_IN), 0, scr, r, F.lane); continue; } r -= I_IN;
        if (r < I_G) { p0_gate_item(win, I.w_gate2 + (size_t)l * 16 * 128, g1, (bf16*)(wl + WO_IN), C_GG, scr, r, F.lane); continue; } r -= I_G;
        if (r < I_O) { p0_transpose_item(I.w_out + (size_t)l * D * D, D, D, 0, D, nullptr, (bf16*)(wl + WO_OUT), 0, scr, r, F.lane); continue; } r -= I_O;
        if (r < I_1) { p0_transpose_item(I.w_mlp1 + (size_t)l * D * FF, D, FF, 0, FF, g2, (bf16*)(wl + WO_1), 0, scr, r, F.lane); continue; } r -= I_1;
        p0_transpose_item(I.w_mlp2 + (size_t)l * FF * D, FF, D, 0, D, nullptr, (bf16*)(wl + WO_2), 0, scr, r, F.lane);
    }
    { const int gt = F.vcu * (NWAVES * 64) + F.tid, NT_ = F.G * NWAVES * 64;
      for (int i = gt; i < DEPTH * 16384; i += NT_) { const int l = i / 16384, o = i % 16384;
          *(GAS v4u*)(ws + WS_W + (size_t)l * W_LAYER + WO_IN + (size_t)2688 * D * 2 + (size_t)o * 16) = (v4u){0u, 0u, 0u, 0u}; }
      for (int i = gt; i < DEPTH * 4 * 64 * 64; i += NT_) { const int ch = i & 63, d = (i >> 6) & 63, lg = i >> 12;
          ((bf16*)(ws + WS_WPOOL))[i] = (bf16)f2bf(I.pool_w[(size_t)lg * 4096 + ch * 64 + d]); } }
    { int m = gw; for (; m + 3 * NGW < M; m += 4 * NGW) x_rows_to_bf16<4>(I.x, (bf16*)(ws + WS_HB), (float*)(ws + WS_SSB), m, NGW, F.lane);
      for (; m < M; m += NGW) x_rows_to_bf16<1>(I.x, (bf16*)(ws + WS_HB), (float*)(ws + WS_SSB), m, NGW, F.lane); }
}

__device__ __forceinline__ void gla_scan(float* GKV, const float* GDEC, int gtid, int nthreads) {
    for (int id = gtid; id < 4 * 2048; id += nthreads) {
        const int bh = id >> 11, ed = id & 2047;
        float* p = GKV + (size_t)bh * NCH * 2048 + ed; const float* dp = GDEC + (size_t)bh * NCH * 32 + (ed & 31);
        float s = 0.f;
#pragma unroll 1
        for (int n0 = 0; n0 < NCH; n0 += 16) {
            float kv[16], dc[16];
#pragma unroll
            for (int i = 0; i < 16; ++i) { kv[i] = p[(size_t)(n0 + i) * 2048]; dc[i] = dp[(n0 + i) * 32]; }
#pragma unroll
            for (int i = 0; i < 16; ++i) { p[(size_t)(n0 + i) * 2048] = s; s = s * dc[i] + kv[i]; }
        }
    }
}
constexpr int PA_PP = 528, PA_GP = 272;
constexpr int PA_POOL = 0, PA_GATE = 80 * PA_PP, PA_GK = PA_GATE + 64 * PA_GP, PA_GV = PA_GK + 64 * PA_GP, PA_END = PA_GV + 64 * PA_PP;
static_assert(PA_END <= RING_BYTES, "phase A LDS");
constexpr int PA_NPIECE = 79 * 32 + 64 * 16 + 64 * 16 + 64 * 32, PA_NI = (PA_NPIECE + 511) / 512;
__device__ __forceinline__ void pa_piece(int p, int tb, int sb, long& goff, int& loff) {
    if (p < 79 * 32) { const int row = p >> 5, pc = p & 31; loff = PA_POOL + row * PA_PP + pc * 16; goff = (sb - 15 + row >= 0) ? ((long)(tb - 15 + row) * NP + C_POOL + pc * 8) : -1; return; }
    p -= 79 * 32;
    if (p < 64 * 16) { const int row = p >> 4, pc = p & 15; loff = PA_GATE + row * PA_GP + pc * 16; goff = (long)(tb + row) * NP + C_GG + pc * 8; return; }
    p -= 64 * 16;
    if (p < 64 * 16) { const int row = p >> 4, pc = p & 15; loff = PA_GK + row * PA_GP + pc * 16; goff = (long)(tb + row) * NP + C_GK + pc * 8; return; }
    p -= 64 * 16;
    if (p < 64 * 32) { const int row = p >> 5, pc = p & 31; loff = PA_GV + row * PA_PP + pc * 16; goff = (long)(tb + row) * NP + C_GV + pc * 8; return; }
    loff = -1; goff = -1;
}
struct StageA { v4u r[PA_NI]; };
__device__ __forceinline__ void stageA_load(StageA& S, const bf16* PROJ, int ck, int tid) {
    asm volatile("" : "+v"(tid));
    const int tb = ck * CHUNK, sb = (ck % NCH) * CHUNK;
#pragma unroll
    for (int i = 0; i < PA_NI; ++i) { long goff; int loff; pa_piece(tid + 512 * i, tb, sb, goff, loff);
        S.r[i] = (goff >= 0) ? *(const GAS v4u*)(PROJ + goff) : (v4u){0u, 0u, 0u, 0u}; }
}
__device__ __forceinline__ void stageA_store(const StageA& S, LAS unsigned char* lds, int ck, int tid) {
    asm volatile("" : "+v"(tid));
    const int tb = ck * CHUNK, sb = (ck % NCH) * CHUNK;
#pragma unroll
    for (int i = 0; i < PA_NI; ++i) { long goff; int loff; pa_piece(tid + 512 * i, tb, sb, goff, loff);
        if (loff >= 0) *(LAS v4u*)(lds + loff) = S.r[i]; }
}
__device__ __forceinline__ void pool_task2(const LAS unsigned char* lds, const bf16* WpT, const float* pscale, bf16* MIX, int ck, int g, int lane) {
    const int c = lane & 31, hh = lane >> 5; const int tb = ck * CHUNK, sb = (ck % NCH) * CHUNK; const int w = 2 << g;
    const bf16* Wg = WpT + (size_t)g * 4096;
#pragma unroll 1
    for (int tbk = 0; tbk < 2; ++tbk) {
        bf16x8 Bf[4];
        const int s = sb + 32 * tbk + c; const int cnt = (s + 1 < w) ? (s + 1) : w; const float inv = 1.0f / (float)cnt;
        const LAS unsigned char* rp = lds + PA_POOL + (15 + 32 * tbk + c) * PA_PP + (g * 64 + 8 * hh) * 2;
#pragma unroll
        for (int kp = 0; kp < 2; ++kp) {
            float cur[2][8], acc[2][8];
#pragma unroll
            for (int k2 = 0; k2 < 2; ++k2) { unpack8(*(const LAS v4u*)(rp + 32 * (2 * kp + k2)), cur[k2]);
#pragma unroll
                for (int j = 0; j < 8; ++j) acc[k2][j] = cur[k2][j]; }
#pragma unroll 2
            for (int i = 1; i < w; ++i) {
#pragma unroll
                for (int k2 = 0; k2 < 2; ++k2) { float v[8]; unpack8(*(const LAS v4u*)(rp - i * PA_PP + 32 * (2 * kp + k2)), v);
#pragma unroll
                    for (int j = 0; j < 8; ++j) acc[k2][j] += v[j]; }
            }
#pragma unroll
            for (int k2 = 0; k2 < 2; ++k2) { float p[8];
#pragma unroll
                for (int j = 0; j < 8; ++j) p[j] = acc[k2][j] * inv - cur[k2][j];
                Bf[2 * kp + k2] = pack8(p); }
        }
#pragma unroll
        for (int db = 0; db < 2; ++db) {
            f32x16 dacc = {};
#pragma unroll
            for (int ks = 0; ks < 4; ++ks) dacc = __builtin_amdgcn_mfma_f32_32x32x16_bf16(*(const GAS bf16x8*)(Wg + (size_t)(32 * db + c) * 64 + 16 * ks + 8 * hh), Bf[ks], dacc, 0, 0, 0);
            bf16* op = MIX + (size_t)(tb + 32 * tbk + c) * D + g * 64 + 32 * db + 4 * hh;
            const float* sp = pscale + g * 64 + 32 * db + 4 * hh;
#pragma unroll
            for (int q = 0; q < 4; ++q) { const f32x4 sc = *(const f32x4*)(sp + 8 * q);
                u32x2v o; o.x = cvtpk(dacc[4 * q] * sc[0], dacc[4 * q + 1] * sc[1]); o.y = cvtpk(dacc[4 * q + 2] * sc[2], dacc[4 * q + 3] * sc[3]);
                *(GAS u32x2v*)(op + 8 * q) = o; }
        }
    }
}
__device__ __forceinline__ void gla_kv_task2(const LAS unsigned char* lds, const float* bgate, float* GKV, float* GDEC, int ck, int h, int lane) {
    const int d = lane & 31, hh = lane >> 5; const int b = ck / NCH, n = ck % NCH; const int bhn = (b * 4 + h) * NCH + n;
    const float bg = bgate[h * 32 + d];
    const LAS unsigned short* Gp = (const LAS unsigned short*)(lds + PA_GATE) + h * 32 + d;
    const LAS unsigned short* Kp = (const LAS unsigned short*)(lds + PA_GK) + h * 32 + d;
    float bc[4][8], gt[4];
#pragma unroll
    for (int ks = 0; ks < 4; ++ks) { float run = 0.f;
#pragma unroll
        for (int j = 0; j < 8; ++j) { const int t = 16 * ks + 8 * hh + j; run += logsig(bf2f(Gp[t * (PA_GP / 2)]) + bg) * (1.0f / 16.0f); bc[ks][j] = run; }
        gt[ks] = run; }
    float base = 0.f, blast;
    {
        float pt[4];
#pragma unroll
        for (int ks = 0; ks < 4; ++ks) pt[ks] = __shfl_xor(gt[ks], 32);
#pragma unroll
        for (int ks = 0; ks < 4; ++ks) { const float lo = hh ? pt[ks] : gt[ks], hi_ = hh ? gt[ks] : pt[ks];
            const float off = base + (hh ? lo : 0.f);
#pragma unroll
            for (int j = 0; j < 8; ++j) bc[ks][j] += off;
            base += lo + hi_; }
        blast = base;
    }
    bf16x8 Af[4];
#pragma unroll
    for (int ks = 0; ks < 4; ++ks) { float v[8];
#pragma unroll
        for (int j = 0; j < 8; ++j) { const int t = 16 * ks + 8 * hh + j; v[j] = bf2f(Kp[t * (PA_GP / 2)]) * __expf(blast - bc[ks][j]); }
        Af[ks] = pack8(v); }
    const LAS unsigned short* Vp = (const LAS unsigned short*)(lds + PA_GV) + h * 64 + d;
#pragma unroll
    for (int nb = 0; nb < 2; ++nb) {
        f32x16 dacc = {};
#pragma unroll
        for (int ks = 0; ks < 4; ++ks) { v4u w;
            unsigned short e[8];
#pragma unroll
            for (int j = 0; j < 8; ++j) e[j] = Vp[(16 * ks + 8 * hh + j) * (PA_PP / 2) + 32 * nb];
            w.x = e[0] | ((unsigned)e[1] << 16); w.y = e[2] | ((unsigned)e[3] << 16); w.z = e[4] | ((unsigned)e[5] << 16); w.w = e[6] | ((unsigned)e[7] << 16);
            dacc = __builtin_amdgcn_mfma_f32_32x32x16_bf16(Af[ks], __builtin_bit_cast(bf16x8, w), dacc, 0, 0, 0); }
        float* op = GKV + ((size_t)bhn * 64 + 32 * nb + d) * 32 + 4 * hh;
#pragma unroll
        for (int q = 0; q < 4; ++q) *(GAS f32x4*)(op + 8 * q) = (f32x4){dacc[4 * q], dacc[4 * q + 1], dacc[4 * q + 2], dacc[4 * q + 3]};
    }
    if (hh == 0) GDEC[(size_t)bhn * 32 + d] = __expf(blast);
}
constexpr int PC_GATE = 0, PC_GQ = 64 * PA_GP, PC_GK = 2 * 64 * PA_GP, PC_GV = 3 * 64 * PA_GP, PC_SCR = PC_GV + 64 * PA_PP, PC_END = PC_SCR + 4 * 8448;
static_assert(PC_END <= RING_BYTES, "phase C LDS");
constexpr int PC_NPIECE = 3 * 64 * 16 + 64 * 32, PC_NI = PC_NPIECE / 512;
static_assert(PC_NPIECE % 512 == 0, "phase C pieces");
__device__ __forceinline__ void pc_piece(int p, int tb, long& goff, int& loff) {
    if (p < 3 * 64 * 16) { const int reg = p >> 10, q = p & 1023, row = q >> 4, pc = q & 15; loff = reg * 64 * PA_GP + row * PA_GP + pc * 16;
        goff = (long)(tb + row) * NP + (reg == 0 ? C_GG : reg == 1 ? C_GQ : C_GK) + pc * 8; return; }
    p -= 3 * 64 * 16; { const int row = p >> 5, pc = p & 31; loff = PC_GV + row * PA_PP + pc * 16; goff = (long)(tb + row) * NP + C_GV + pc * 8; }
}
struct StageC { v4u r[PC_NI]; };
__device__ __forceinline__ void stageC_load(StageC& S, const bf16* PROJ, int ck, int tid) {
    asm volatile("" : "+v"(tid));
#pragma unroll
    for (int i = 0; i < PC_NI; ++i) { long goff; int loff; pc_piece(tid + 512 * i, ck * CHUNK, goff, loff); S.r[i] = *(const GAS v4u*)(PROJ + goff); }
}
__device__ __forceinline__ void stageC_store(const StageC& S, LAS unsigned char* lds, int ck, int tid) {
    asm volatile("" : "+v"(tid));
#pragma unroll
    for (int i = 0; i < PC_NI; ++i) { long goff; int loff; pc_piece(tid + 512 * i, ck * CHUNK, goff, loff); *(LAS v4u*)(lds + loff) = S.r[i]; }
}
__device__ __forceinline__ void gla_out_task2(LAS unsigned char* lds, const bf16* PROJ, const float* bgate, const float* gnorm, const float* GKV, bf16* MIX, int ck, int h, int ib, int lane) {
    const int c = lane & 31, hh = lane >> 5; const int tb = ck * CHUNK; const int b = ck / NCH, n = ck % NCH; const int bhn = (b * 4 + h) * NCH + n;
    LAS float* scr = (LAS float*)(lds + PC_SCR + h * 8448);
    const int tok = tb + 32 * ib + c;
    const float* Sp = GKV + (size_t)bhn * 2048;
    f32x4 sv[2][2][2];
#pragma unroll
    for (int eb = 0; eb < 2; ++eb)
#pragma unroll
        for (int ks = 0; ks < 2; ++ks) { const float* sp = Sp + (size_t)(32 * eb + c) * 32 + 16 * ks + 8 * hh; sv[eb][ks][0] = *(const GAS f32x4*)sp; sv[eb][ks][1] = *(const GAS f32x4*)(sp + 4); }
    const bf16* rp = PROJ + (size_t)tok * NP + C_GR + h * 64 + 4 * hh;
    u32x2v rw[2][4];
#pragma unroll
    for (int eb = 0; eb < 2; ++eb)
#pragma unroll
        for (int q = 0; q < 4; ++q) rw[eb][q] = *(const GAS u32x2v*)(rp + 32 * eb + 8 * q);
    {
        const float bg = bgate[h * 32 + c];
        const LAS unsigned short* Gp = (const LAS unsigned short*)(lds + PC_GATE) + (32 * hh) * (PA_GP / 2) + h * 32 + c;
        float bc[32]; float run = 0.f;
#pragma unroll
        for (int i = 0; i < 32; ++i) { run += logsig(bf2f(Gp[i * (PA_GP / 2)]) + bg) * (1.0f / 16.0f); bc[i] = run; }
        const float tot0 = __shfl(run, c);
        const float off = hh ? tot0 : 0.f;
#pragma unroll
        for (int i = 0; i < 32; ++i) scr[(32 * hh + i) * 33 + c] = bc[i] + off;
        LDS_WAIT(); asm volatile("" ::: "memory");
    }
    bf16x8 Qf[2], Kf[2][2];
    const float qs = 0.17677669529663687f;
#pragma unroll
    for (int ks = 0; ks < 2; ++ks) { const int i = 32 * ib + c, d0 = 16 * ks + 8 * hh; float q[8], qd[8];
        unpack8(*(const LAS v4u*)(lds + PC_GQ + i * PA_GP + (h * 32 + d0) * 2), q);
#pragma unroll
        for (int j = 0; j < 8; ++j) qd[j] = q[j] * qs * __expf(scr[i * 33 + d0 + j]);
        Qf[ks] = pack8(qd); }
#pragma unroll
    for (int jb = 0; jb < 2; ++jb)
#pragma unroll
        for (int ks = 0; ks < 2; ++ks) { const int i = 32 * jb + c, d0 = 16 * ks + 8 * hh; float k[8], ki[8];
            if (jb <= ib) {
                unpack8(*(const LAS v4u*)(lds + PC_GK + i * PA_GP + (h * 32 + d0) * 2), k);
#pragma unroll
                for (int j = 0; j < 8; ++j) ki[j] = k[j] * __expf(-scr[i * 33 + d0 + j]);
                Kf[jb][ks] = pack8(ki); } }
    const LAS unsigned short* Vp = (const LAS unsigned short*)(lds + PC_GV) + h * 64;
    const float* gn = gnorm + h * 64;
    f32x16 o[2]; o[0] = f32x16{}; o[1] = f32x16{};
    for (int jb = 0; jb <= ib; ++jb) {
        f32x16 at = {};
#pragma unroll
        for (int ks = 0; ks < 2; ++ks) at = __builtin_amdgcn_mfma_f32_32x32x16_bf16(jb == 0 ? Kf[0][ks] : Kf[1][ks], Qf[ks], at, 0, 0, 0);
        if (jb == ib) {
#pragma unroll
            for (int r = 0; r < 16; ++r) if (crow(r, hh) > c) at[r] = 0.f;
        }
#pragma unroll
        for (int s = 0; s < 2; ++s) {
            float pv_[8];
#pragma unroll
            for (int jj = 0; jj < 8; ++jj) pv_[jj] = at[8 * s + jj];
            const bf16x8 Pf = pack8(pv_);
#pragma unroll
            for (int eb = 0; eb < 2; ++eb) { unsigned short e[8];
#pragma unroll
                for (int jj = 0; jj < 8; ++jj) { const int j = 32 * jb + 16 * s + 8 * (jj >> 2) + 4 * hh + (jj & 3); e[jj] = Vp[j * (PA_PP / 2) + 32 * eb + c]; }
                v4u w; w.x = e[0] | ((unsigned)e[1] << 16); w.y = e[2] | ((unsigned)e[3] << 16); w.z = e[4] | ((unsigned)e[5] << 16); w.w = e[6] | ((unsigned)e[7] << 16);
                o[eb] = __builtin_amdgcn_mfma_f32_32x32x16_bf16(__builtin_bit_cast(bf16x8, w), Pf, o[eb], 0, 0, 0); }
        }
    }
#pragma unroll
    for (int eb = 0; eb < 2; ++eb)
#pragma unroll
        for (int ks = 0; ks < 2; ++ks) { const f32x4 s0 = sv[eb][ks][0], s1 = sv[eb][ks][1];
            const float svv[8] = {s0[0], s0[1], s0[2], s0[3], s1[0], s1[1], s1[2], s1[3]};
            o[eb] = __builtin_amdgcn_mfma_f32_32x32x16_bf16(pack8(svv), Qf[ks], o[eb], 0, 0, 0); }
    float ssq = 0.f;
#pragma unroll
    for (int eb = 0; eb < 2; ++eb)
#pragma unroll
        for (int r = 0; r < 16; ++r) ssq += o[eb][r] * o[eb][r];
    ssq += __shfl_xor(ssq, 32);
    const float rstd = __builtin_amdgcn_rsqf(ssq * (1.0f / 64.0f) + EPS);
    bf16* op = MIX + (size_t)tok * D + 768 + h * 64 + 4 * hh;
#pragma unroll
    for (int eb = 0; eb < 2; ++eb)
#pragma unroll
        for (int q = 0; q < 4; ++q) { const int e0 = 32 * eb + 8 * q;
            const u32x2v rww = rw[eb][q]; const f32x4 g4 = *(const f32x4*)(gn + e0 + 4 * hh);
            const float rg[4] = {__uint_as_float(rww.x << 16), __uint_as_float(rww.x & 0xffff0000u), __uint_as_float(rww.y << 16), __uint_as_float(rww.y & 0xffff0000u)};
            float y[4];
#pragma unroll
            for (int k = 0; k < 4; ++k) { const float sil = rg[k] / (1.f + __expf(-rg[k])); y[k] = o[eb][4 * q + k] * rstd * g4[k] * sil; }
            u32x2v ow; ow.x = cvtpk(y[0], y[1]); ow.y = cvtpk(y[2], y[3]); *(GAS u32x2v*)(op + e0) = ow; }
    LDS_WAIT(); asm volatile("" ::: "memory");
}
template <int R> __device__ __forceinline__ void diff_fin_rows(const bf16* OATT, const float* dng, bf16* MIX, int tok0, int tstride, float lam, float oml, int lane) {
    const int hd = lane >> 4, e0 = (lane & 15) * 8;
    v4u w1[R], w2[R];
#pragma unroll
    for (int r = 0; r < R; ++r) { const size_t o = (size_t)(tok0 + r * tstride) * D + hd * 256 + e0; w1[r] = *(const GAS v4u*)(OATT + o); w2[r] = *(const GAS v4u*)(OATT + o + 128); }
    const f32x4 g0 = *(const f32x4*)(dng + hd * 128 + e0), g1 = *(const f32x4*)(dng + hd * 128 + e0 + 4);
#pragma unroll
    for (int r = 0; r < R; ++r) { float a1[8], a2[8], a[8]; unpack8(w1[r], a1); unpack8(w2[r], a2);
        float ss = 0.f;
#pragma unroll
        for (int j = 0; j < 8; ++j) { a[j] = a1[j] - lam * a2[j]; ss += a[j] * a[j]; }
        ss += __shfl_xor(ss, 1); ss += __shfl_xor(ss, 2); ss += __shfl_xor(ss, 4); ss += __shfl_xor(ss, 8);
        const float rstd = __builtin_amdgcn_rsqf(ss * (1.0f / 128.0f) + EPS) * oml;
        float y[8];
#pragma unroll
        for (int j = 0; j < 4; ++j) { y[j] = a[j] * rstd * g0[j]; y[4 + j] = a[4 + j] * rstd * g1[j]; }
        *(GAS bf16x8*)(MIX + (size_t)(tok0 + r * tstride) * D + 256 + hd * 128 + e0) = pack8(y); }
}
template <int R> __device__ __forceinline__ void final_norm_rows(const bf16* hb, float* out, const float* g, int row0, int rstride, int lane) {
    v4u w[R][2];
#pragma unroll
    for (int r = 0; r < R; ++r)
#pragma unroll
        for (int j = 0; j < 2; ++j) w[r][j] = *(const GAS v4u*)(hb + (size_t)(row0 + r * rstride) * D + j * 512 + lane * 8);
    f32x4 g4[2][2];
#pragma unroll
    for (int j = 0; j < 2; ++j) { g4[j][0] = *(const f32x4*)(g + j * 512 + lane * 8); g4[j][1] = *(const f32x4*)(g + j * 512 + lane * 8 + 4); }
#pragma unroll
    for (int r = 0; r < R; ++r) { float v[2][8]; float s2 = 0.f;
#pragma unroll
        for (int j = 0; j < 2; ++j) { unpack8(w[r][j], v[j]);
#pragma unroll
            for (int e = 0; e < 8; ++e) s2 += v[j][e] * v[j][e]; }
        const float rstd = __builtin_amdgcn_rsqf(wave_sum(s2) * (1.0f / D) + EPS);
        float* op = out + (size_t)(row0 + r * rstride) * D + lane * 8;
#pragma unroll
        for (int j = 0; j < 2; ++j) { f32x4 o0, o1;
#pragma unroll
            for (int e = 0; e < 4; ++e) { o0[e] = v[j][e] * rstd * g4[j][0][e]; o1[e] = v[j][4 + e] * rstd * g4[j][1][e]; }
            *(GAS f32x4*)(op + j * 512) = o0; *(GAS f32x4*)(op + j * 512 + 4) = o1; } }
}

template <class Sched> __device__ __forceinline__ void rs_table(LAS float* rst, const float* ss, const Sched& S, int tid) {
    asm volatile("" : "+v"(tid));
    const int row = tid >> 1, half = tid & 1;
#pragma unroll 1
    for (int i0 = 0; i0 < RST_MAXU; i0 += 4) {
        f32x4 a[4], b[4]; bool ok[4];
#pragma unroll
        for (int j = 0; j < 4; ++j) { pg8::Unit u; ok[j] = S.next(i0 + j, u);
            if (ok[j]) { const float* p = ss + ((size_t)u.pm * 256 + row) * 16 + half * 8; a[j] = *(const GAS f32x4*)p; b[j] = *(const GAS f32x4*)(p + 4); }
            else { a[j] = (f32x4){0.f, 0.f, 0.f, 0.f}; b[j] = a[j]; } }
#pragma unroll
        for (int j = 0; j < 4; ++j) { float s_ = ((a[j][0] + a[j][1]) + (a[j][2] + a[j][3])) + ((b[j][0] + b[j][1]) + (b[j][2] + b[j][3]));
            s_ += __shfl_xor(s_, 1);
            if (ok[j] && half == 0) rst[(i0 + j) * 256 + row] = __builtin_amdgcn_rsqf(s_ * (1.0f / 1024.0f) + EPS); }
        if (!ok[3]) break;
    }
    __syncthreads();
}
struct Args { const float* in[18]; float* out; unsigned char* ws; };
__global__ void __launch_bounds__(NWAVES * 64, 2) fwd_kernel(Args args) {
    extern __shared__ __attribute__((aligned(16))) unsigned char lds[];
    Frame F;
    F.lds = (LAS unsigned char*)lds;
    F.MISC = (volatile LAS unsigned*)(F.lds + MISC_OFF);
    F.tid = threadIdx.x; F.lane = F.tid & 63; F.wave = __builtin_amdgcn_readfirstlane(F.tid >> 6);
    F.G = gridDim.x; { const int bx = blockIdx.x; F.vcu = (F.G % 8 == 0) ? (bx % 8) * (F.G / 8) + bx / 8 : bx; }
    unsigned char* ws = args.ws;
    F.ctl = (gu32*)(ws + WS_CTL);
    for (int u = F.tid; u < (LDS_BYTES - LDSCTL_OFF) / 4; u += NWAVES * 64) ((LAS unsigned*)(F.lds + LDSCTL_OFF))[u] = 0u;
    __syncthreads();
    XcdBarrier bar; bar.bar = (unsigned*)(F.ctl + CW_BAR); bar.x = xb_xcc_id(); bar.st = F.MISC + 8;
    if (F.tid == 0) F.MISC[12] = xb_add(&bar.bar[XB_XCNT(bar.x)], 1u);
#define REFRESH() do { int t_ = threadIdx.x; asm volatile("" : "+v"(t_)); F.tid = t_; F.lane = t_ & 63; F.wave = __builtin_amdgcn_readfirstlane(t_ >> 6); } while (0)

    { Inputs I;
      I.x = args.in[0]; I.norm1_g = args.in[1]; I.w_in = args.in[2]; I.pool_w = args.in[3]; I.pool_scale = args.in[4]; I.lq1 = args.in[5]; I.lk1 = args.in[6]; I.lq2 = args.in[7]; I.lk2 = args.in[8];
      I.diff_norm_g = args.in[9]; I.w_gate2 = args.in[10]; I.b_gate = args.in[11]; I.gla_norm_g = args.in[12]; I.w_out = args.in[13]; I.norm2_g = args.in[14]; I.w_mlp1 = args.in[15]; I.w_mlp2 = args.in[16]; I.final_g = args.in[17];
      p0_prologue(F, I, ws); }
    xcd_barrier(bar);
    int r, nloc, kx = 0, nx = 0;
    { r = (int)F.MISC[12]; nloc = (int)F.MISC[8];
#pragma unroll
      for (unsigned j = 0; j < 16; ++j) { const unsigned c = xb_ld(&bar.bar[XB_XCNT(j)]); if (c) { if (j < bar.x) ++kx; ++nx; } }
      r = __builtin_amdgcn_readfirstlane(r); nloc = __builtin_amdgcn_readfirstlane(nloc); kx = __builtin_amdgcn_readfirstlane(kx); nx = __builtin_amdgcn_readfirstlane(nx);
      if (nloc < 1) nloc = 1; if (nx < 1) nx = 1; }
#define LOCAL_BAR() xcd_local_barrier(bar)

#pragma unroll 1
    for (int bb = kx; bb < BATCH; bb += nx) {
#define HBb   ((bf16*)(ws + WS_HB) + (size_t)bb * SEQ * D)
#define SSAb  ((float*)(ws + WS_SSA) + (size_t)bb * SEQ * 16)
#define SSBb  ((float*)(ws + WS_SSB) + (size_t)bb * SEQ * 16)
#define GKVb  ((float*)(ws + WS_GKV) + (size_t)bb * 4 * NCH * 2048)
#define GDECb ((float*)(ws + WS_GDEC) + (size_t)bb * 4 * NCH * 32)
#define REGb  (ws + WS_REG + (size_t)bb * REG_B)
#define PROJ  ((bf16*)(REGb + RO_PROJ))
#define OATT  ((bf16*)(REGb + RO_OATT))
#define MIX   ((bf16*)(REGb + RO_MIX))
#define HID   ((bf16*)(REGb + RO_HID))
#pragma unroll 1
        for (int l = 0; l < DEPTH; ++l) {
            unsigned char* wl = ws + WS_W + (size_t)l * W_LAYER;
            const float lambda_init = (l == 0) ? 0.2f : 0.35550906759096927f;
            {
                pg8::Gemm g{HBb, (const bf16*)(wl + WO_IN), SEQ, NP, D}; pg8::BatchOrder S; S.init(SEQ, NP, nloc, r);
                rs_table((LAS float*)(F.lds + RST_OFF), SSBb, S, threadIdx.x);
                pg8::EpiRs<0> E{PROJ, NP, (const LAS float*)(F.lds + RST_OFF), SSBb, 1, 3, attn2::C2};
                pg8::gemm_phase<pg8::EpiRs<0>, pg8::BatchOrder, true, true>(F.lds + RING_OFF, g, S, E);
                LOCAL_BAR();
            }
            {
                REFRESH();
                if (r < NCH) {
                    StageA SA; int ck = r;
                    stageA_load(SA, PROJ, ck, F.tid);
                    for (; ck < NCH; ck += nloc) {
                        stageA_store(SA, F.lds + RING_OFF, ck, F.tid);
                        __syncthreads();
                        stageA_load(SA, PROJ, (ck + nloc < NCH) ? ck + nloc : ck, F.tid);
                        if (F.wave < 4) pool_task2(F.lds + RING_OFF, (const bf16*)(ws + WS_WPOOL) + (size_t)l * 4 * 4096, args.in[4] + l * 256, MIX, ck, F.wave, F.lane);
                        else gla_kv_task2(F.lds + RING_OFF, args.in[11] + l * 128, GKVb, GDECb, ck, F.wave - 4, F.lane);
                        __syncthreads();
                    }
                }
                LOCAL_BAR();
            }
            {
                REFRESH();
                if (F.tid < 256) gla_scan(GKVb, GDECb, r * 256 + F.tid, nloc * 256);
                __syncthreads();
                attn2::attn_phase3((char*)lds + RING_OFF, (const attn2::bf16*)PROJ, (attn2::bf16*)OATT, r, nloc, C_DQ, C_DK, C_DV);
                LOCAL_BAR();
            }
            {
                REFRESH();
                if (r < NCH) {
                    StageC SC; int ck = r;
                    stageC_load(SC, PROJ, ck, F.tid);
                    for (; ck < NCH; ck += nloc) {
                        stageC_store(SC, F.lds + RING_OFF, ck, F.tid);
                        __syncthreads();
                        stageC_load(SC, PROJ, (ck + nloc < NCH) ? ck + nloc : ck, F.tid);
                        gla_out_task2(F.lds + RING_OFF, PROJ, args.in[11] + l * 128, args.in[12] + l * 256, GKVb, MIX, ck, F.wave & 3, F.wave >> 2, F.lane);
                        __syncthreads();
                    }
                }
                const float s1 = wave_sum(args.in[5][l * 64 + F.lane] * args.in[6][l * 64 + F.lane]), s2 = wave_sum(args.in[7][l * 64 + F.lane] * args.in[8][l * 64 + F.lane]);
                const float lam = __expf(s1) - __expf(s2) + lambda_init;
                const int NGWb = nloc * NWAVES; int tok = r * NWAVES + F.wave;
                for (; tok + 3 * NGWb < SEQ; tok += 4 * NGWb) diff_fin_rows<4>(OATT, args.in[9] + l * 512, MIX, tok, NGWb, lam, 1.0f - lambda_init, F.lane);
                for (; tok < SEQ; tok += NGWb) diff_fin_rows<1>(OATT, args.in[9] + l * 512, MIX, tok, NGWb, lam, 1.0f - lambda_init, F.lane);
                LOCAL_BAR();
            }
            {
                pg8::Gemm g{MIX, (const bf16*)(wl + WO_OUT), SEQ, D, D}; pg8::BatchOrder S; S.init(SEQ, D, nloc, r);
                pg8::EpiRes E{HBb, SSAb, D};
                pg8::gemm_phase<pg8::EpiRes, pg8::BatchOrder, true, true>(F.lds + RING_OFF, g, S, E);
                LOCAL_BAR();
            }
            {
                pg8::Gemm g{HBb, (const bf16*)(wl + WO_1), SEQ, FF, D}; pg8::BatchOrder S; S.init(SEQ, FF, nloc, r);
                rs_table((LAS float*)(F.lds + RST_OFF), SSAb, S, threadIdx.x);
                pg8::EpiRs<2> E{HID, FF, (const LAS float*)(F.lds + RST_OFF), SSAb, 0, 0, 1.f};
                pg8::gemm_phase<pg8::EpiRs<2>, pg8::BatchOrder, true, true>(F.lds + RING_OFF, g, S, E);
                LOCAL_BAR();
            }
            {
                pg8::Gemm g{HID, (const bf16*)(wl + WO_2), SEQ, D, FF}; pg8::BatchOrder S; S.init(SEQ, D, nloc, r);
                pg8::EpiRes E{HBb, SSBb, D};
                pg8::gemm_phase<pg8::EpiRes, pg8::BatchOrder, true, true>(F.lds + RING_OFF, g, S, E);
                LOCAL_BAR();
            }
        }
        { REFRESH(); const int NGWb = nloc * NWAVES; int m = r * NWAVES + F.wave; float* const outb = args.out + (size_t)bb * SEQ * D;
          for (; m + 3 * NGWb < SEQ; m += 4 * NGWb) final_norm_rows<4>(HBb, outb, args.in[17], m, NGWb, F.lane);
          for (; m < SEQ; m += NGWb) final_norm_rows<1>(HBb, outb, args.in[17], m, NGWb, F.lane); }
    }
#undef LOCAL_BAR
#undef REFRESH
#undef HBb
#undef SSAb
#undef SSBb
#undef GKVb
#undef GDECb
#undef REGb
#undef PROJ
#undef OATT
#undef MIX
#undef HID
}

extern "C" void kernel_launch(void* const* d_in, const int* in_sizes, int n_in, void* d_out, int out_size, void* d_ws, size_t ws_size, hipStream_t stream) {
    static int grid = 0;
    if (grid == 0) {
        if (n_in != 18 || in_sizes[0] != M * D || out_size != M * D || ws_size < WS_END) { fprintf(stderr, "kernel_launch: unexpected shapes: n_in %d, in0 %d, out %d, ws %zu (need %zu); nothing launched\n", n_in, n_in > 0 ? in_sizes[0] : -1, out_size, ws_size, (size_t)WS_END); grid = -1; return; }
        int dev = 0, cus = 0, per_cu = 0;
        if (hipGetDevice(&dev) != hipSuccess || hipDeviceGetAttribute(&cus, hipDeviceAttributeMultiprocessorCount, dev) != hipSuccess) { grid = -1; return; }
        if (hipFuncSetAttribute((const void*)fwd_kernel, hipFuncAttributeMaxDynamicSharedMemorySize, LDS_BYTES) != hipSuccess) { fprintf(stderr, "kernel_launch: hipFuncSetAttribute failed\n"); grid = -1; return; }
        if (hipOccupancyMaxActiveBlocksPerMultiprocessor(&per_cu, (const void*)fwd_kernel, NWAVES * 64, LDS_BYTES) != hipSuccess || per_cu < 1) { fprintf(stderr, "kernel_launch: occupancy query reports %d workgroups per CU\n", per_cu); }
        (void)hipGetLastError();
        grid = cus;
    }
    if (grid < 0) return;
    if (hipMemsetAsync((char*)d_ws + WS_CTL, 0, CTL_ZERO_BYTES, stream) != hipSuccess) return;
    Args a{};
    for (int i = 0; i < 18; ++i) a.in[i] = (const float*)d_in[i];
    a.out = (float*)d_out; a.ws = (unsigned char*)d_ws;
    hipLaunchKernelGGL(fwd_kernel, dim3(grid), dim3(NWAVES * 64), LDS_BYTES, stream, a);
}
```

```cpp
#include <hip/hip_runtime.h>
#include <cstdio>
#include <cstdint>
namespace pg8 {
#define PG8_LAS __attribute__((address_space(3)))
typedef unsigned short bf16_t;
typedef short bf16x8 __attribute__((ext_vector_type(8)));
typedef float f32x4 __attribute__((ext_vector_type(4)));
typedef unsigned u32x4 __attribute__((ext_vector_type(4)));
constexpr int BM = 256, BK = 64, HALF = 128, HTB = HALF * BK * 2  , STAGE_BYTES = 8 * HTB, NXCD = 8, WGM = 8;

__host__ __device__ __forceinline__ int lds_byte(int r, int c) { const int st = (r >> 4) * 2 + (c >> 5), rr = r & 15, cc = c & 31, ob = rr * 64 + cc * 2; return st * 1024 + (ob ^ (((ob >> 9) & 1) << 5)); }
__host__ __device__ __forceinline__ void stage_rc(int b, int& R, int& C) { const int st = b / 1024, sb = b % 1024, swz = sb ^ (((sb >> 9) & 1) << 5); R = (st >> 1) * 16 + swz / 64; C = (st & 1) * 32 + (swz % 64) / 2; }
__host__ __device__ __forceinline__ int perm32(int rho) { const int n = rho >> 4, i = rho & 15; return 8 * (i >> 2) + 4 * n + (i & 3); }

struct Unit { int pm, pn; };
struct Gemm { const bf16_t* A; const bf16_t* Bt; int M, N, K; };

struct StaticOrder {
    int nM, nN, nwg, G, c;
    __host__ __device__ void init(int M, int N, int G_, int c_) { nM = M / BM; nN = N / BM; nwg = nM * nN; G = G_; c = c_; }
    __host__ __device__ bool next(int i, Unit& u) const {
        const long L = (long)i * G + c; if (L >= nwg) return false;
        int wgid = (int)L; { const int q = nwg / NXCD, r = nwg % NXCD, xcd = wgid % NXCD, off = wgid / NXCD; wgid = (xcd < r ? xcd * (q + 1) : r * (q + 1) + (xcd - r) * q) + off; }
        const int nig = WGM * nN, gid = wgid / nig, fm = gid * WGM, gsz = (nM - fm) < WGM ? (nM - fm) : WGM;
        u.pm = fm + ((wgid % nig) % gsz); u.pn = (wgid % nig) / gsz; return true;
    }
    __device__ __forceinline__ void a_ready(const Unit&) const {}
    __device__ __forceinline__ void done(const Unit&) const {}
};

__device__ __forceinline__ unsigned cvt_pk_bf16(float lo, float hi) { unsigned r; asm volatile("v_cvt_pk_bf16_f32 %0, %1, %2" : "=v"(r) : "v"(lo), "v"(hi)); return r; }
typedef float f32x2 __attribute__((ext_vector_type(2)));
typedef float f32x2 __attribute__((ext_vector_type(2)));
typedef unsigned u32x2 __attribute__((ext_vector_type(2)));
__device__ __forceinline__ float row_rs(const float* ss, int row, int fq, float eps) {
    const f32x4 p = *(const f32x4*)(ss + (size_t)row * 16 + fq * 4);
    float s = (p[0] + p[1]) + (p[2] + p[3]);
    s += __shfl_xor(s, 16); s += __shfl_xor(s, 32);
    return __builtin_amdgcn_rsqf(s * (1.0f / 1024.0f) + eps);
}
template <int ACT> struct EpiRs {
    static constexpr bool PERM = true, AFTER_DRAIN = false;
    bf16_t* O; int ldc; const PG8_LAS float* rst; int sc_lo, sc_hi; float tile_scale;
    __device__ __forceinline__ void operator()(const f32x4 (&acc)[2][2][4][2], const Unit& u, int ui, int wr, int wc, int fr, int fq) const {
        const int row0 = u.pm * BM + wr * 64 + fr; const int col0 = u.pn * BM + wc * 32 + 8 * fq;
        const float sc = (u.pn >= sc_lo && u.pn < sc_hi) ? tile_scale : 1.f;
        float rs[2][4];
#pragma unroll
        for (int ai = 0; ai < 2; ++ai)
#pragma unroll
            for (int m = 0; m < 4; ++m) rs[ai][m] = rst[ui * BM + wr * 64 + fr + ai * HALF + m * 16] * sc;
#pragma unroll
        for (int ai = 0; ai < 2; ++ai)
#pragma unroll
            for (int m = 0; m < 4; ++m) { bf16_t* rowp = O + (size_t)(row0 + ai * HALF + m * 16) * ldc + col0; const float r = rs[ai][m];
#pragma unroll
                for (int bj = 0; bj < 2; ++bj) { f32x4 v0 = acc[ai][bj][m][0] * r, v1 = acc[ai][bj][m][1] * r;
                    if (ACT == 2) {
#pragma unroll
                        for (int e = 0; e < 4; ++e) { const float a = __builtin_fmaxf(v0[e], 0.f), b = __builtin_fmaxf(v1[e], 0.f); v0[e] = a * a; v1[e] = b * b; } }
                    u32x4 w; w.x = cvt_pk_bf16(v0[0], v0[1]); w.y = cvt_pk_bf16(v0[2], v0[3]); w.z = cvt_pk_bf16(v1[0], v1[1]); w.w = cvt_pk_bf16(v1[2], v1[3]);
                    __builtin_nontemporal_store(w, (u32x4*)(rowp + bj * HALF)); } }
    }
};
struct EpiRes {
    static constexpr bool PERM = true, AFTER_DRAIN = false;
    bf16_t* hb; float* ss; int ldc;
    __device__ __forceinline__ void operator()(const f32x4 (&acc)[2][2][4][2], const Unit& u, int ui, int wr, int wc, int fr, int fq) const {
        const int row0 = u.pm * BM + wr * 64 + fr; const int col0 = u.pn * BM + wc * 32 + 8 * fq;
        u32x4 b[2][4][2];
#pragma unroll
        for (int ai = 0; ai < 2; ++ai)
#pragma unroll
            for (int m = 0; m < 4; ++m)
#pragma unroll
                for (int bj = 0; bj < 2; ++bj) b[ai][m][bj] = *(const u32x4*)(hb + (size_t)(row0 + ai * HALF + m * 16) * ldc + col0 + bj * HALF);
#pragma unroll
        for (int ai = 0; ai < 2; ++ai)
#pragma unroll
            for (int m = 0; m < 4; ++m) { const int row = row0 + ai * HALF + m * 16; bf16_t* rowp = hb + (size_t)row * ldc + col0; float sq = 0.f;
#pragma unroll
                for (int bj = 0; bj < 2; ++bj) { const u32x4 bb = b[ai][m][bj];
                    f32x4 o0, o1;
                    o0[0] = __uint_as_float(bb.x << 16) + acc[ai][bj][m][0][0]; o0[1] = __uint_as_float(bb.x & 0xffff0000u) + acc[ai][bj][m][0][1];
                    o0[2] = __uint_as_float(bb.y << 16) + acc[ai][bj][m][0][2]; o0[3] = __uint_as_float(bb.y & 0xffff0000u) + acc[ai][bj][m][0][3];
                    o1[0] = __uint_as_float(bb.z << 16) + acc[ai][bj][m][1][0]; o1[1] = __uint_as_float(bb.z & 0xffff0000u) + acc[ai][bj][m][1][1];
                    o1[2] = __uint_as_float(bb.w << 16) + acc[ai][bj][m][1][2]; o1[3] = __uint_as_float(bb.w & 0xffff0000u) + acc[ai][bj][m][1][3];
                    u32x4 w; w.x = cvt_pk_bf16(o0[0], o0[1]); w.y = cvt_pk_bf16(o0[2], o0[3]); w.z = cvt_pk_bf16(o1[0], o1[1]); w.w = cvt_pk_bf16(o1[2], o1[3]);
                    *(u32x4*)(rowp + bj * HALF) = w;
                    sq += ((o0[0] * o0[0] + o0[1] * o0[1]) + (o0[2] * o0[2] + o0[3] * o0[3])) + ((o1[0] * o1[0] + o1[1] * o1[1]) + (o1[2] * o1[2] + o1[3] * o1[3])); }
                sq += __shfl_xor(sq, 16); sq += __shfl_xor(sq, 32);
                if (fq == 0) ss[(size_t)row * 16 + u.pn * 4 + wc] = sq; }
    }
};
template <class Epi, class Sched, bool ALIGN_EPI = false, bool SP2 = false>
__device__ __forceinline__ void gemm_phase(PG8_LAS unsigned char* lds, const Gemm g, const Sched& S, const Epi& E) {
    int tid_ = threadIdx.x; asm volatile("" : "+v"(tid_));
    const int tid = tid_, wid = __builtin_amdgcn_readfirstlane(tid >> 6), lane = tid & 63, wr = wid >> 2, wc = wid & 3, fr = lane & 15, fq = lane >> 4;
    const int K = g.K, nt = K / BK;
    unsigned voffA[2], voffB[2];
#pragma unroll
    for (int i = 0; i < 2; ++i) { int R, C; stage_rc(tid * 16 + i * 8192, R, C); const int Rb = Epi::PERM ? ((R & ~31) + perm32(R & 31)) : R;
        voffA[i] = (unsigned)(R * K + C) * 2u; voffB[i] = (unsigned)(Rb * K + C) * 2u; }
    const size_t kstep = (size_t)(BK * 2);
    const size_t hstep = (size_t)HALF * K * 2;
    const size_t tstep = 2 * hstep;
    const unsigned ldsw = (unsigned)wid * 1024u;
    const int aoff = lds_byte(wr * 64 + fr, fq * 8), boff = lds_byte(wc * 32 + fr, fq * 8);
#define PG8_SA(b, h) (((b) * 2 + (h)) * HTB)
#define PG8_SB(b, h) ((4 + (b) * 2 + (h)) * HTB)
#define PG8_STAGE(bufoff, gbase, voff) do { _Pragma("unroll") for (int _i = 0; _i < 2; ++_i) \
        __builtin_amdgcn_global_load_lds((const unsigned*)((const char*)(gbase) + (voff)[_i]), (PG8_LAS unsigned*)(lds + (bufoff) + ldsw + _i * 8192), 16, 0, 0); } while (0)
#define PG8_LDA(dst, b, h) do { _Pragma("unroll") for (int m = 0; m < 4; ++m) _Pragma("unroll") for (int k = 0; k < 2; ++k) dst[m][k] = *(const PG8_LAS bf16x8*)(lds + PG8_SA(b, h) + aoff + m * 2048 + k * 1024); } while (0)
#define PG8_LDB(dst, b, h) do { _Pragma("unroll") for (int n = 0; n < 2; ++n) _Pragma("unroll") for (int k = 0; k < 2; ++k) dst[n][k] = *(const PG8_LAS bf16x8*)(lds + PG8_SB(b, h) + boff + n * 2048 + k * 1024); } while (0)
#define PG8_MMA(ai, bj, At, Bt) do { __builtin_amdgcn_s_setprio(1); _Pragma("unroll") for (int m = 0; m < 4; ++m) _Pragma("unroll") for (int n = 0; n < 2; ++n) _Pragma("unroll") for (int k = 0; k < 2; ++k) \
        acc[ai][bj][m][n] = __builtin_amdgcn_mfma_f32_16x16x32_bf16(Bt[n][k], At[m][k], acc[ai][bj][m][n], 0, 0, 0); __builtin_amdgcn_s_setprio(0); } while (0)
#define PG8_WAIT_V(n) asm volatile("s_waitcnt vmcnt(" #n ")" ::: "memory")
#define PG8_WAIT_L(n) asm volatile("s_waitcnt lgkmcnt(" #n ")" ::: "memory")
#define PG8_BAR __builtin_amdgcn_s_barrier()
#define PG8_SCHED __builtin_amdgcn_sched_barrier(0)
    Unit cur, nxt; int ui = 0;
    if (!S.next(0, cur)) return;
    f32x4 acc[2][2][4][2];
#pragma unroll
    for (int a = 0; a < 2; ++a)
#pragma unroll
        for (int b = 0; b < 2; ++b)
#pragma unroll
            for (int m = 0; m < 4; ++m)
#pragma unroll
                for (int n = 0; n < 2; ++n) acc[a][b][m][n] = (f32x4){0.f, 0.f, 0.f, 0.f};
    bf16x8 At[4][2], B0[2][2], B1[2][2];
    const char* cA = (const char*)g.A + (size_t)cur.pm * tstep; const char* cB = (const char*)g.Bt + (size_t)cur.pn * tstep;
    S.a_ready(cur);
    if constexpr (SP2) {
        PG8_STAGE(PG8_SB(0, 0), cB, voffB); PG8_STAGE(PG8_SB(0, 1), cB + hstep, voffB); PG8_STAGE(PG8_SA(0, 0), cA, voffA); PG8_STAGE(PG8_SA(0, 1), cA + hstep, voffA);
        if (wr == 1) PG8_BAR;
        PG8_WAIT_V(2); PG8_BAR;
        PG8_STAGE(PG8_SB(1, 0), cB + kstep, voffB); PG8_STAGE(PG8_SA(1, 0), cA + kstep, voffA); PG8_STAGE(PG8_SB(1, 1), cB + hstep + kstep, voffB);
        PG8_WAIT_V(6); PG8_BAR;
    } else {
        PG8_STAGE(PG8_SB(0, 0), cB, voffB); PG8_STAGE(PG8_SA(0, 0), cA, voffA); PG8_STAGE(PG8_SB(0, 1), cB + hstep, voffB); PG8_STAGE(PG8_SA(0, 1), cA + hstep, voffA);
        if (wr == 1) PG8_BAR;
        PG8_WAIT_V(4); PG8_BAR;
        PG8_STAGE(PG8_SB(1, 0), cB + kstep, voffB); PG8_STAGE(PG8_SA(1, 0), cA + kstep, voffA); PG8_STAGE(PG8_SB(1, 1), cB + hstep + kstep, voffB);
        PG8_WAIT_V(6); PG8_BAR;
    }
    for (;;) {
        const bool has_next = S.next(ui + 1, nxt);
        const char* nA = has_next ? (const char*)g.A + (size_t)nxt.pm * tstep : cA; const char* nB = has_next ? (const char*)g.Bt + (size_t)nxt.pn * tstep : cB;
        for (int t = 0; t < nt; t += 2) {
            const bool last = (t == nt - 2);
            const char* a1 = cA + (size_t)(t + 1) * kstep;
            const char* a2 = last ? nA : cA + (size_t)(t + 2) * kstep; const char* b2 = last ? nB : cB + (size_t)(t + 2) * kstep;
            const char* a3 = a2 + kstep; const char* b3 = b2 + kstep;
            if (last && has_next) S.a_ready(nxt);
            if constexpr (SP2) {
            PG8_LDB(B0, 0, 0); PG8_LDB(B1, 0, 1); PG8_SCHED; PG8_LDA(At, 0, 0); PG8_STAGE(PG8_SA(1, 1), a1 + hstep, voffA);
            PG8_WAIT_V(8); PG8_WAIT_L(0); PG8_BAR; PG8_MMA(0, 0, At, B0); PG8_MMA(0, 1, At, B1); PG8_BAR; PG8_SCHED;
            PG8_LDA(At, 0, 1); PG8_STAGE(PG8_SB(0, 0), b2, voffB); PG8_STAGE(PG8_SB(0, 1), b2 + hstep, voffB); PG8_STAGE(PG8_SA(0, 0), a2, voffA);
            PG8_WAIT_V(8); PG8_WAIT_L(0); PG8_BAR; PG8_MMA(1, 0, At, B0); PG8_MMA(1, 1, At, B1); PG8_BAR; PG8_SCHED;
            PG8_LDB(B0, 1, 0); PG8_LDB(B1, 1, 1); PG8_SCHED; PG8_LDA(At, 1, 0); PG8_STAGE(PG8_SA(0, 1), a2 + hstep, voffA);
            PG8_WAIT_V(8); PG8_WAIT_L(0); PG8_BAR; PG8_MMA(0, 0, At, B0); PG8_MMA(0, 1, At, B1); PG8_BAR; PG8_SCHED;
            PG8_LDA(At, 1, 1); PG8_STAGE(PG8_SB(1, 0), b3, voffB); PG8_STAGE(PG8_SB(1, 1), b3 + hstep, voffB); PG8_STAGE(PG8_SA(1, 0), a3, voffA);
            PG8_WAIT_V(8); PG8_WAIT_L(0); PG8_BAR; PG8_MMA(1, 0, At, B0); PG8_MMA(1, 1, At, B1); PG8_BAR; PG8_SCHED;
            } else {
            PG8_LDB(B0, 0, 0); PG8_SCHED; PG8_LDA(At, 0, 0); PG8_STAGE(PG8_SA(1, 1), a1 + hstep, voffA);
            PG8_WAIT_L(8); PG8_BAR; PG8_WAIT_L(0); PG8_MMA(0, 0, At, B0); PG8_BAR; PG8_SCHED;
            PG8_LDB(B1, 0, 1); PG8_STAGE(PG8_SB(0, 0), b2, voffB);
            PG8_BAR; PG8_WAIT_L(0); PG8_MMA(0, 1, At, B1); PG8_BAR;
            PG8_LDA(At, 0, 1); PG8_STAGE(PG8_SA(0, 0), a2, voffA);
            PG8_BAR; PG8_WAIT_L(0); PG8_MMA(1, 0, At, B0); PG8_BAR; PG8_SCHED;
            PG8_STAGE(PG8_SB(0, 1), b2 + hstep, voffB);
            PG8_WAIT_V(6); PG8_BAR; PG8_MMA(1, 1, At, B1); PG8_BAR;
            PG8_LDB(B0, 1, 0); PG8_SCHED; PG8_LDA(At, 1, 0); PG8_STAGE(PG8_SA(0, 1), a2 + hstep, voffA);
            PG8_WAIT_L(8); PG8_BAR; PG8_WAIT_L(0); PG8_MMA(0, 0, At, B0); PG8_BAR; PG8_SCHED;
            PG8_LDB(B1, 1, 1); PG8_STAGE(PG8_SB(1, 0), b3, voffB);
            PG8_BAR; PG8_WAIT_L(0); PG8_MMA(0, 1, At, B1); PG8_BAR;
            PG8_LDA(At, 1, 1); PG8_STAGE(PG8_SA(1, 0), a3, voffA);
            PG8_BAR; PG8_WAIT_L(0); PG8_MMA(1, 0, At, B0); PG8_BAR; PG8_SCHED;
            PG8_STAGE(PG8_SB(1, 1), b3 + hstep, voffB);
            PG8_WAIT_V(6); PG8_BAR; PG8_MMA(1, 1, At, B1); PG8_BAR;
            }
        }
        if constexpr (ALIGN_EPI) { if (wr == 0) PG8_BAR; }
        if constexpr (!Epi::AFTER_DRAIN) { E(acc, cur, ui, wr, wc, fr, fq); S.done(cur); }
        if (!has_next) break;
#pragma unroll
        for (int a = 0; a < 2; ++a)
#pragma unroll
            for (int b = 0; b < 2; ++b)
#pragma unroll
                for (int m = 0; m < 4; ++m)
#pragma unroll
                    for (int n = 0; n < 2; ++n) acc[a][b][m][n] = (f32x4){0.f, 0.f, 0.f, 0.f};
        cur = nxt; cA = nA; cB = nB; ++ui;
        if constexpr (ALIGN_EPI) { if (wr == 1) PG8_BAR; }
    }
    PG8_WAIT_V(0);
    if constexpr (!ALIGN_EPI) { if (wr == 0) PG8_BAR; }
    PG8_BAR;
    if constexpr (Epi::AFTER_DRAIN) { E.fused(acc, cur, wr, wc, fr, fq, lds, wid, lane); S.done(cur); }
#undef PG8_SA
#undef PG8_SB
#undef PG8_STAGE
#undef PG8_LDA
#undef PG8_LDB
#undef PG8_MMA
#undef PG8_WAIT_V
#undef PG8_WAIT_L
#undef PG8_BAR
#undef PG8_SCHED
}
}

#ifndef PG8_SP2
#define PG8_SP2 true
#endif
#ifndef PG8_ALIGN
#define PG8_ALIGN true
#endif
namespace attn2 {
using bf16 = unsigned short;
typedef short bf16x8 __attribute__((ext_vector_type(8)));
typedef short s16x4 __attribute__((ext_vector_type(4)));
typedef float f32x16 __attribute__((ext_vector_type(16)));
typedef unsigned u32x4 __attribute__((ext_vector_type(4)));
constexpr int SEQ = 8192, DQ = 64, DV = 128, PIN = 2816, POUT = 1024;
constexpr int NW = 8, QBLK = 32, KVBLK = 64, QB = NW * QBLK;
constexpr int SHM_V = KVBLK * DV * 2, SHM_K = KVBLK * DQ * 2;
constexpr int LDS_BYTES = 2 * SHM_V + 2 * SHM_K + NW * 64 * 4;
#ifndef A2_ILV
#define A2_ILV 1
#endif
constexpr float THR = 8.f;
constexpr float C2 = 0.125f * 1.4426950408889634f;
#define A2_KSWZ(row, colB) ((row) * 128 + ((colB) ^ ((((row) >> 1) & 7) << 4)))
#define A2_SBAR() __builtin_amdgcn_sched_barrier(0)
__device__ __forceinline__ int v_rd_base(int lane) { return ((lane & 3) << 3) | (((lane >> 2) & 3) << 6) | (((lane >> 4) & 1) << 5) | (((lane >> 5) & 1) << 8); }
constexpr int v_rd_off(int d0, int ks, int half) { return d0 * 512 + ks * 4096 + half * 2048; }
__device__ __forceinline__ int crow(int r, int hi) { return (r & 3) + 8 * (r >> 2) + 4 * hi; }
typedef float f32x2_a __attribute__((ext_vector_type(2))); typedef __bf16 bf16x2_a __attribute__((ext_vector_type(2)));
__device__ __forceinline__ unsigned cvtpk(float lo, float hi) { f32x2_a v = {lo, hi}; bf16x2_a b = __builtin_convertvector(v, bf16x2_a); return __builtin_bit_cast(unsigned, b); }
typedef short v4i16_t __attribute__((ext_vector_type(4)));
typedef __attribute__((address_space(3))) const char* lds_cptr;
__device__ __forceinline__ s16x4 vtr(lds_cptr p) { return __builtin_bit_cast(s16x4, __builtin_amdgcn_ds_read_tr16_b64_v4i16((__attribute__((address_space(3))) v4i16_t*)p)); }
template <int VB>
__device__ __forceinline__ void pv_tile(f32x16* o, int vb0, bf16x8 pa0, bf16x8 pa1, bf16x8 pa2, bf16x8 pa3, bool act) {
    if (!act) return;
#define A2_TRRD(dst, off) asm volatile("ds_read_b64_tr_b16 %0, %1 offset:%2" : "=&v"(dst) : "v"(vb0), "i"(off) : "memory")
#define A2_PV_D0(d0) do { s16x4 l0, l1, l2, l3, h0, h1, h2, h3; constexpr int b_ = VB * SHM_V + v_rd_off(d0, 0, 0); \
        A2_TRRD(l0, b_); A2_TRRD(h0, b_ + 2048); A2_TRRD(l1, b_ + 4096); A2_TRRD(h1, b_ + 6144); A2_TRRD(l2, b_ + 8192); A2_TRRD(h2, b_ + 10240); A2_TRRD(l3, b_ + 12288); A2_TRRD(h3, b_ + 14336); \
        asm volatile("s_waitcnt lgkmcnt(0)" ::: "memory"); A2_SBAR();   \
        o[d0] = __builtin_amdgcn_mfma_f32_32x32x16_bf16(pa0, (bf16x8){l0[0], l0[1], l0[2], l0[3], h0[0], h0[1], h0[2], h0[3]}, o[d0], 0, 0, 0);   \
        o[d0] = __builtin_amdgcn_mfma_f32_32x32x16_bf16(pa1, (bf16x8){l1[0], l1[1], l1[2], l1[3], h1[0], h1[1], h1[2], h1[3]}, o[d0], 0, 0, 0);   \
        o[d0] = __builtin_amdgcn_mfma_f32_32x32x16_bf16(pa2, (bf16x8){l2[0], l2[1], l2[2], l2[3], h2[0], h2[1], h2[2], h2[3]}, o[d0], 0, 0, 0);   \
        o[d0] = __builtin_amdgcn_mfma_f32_32x32x16_bf16(pa3, (bf16x8){l3[0], l3[1], l3[2], l3[3], h3[0], h3[1], h3[2], h3[3]}, o[d0], 0, 0, 0); } while (0)
    A2_PV_D0(0); A2_PV_D0(1); A2_PV_D0(2); A2_PV_D0(3);
#undef A2_PV_D0
#undef A2_TRRD
}
struct BlockRef { const bf16* Q; const bf16* K; const bf16* V; bf16* O; int P0; };
__device__ __forceinline__ BlockRef unit_ref(int vcu, int i, const bf16* P, bf16* O, int cq, int ck, int cv) {
    const int s = vcu & 7, hs = i >> 2, k = i & 3, hm = (vcu >> 3) + 32 * hs, qb = (k == 0) ? s : (k == 1) ? 15 - s : (k == 2) ? 16 + s : 31 - s;
    const int m = hm & 1, h = (hm >> 1) & 3, b = hm >> 3;
    const bf16* base = P + (size_t)b * SEQ * PIN;
    BlockRef r; r.Q = base + (size_t)qb * QB * PIN + cq + (2 * h + m) * 64; r.K = base + ck + (2 * h + m) * 64; r.V = base + cv + h * 128;
    r.O = O + ((size_t)b * SEQ + (size_t)qb * QB) * POUT + h * 256 + m * 128; r.P0 = qb * QB; return r;
}
template <int KB>
__device__ __forceinline__ void qkt_rel(f32x16& p0, f32x16& p1, const char* K_lds, int r32, int hi, const bf16x8* qr, const f32x16& negm, bool act) {
    if (!act) { const float NEG = -__builtin_inff();
#pragma unroll
        for (int r = 0; r < 16; ++r) { p0[r] = NEG; p1[r] = NEG; } return; }
#pragma unroll
    for (int d0 = 0; d0 < 4; ++d0) { const char* a = K_lds + KB * SHM_K + A2_KSWZ(r32, (d0 * 16 + hi * 8) * 2);
        bf16x8 b0 = *reinterpret_cast<const bf16x8*>(a);
        bf16x8 b1 = *reinterpret_cast<const bf16x8*>(a + 32 * 128);
        if (d0 == 0) { p0 = __builtin_amdgcn_mfma_f32_32x32x16_bf16(b0, qr[0], negm, 0, 0, 0); p1 = __builtin_amdgcn_mfma_f32_32x32x16_bf16(b1, qr[0], negm, 0, 0, 0); }
        else { p0 = __builtin_amdgcn_mfma_f32_32x32x16_bf16(b0, qr[d0], p0, 0, 0, 0); p1 = __builtin_amdgcn_mfma_f32_32x32x16_bf16(b1, qr[d0], p1, 0, 0, 0); } }
}
__device__ __forceinline__ void partialSM_rel(f32x16& p0, f32x16& p1, float& mhat, f32x16& negm, float& alpha, bool first) {
    float pmax = p0[0];
#pragma unroll
    for (int r = 1; r < 16; ++r) pmax = fmaxf(pmax, p0[r]);
#pragma unroll
    for (int r = 0; r < 16; ++r) pmax = fmaxf(pmax, p1[r]);
    { auto rr = __builtin_amdgcn_permlane32_swap(__float_as_uint(pmax), __float_as_uint(pmax), false, false);
      pmax = fmaxf(__uint_as_float(rr[0]), __uint_as_float(rr[1])); }
    alpha = 1.f;
    if (first || __any(pmax > THR)) { const float dl = first ? pmax : fmaxf(pmax, 0.f); mhat += dl;
#pragma unroll
        for (int r = 0; r < 16; ++r) { p0[r] -= dl; p1[r] -= dl; }
#pragma unroll
        for (int r = 0; r < 16; ++r) negm[r] = -mhat;
        asm volatile("" : "+v"(negm));
        if (!first) alpha = __builtin_amdgcn_exp2f(-dl); }
#pragma unroll
    for (int r = 0; r < 16; ++r) p0[r] = __builtin_amdgcn_exp2f(p0[r]);
}
typedef float f32x2_s __attribute__((ext_vector_type(2)));
__device__ __forceinline__ void finishSM2(f32x16& p0, f32x16& p1, float alpha, float& l_reg, bf16x8& pa0, bf16x8& pa1, bf16x8& pa2, bf16x8& pa3) {
#pragma unroll
    for (int r = 0; r < 16; ++r) p1[r] = __builtin_amdgcn_exp2f(p1[r]);
    f32x2_s sa = {p0[0], p0[1]}, sb = {p0[2], p0[3]};
#pragma unroll
    for (int r = 4; r < 16; r += 4) { sa += (f32x2_s){p0[r], p0[r + 1]}; sb += (f32x2_s){p0[r + 2], p0[r + 3]}; }
#pragma unroll
    for (int r = 0; r < 16; r += 4) { sa += (f32x2_s){p1[r], p1[r + 1]}; sb += (f32x2_s){p1[r + 2], p1[r + 3]}; }
    sa += sb; float ps = sa[0] + sa[1];
    { auto rr = __builtin_amdgcn_permlane32_swap(__float_as_uint(ps), __float_as_uint(ps), false, false);
      ps = __uint_as_float(rr[0]) + __uint_as_float(rr[1]); }
    l_reg = l_reg * alpha + ps;
#define A2_PK4(P, B_, OUT) do { u32x4 w = {cvtpk(P[B_+0], P[B_+1]), cvtpk(P[B_+2], P[B_+3]), cvtpk(P[B_+4], P[B_+5]), cvtpk(P[B_+6], P[B_+7])}; OUT = *reinterpret_cast<bf16x8*>(&w); } while (0)
    A2_PK4(p0, 0, pa0); A2_PK4(p0, 8, pa1); A2_PK4(p1, 0, pa2); A2_PK4(p1, 8, pa3);
#undef A2_PK4
}
constexpr int R_V = 0, R_K = 3 * SHM_V, R_WS = R_K + 3 * SHM_K, R_STG = R_WS + NW * 64 * 4, LDS3_BYTES = R_STG + NW * 4096;
typedef __attribute__((address_space(3))) unsigned char* lds_ptr;
#define A3_WAITBAR(N) asm volatile("s_waitcnt vmcnt(" #N ") lgkmcnt(0)\n\ts_barrier" ::: "memory")
struct Dma { const bf16* ks; const bf16* va; const bf16* vb; };
__device__ __forceinline__ Dma dma_src(const bf16* Kh, const bf16* Vh, int wid, int lane) {
    Dma d;
    { const int p = wid * 64 + lane, row = p >> 3, slot = p & 7, c = slot ^ ((row >> 1) & 7); d.ks = Kh + (size_t)row * PIN + c * 8; }
#pragma unroll
    for (int j = 0; j < 2; ++j) { const int st = (2 * wid + j) * 2 + (lane >> 5), kk = (st >> 2) * 8 + ((lane & 31) >> 2), c = (st & 3) * 32 + (lane & 3) * 8;
        const int key = kk;
        const bf16* p_ = Vh + (size_t)key * PIN + c; if (j == 0) d.va = p_; else d.vb = p_; }
    return d;
}
__device__ __forceinline__ void glds16(const void* gsrc, unsigned lds_dst) { unsigned keep;
    asm volatile("s_mov_b32 %0, m0\n\ts_mov_b32 m0, %2\n\ts_nop 0\n\tglobal_load_lds_dwordx4 %1, off\n\ts_mov_b32 m0, %0" : "=&s"(keep) : "v"(gsrc), "s"(lds_dst) : "memory"); }
#define A3_DMA_K(D, t, slot) glds16((D).ks + (size_t)(t) * KVBLK * PIN, (unsigned)__builtin_amdgcn_readfirstlane(lds0 + R_K + (slot) * SHM_K + wid * 1024))
#define A3_DMA_V(D, t, slot) do { glds16((D).va + (size_t)(t) * KVBLK * PIN, (unsigned)__builtin_amdgcn_readfirstlane(lds0 + R_V + (slot) * SHM_V + wid * 2048)); \
                                  glds16((D).vb + (size_t)(t) * KVBLK * PIN, (unsigned)__builtin_amdgcn_readfirstlane(lds0 + R_V + (slot) * SHM_V + wid * 2048 + 1024)); } while (0)
struct Seam3 { bf16x8 qr[4]; };
__device__ __forceinline__ void prime3(const BlockRef& cur, char* lds, Seam3& S) {
    int tid_ = threadIdx.x; asm volatile("" : "+v"(tid_));
    const int tid = tid_, wid = __builtin_amdgcn_readfirstlane(tid >> 6), lane = tid & 63, r32 = lane & 31, hi = lane >> 5;
    const unsigned lds0 = (unsigned)(uintptr_t)lds;
    const Dma D = dma_src(cur.K, cur.V, wid, lane);
    A3_DMA_K(D, 0, 0); A3_DMA_K(D, 1, 1); A2_SBAR();
#pragma unroll
    for (int d0 = 0; d0 < 4; ++d0) S.qr[d0] = *(const bf16x8*)(cur.Q + (size_t)(wid * QBLK + r32) * PIN + d0 * 16 + hi * 8);
    A2_SBAR();
    A3_WAITBAR(5);
    A3_DMA_V(D, 0, 0);
}
__device__ __forceinline__ void block3(const BlockRef& cur, const BlockRef& nxt, char* lds, Seam3& S) {
    int tid_ = threadIdx.x; asm volatile("" : "+v"(tid_));
    const int tid = tid_, wid = __builtin_amdgcn_readfirstlane(tid >> 6), lane = tid & 63, r32 = lane & 31, hi = lane >> 5;
    const int NT = (cur.P0 + QB) / KVBLK;
    const int wchunk = (cur.P0 + wid * QBLK) >> 6;
    const unsigned lds0 = (unsigned)(uintptr_t)lds;
    char* V_lds = lds + R_V; char* K_lds = lds + R_K;
    float* ws = (float*)(lds + R_WS) + wid * 64; float* li_l = ws, * al_l = ws + 32;
    float mhat = 0.f, l_reg = 0; f32x16 o[4] = {}; f32x16 negm = {}; asm volatile("" : "+v"(negm));
    const int vb0 = (int)(uintptr_t)V_lds + v_rd_base(lane);
    const lds_cptr vb3 = (lds_cptr)V_lds + v_rd_base(lane);
    const Dma D = dma_src(cur.K, cur.V, wid, lane);
    int s0 = 0, s1 = 1, s2 = 2;
#define A3_ROT() do { const int t_ = s0; s0 = s1; s1 = s2; s2 = t_; } while (0)
#define A2_RESC(a) do { if (__any((a) < 1.f)) { if (hi == 0) al_l[r32] = (a); asm volatile("s_waitcnt lgkmcnt(0)" ::: "memory");              \
                     _Pragma("unroll") for (int d_ = 0; d_ < 4; ++d_) _Pragma("unroll") for (int r = 0; r < 16; ++r) o[d_][r] *= al_l[crow(r, hi)]; } } while (0)
#define A2_ACT(t) ((t) <= wchunk)
    f32x16 pA0, pA1, pB0, pB1; float mnA, mnB, alA, alB; bf16x8 pa0, pa1, pa2, pa3;
    A2_SBAR(); qkt_rel<0>(pA0, pA1, K_lds, r32, hi, S.qr, negm, true);
    A3_DMA_K(D, 2, 2); A3_DMA_V(D, 1, 1);
    partialSM_rel(pA0, pA1, mhat, negm, alA, true);
    A2_SBAR(); A3_WAITBAR(3);
#define A2_VFR(i) (bf16x8){vl[(i) & 3][0], vl[(i) & 3][1], vl[(i) & 3][2], vl[(i) & 3][3], vh[(i) & 3][0], vh[(i) & 3][1], vh[(i) & 3][2], vh[(i) & 3][3]}
#define A2_VRD(i, VBP) do { vl[(i) & 3] = vtr((VBP) + ((i) & 3) * 512 + ((i) >> 2) * 4096); vh[(i) & 3] = vtr((VBP) + ((i) & 3) * 512 + ((i) >> 2) * 4096 + 2048); } while (0)
#define A2_PAK(i) (((i) >> 2) == 0 ? pa0 : ((i) >> 2) == 1 ? pa1 : ((i) >> 2) == 2 ? pa2 : pa3)
#define A2_GAP(i, PX0, PX1, mnX, alX, VBP) do {                                                                               \
        if ((i) + 2 < 16) A2_VRD((i) + 2, VBP);                                                                               \
        o[(i) & 3] = __builtin_amdgcn_mfma_f32_32x32x16_bf16(A2_PAK(i), A2_VFR(i), o[(i) & 3], 0, 0, 0);                     \
        if ((i) < 4) { const int j_ = 4 * (i);                                                                               \
            if ((i) == 0) { mxa = __builtin_fmaxf(PX0[0], PX0[1]); mxb = __builtin_fmaxf(PX0[2], PX0[3]); }                  \
            else { mxa = __builtin_fmaxf(__builtin_fmaxf(mxa, PX0[j_]), PX0[j_ + 1]); mxb = __builtin_fmaxf(__builtin_fmaxf(mxb, PX0[j_ + 2]), PX0[j_ + 3]); } \
            mxa = __builtin_fmaxf(__builtin_fmaxf(mxa, PX1[j_]), PX1[j_ + 1]); mxb = __builtin_fmaxf(__builtin_fmaxf(mxb, PX1[j_ + 2]), PX1[j_ + 3]);         \
            asm volatile("" : "+v"(mxa), "+v"(mxb)); }                                                                       \
        else if ((i) == 4) { float pmax = __builtin_fmaxf(mxa, mxb);                                                         \
            { auto rr = __builtin_amdgcn_permlane32_swap(__float_as_uint(pmax), __float_as_uint(pmax), false, false); pmax = __builtin_fmaxf(__uint_as_float(rr[0]), __uint_as_float(rr[1])); } \
            alX = 1.f;                                                                                                       \
            if (__builtin_expect(__any(pmax > THR), 0)) { const float dl_ = __builtin_fmaxf(pmax, 0.f); mhat += dl_;          \
                _Pragma("unroll") for (int r_ = 0; r_ < 16; ++r_) { PX0[r_] -= dl_; PX1[r_] -= dl_; }                         \
                _Pragma("unroll") for (int r_ = 0; r_ < 16; ++r_) negm[r_] = -mhat;                                           \
                asm volatile("" : "+v"(negm)); alX = __builtin_amdgcn_exp2f(-dl_); }                                          \
            asm volatile("" : "+v"(alX), "+v"(PX0), "+v"(PX1)); }                                                            \
        else if ((i) < 13) { const int k_ = 2 * ((i) - 5);                                                                   \
            PX0[k_] = __builtin_amdgcn_exp2f(PX0[k_]); PX0[k_ + 1] = __builtin_amdgcn_exp2f(PX0[k_ + 1]);                     \
            asm volatile("" : "+v"(PX0)); }                                                                                  \
        A2_SBAR(); } while (0)
#define A2_PVSM(PX0, PX1, mnX, alX, VBP) do { s16x4 vl[4], vh[4]; float mxa, mxb;                                             \
        A2_VRD(0, VBP); A2_VRD(1, VBP); A2_SBAR();                                                                             \
        A2_GAP(0, PX0, PX1, mnX, alX, VBP); A2_GAP(1, PX0, PX1, mnX, alX, VBP); A2_GAP(2, PX0, PX1, mnX, alX, VBP); A2_GAP(3, PX0, PX1, mnX, alX, VBP);       \
        A2_GAP(4, PX0, PX1, mnX, alX, VBP); A2_GAP(5, PX0, PX1, mnX, alX, VBP); A2_GAP(6, PX0, PX1, mnX, alX, VBP); A2_GAP(7, PX0, PX1, mnX, alX, VBP);       \
        A2_GAP(8, PX0, PX1, mnX, alX, VBP); A2_GAP(9, PX0, PX1, mnX, alX, VBP); A2_GAP(10, PX0, PX1, mnX, alX, VBP); A2_GAP(11, PX0, PX1, mnX, alX, VBP);     \
        A2_GAP(12, PX0, PX1, mnX, alX, VBP); A2_GAP(13, PX0, PX1, mnX, alX, VBP); A2_GAP(14, PX0, PX1, mnX, alX, VBP); A2_GAP(15, PX0, PX1, mnX, alX, VBP);   \
    } while (0)
#define A2_SG(mask, n) __builtin_amdgcn_sched_group_barrier(mask, n, 0)
#define A3_FAST_STEP(PX0, PX1, mnX, alX, PY0, PY1, alY, t) do {                                                      \
        A2_SBAR(); qkt_rel<0>(PX0, PX1, K_lds + s1 * SHM_K, r32, hi, S.qr, negm, true);                                             \
        finishSM2(PY0, PY1, alY, l_reg, pa0, pa1, pa2, pa3);                                                           \
        A3_DMA_K(D, (t) + 2, s0); A3_DMA_V(D, (t) + 1, s2);                                               \
        asm volatile("" : "+v"(pa0), "+v"(pa1), "+v"(pa2), "+v"(pa3), "+v"(l_reg)); asm volatile("" : "+v"(PX0), "+v"(PX1));         \
        A2_SG(0x100, 4); _Pragma("unroll") for (int g_ = 0; g_ < 8; ++g_) { A2_SG(0x008, 1); A2_SG(0x002, 5); A2_SG(0x400, 2); A2_SG(0x100, 1); }      \
        A2_SBAR();                                                                                                            \
        { const lds_cptr vbs_ = vb3 + s0 * SHM_V; A2_PVSM(PX0, PX1, mnX, alX, vbs_); }                                        \
        A2_SBAR(); A2_RESC(alX);                                                                                              \
        A3_WAITBAR(3); A3_ROT(); } while (0)
#define A3_BAND_STEP(PX0, PX1, mnX, alX, PY0, PY1, alY, t) do {                                                      \
        f32x16 cn_ = negm; if (!A2_ACT(t)) { _Pragma("unroll") for (int r_ = 0; r_ < 16; ++r_) cn_[r_] = -__builtin_inff(); }   \
        A2_SBAR(); qkt_rel<0>(PX0, PX1, K_lds + s1 * SHM_K, r32, hi, S.qr, cn_, true);                                             \
        finishSM2(PY0, PY1, alY, l_reg, pa0, pa1, pa2, pa3);                                                           \
        if ((t) + 2 < NT) A3_DMA_K(D, (t) + 2, s0);                                                                           \
        if ((t) + 1 < NT) A3_DMA_V(D, (t) + 1, s2);                                                                           \
        asm volatile("" : "+v"(pa0), "+v"(pa1), "+v"(pa2), "+v"(pa3), "+v"(l_reg)); asm volatile("" : "+v"(PX0), "+v"(PX1));         \
        A2_SBAR();                                                                                                            \
        { const lds_cptr vbs_ = vb3 + s0 * SHM_V; A2_PVSM(PX0, PX1, mnX, alX, vbs_); }                                        \
        A2_SBAR(); A2_RESC(alX);                                                                                              \
        if ((t) + 2 < NT) A3_WAITBAR(3); else if ((t) + 1 < NT) A3_WAITBAR(2); else A3_WAITBAR(0);                            \
        A3_ROT(); } while (0)
    int t = 1;
    for (; t + 1 < NT - 4; t += 2) {
        A3_FAST_STEP(pB0, pB1, mnB, alB, pA0, pA1, alA, t);
        A3_FAST_STEP(pA0, pA1, mnA, alA, pB0, pB1, alB, t + 1);
    }
    for (; t + 1 < NT; t += 2) {
        A3_BAND_STEP(pB0, pB1, mnB, alB, pA0, pA1, alA, t);
        A3_BAND_STEP(pA0, pA1, mnA, alA, pB0, pB1, alB, t + 1);
    }
    A2_SBAR(); qkt_rel<0>(pB0, pB1, K_lds + s1 * SHM_K, r32, hi, S.qr, negm, A2_ACT(NT - 1));
    finishSM2(pA0, pA1, alA, l_reg, pa0, pa1, pa2, pa3); A2_SBAR();
    pv_tile<0>(o, vb0 + s0 * SHM_V, pa0, pa1, pa2, pa3, A2_ACT(NT - 2)); partialSM_rel(pB0, pB1, mhat, negm, alB, false);
    A2_SBAR(); A2_RESC(alB);
    A3_WAITBAR(0);
    const Dma Dn = dma_src(nxt.K, nxt.V, wid, lane);
    A3_DMA_K(Dn, 0, 0); A3_DMA_K(Dn, 1, 1); A2_SBAR();
#pragma unroll
    for (int d0 = 0; d0 < 4; ++d0) S.qr[d0] = *(const bf16x8*)(nxt.Q + (size_t)(wid * QBLK + r32) * PIN + d0 * 16 + hi * 8);
    A2_SBAR();
    finishSM2(pB0, pB1, alB, l_reg, pa0, pa1, pa2, pa3); A2_SBAR(); pv_tile<0>(o, vb0 + s1 * SHM_V, pa0, pa1, pa2, pa3, A2_ACT(NT - 1));
    A2_SBAR();
    if (hi == 0) li_l[r32] = l_reg; asm volatile("s_waitcnt lgkmcnt(0)" ::: "memory");
    float rli[16];
#pragma unroll
    for (int r = 0; r < 16; ++r) rli[r] = __builtin_amdgcn_rcpf(li_l[crow(r, hi)]);
    A2_SBAR();
    asm volatile("s_waitcnt vmcnt(5)" ::: "memory");
    A2_SBAR();
    bf16* Ow = cur.O + (size_t)(wid * QBLK) * POUT;
    { unsigned short* stg = (unsigned short*)(lds + R_STG) + wid * 2048;
#pragma unroll
      for (int pass = 0; pass < 2; ++pass) {
#pragma unroll
          for (int r = 0; r < 16; r += 2) { const int ra = crow(r, hi), rb = crow(r + 1, hi);
#pragma unroll
              for (int dd = 0; dd < 2; ++dd) { const unsigned w = cvtpk(o[2 * pass + dd][r] * rli[r], o[2 * pass + dd][r + 1] * rli[r + 1]);
                  stg[ra * 64 + dd * 32 + r32] = (unsigned short)(w & 0xffffu); stg[rb * 64 + dd * 32 + r32] = (unsigned short)(w >> 16); } }
          asm volatile("s_waitcnt lgkmcnt(0)" ::: "memory");
#pragma unroll
          for (int i = 0; i < 4; ++i) { const int row = i * 8 + (lane >> 3), ch = lane & 7; const u32x4 v = *(const u32x4*)(stg + row * 64 + ch * 8);
              *(u32x4*)(Ow + (size_t)row * POUT + pass * 64 + ch * 8) = v; }
          asm volatile("s_waitcnt lgkmcnt(0)" ::: "memory");
      } }
    A2_SBAR();
    asm volatile("s_waitcnt lgkmcnt(0)\n\ts_barrier" ::: "memory");
    A3_DMA_V(Dn, 0, 0);
#undef A3_ROT
#undef A2_RESC
#undef A2_ACT
#undef A2_VFR
#undef A2_VRD
#undef A2_PAK
#undef A2_GAP
#undef A2_PVSM
#undef A2_SG
#undef A3_FAST_STEP
#undef A3_BAND_STEP
}
__device__ __forceinline__ void attn_phase3(char* lds, const bf16* P, bf16* O, int vcu, int cq, int ck, int cv) {
    Seam3 S; BlockRef cur = unit_ref(vcu, 0, P, O, cq, ck, cv);
    prime3(cur, lds, S);
    for (int i = 0; i < 8; ++i) { const BlockRef nxt = (i + 1 < 8) ? unit_ref(vcu, i + 1, P, O, cq, ck, cv) : cur;
        block3(cur, nxt, lds, S); cur = nxt; }
    asm volatile("s_waitcnt vmcnt(0)\n\ts_barrier" ::: "memory");
}
#undef A2_KSWZ
#undef A2_SBAR
#undef A2_VMW
#undef A2_VMWN
#undef A2_SLOAD
#undef A2_SWRITE_K
#undef A2_SWRITE_V
}
#define GAS __attribute__((address_space(1)))
#define LAS __attribute__((address_space(3)))
typedef unsigned short bf16;
typedef unsigned v4u __attribute__((ext_vector_type(4)));
typedef float f32x4 __attribute__((ext_vector_type(4)));
typedef short bf16x8 __attribute__((ext_vector_type(8)));
typedef GAS unsigned gu32;
typedef GAS unsigned long long gu64;
#define RLX_AGENT __ATOMIC_RELAXED, __HIP_MEMORY_SCOPE_AGENT
#define LDS_WAIT() asm volatile("s_waitcnt lgkmcnt(0)" ::: "memory")
#define VM_WAIT() asm volatile("s_waitcnt vmcnt(0)" ::: "memory")
__device__ __forceinline__ unsigned long long rt() { return __builtin_amdgcn_s_memrealtime(); }
__device__ __forceinline__ unsigned f2bf(float f) { unsigned u = __builtin_bit_cast(unsigned, f); return (u + 0x7fffu + ((u >> 16) & 1u)) >> 16; }
__device__ __forceinline__ unsigned pk2(float lo, float hi) { return f2bf(lo) | (f2bf(hi) << 16); }

#define XB_TMO      128
#define XB_XCNT(j)  (256  + 64 * (j))
#define XB_XSUB(j)  (1280 + 64 * (j))
#define XB_XGEN(j)  (2304 + 64 * (j))
#define XB_TOP      3328
#define XB_TOPGEN   3392
#define XCD_BAR_WORDS 3456
#define XB_SPIN_CAP (1u << 18)

__device__ __forceinline__ unsigned xb_ld(unsigned* p)              { return __hip_atomic_load(p, __ATOMIC_RELAXED, __HIP_MEMORY_SCOPE_AGENT); }
__device__ __forceinline__ unsigned xb_add(unsigned* p, unsigned v) { return __hip_atomic_fetch_add(p, v, __ATOMIC_RELAXED, __HIP_MEMORY_SCOPE_AGENT); }
__device__ __forceinline__ unsigned xb_xcc_id() { return (unsigned)__builtin_amdgcn_s_getreg((3 << 11) | 20) & 0xFu; }
#define XB_SPIN(cond, bar) do { unsigned _sp = 0; while (cond) { __builtin_amdgcn_s_sleep(1); \
    if ((++_sp & 255u) == 0u) { if (xb_ld(&(bar)[XB_TMO])) break; if (_sp > XB_SPIN_CAP) { atomicAdd(&(bar)[XB_TMO], 1u); break; } } } } while (0)

struct XcdBarrier {
    unsigned* bar; unsigned x;
    volatile LAS unsigned* st;
};

__device__ __forceinline__ XcdBarrier xcd_barrier_post(unsigned* bar, volatile LAS unsigned* st) {
    XcdBarrier b; b.bar = bar; b.x = xb_xcc_id(); b.st = st;
    if (threadIdx.x == 0) (void)xb_add(&bar[XB_XCNT(b.x)], 1u);
    return b;
}
__device__ __forceinline__ void xcd_barrier_complete(unsigned* bar, unsigned x, unsigned& nloc, unsigned& nx) {
    const unsigned G = gridDim.x * gridDim.y * gridDim.z;
    unsigned sum, cnt, mine, sp = 0u;
    for (;;) {
        sum = 0u; cnt = 0u; mine = 0u;
#pragma unroll
        for (unsigned j = 0; j < 16; ++j) { const unsigned c = xb_ld(&bar[XB_XCNT(j)]); sum += c; cnt += (c > 0u) ? 1u : 0u; mine = (j == x) ? c : mine; }
        if (sum == G) break;
        __builtin_amdgcn_s_sleep(1);
        if ((++sp & 255u) == 0u) { if (xb_ld(&bar[XB_TMO])) break; if (sp > XB_SPIN_CAP) { atomicAdd(&bar[XB_TMO], 1u); break; } }
    }
    nloc = mine > 0u ? mine : 1u; nx = cnt > 0u ? cnt : 1u;
}

__device__ __forceinline__ void xcd_barrier(const XcdBarrier& b) {
    asm volatile("s_waitcnt vmcnt(0)" ::: "memory");
    __syncthreads();
    if (threadIdx.x == 0) {
        unsigned* bar = b.bar;
        __builtin_amdgcn_s_waitcnt(0);
        unsigned nloc = b.st[0], nx = b.st[1];
        if (nloc == 0u) { xcd_barrier_complete(bar, b.x, nloc, nx); b.st[0] = nloc; b.st[1] = nx; }
        const unsigned old = xb_add(&bar[XB_XSUB(b.x)], 1u);
        const unsigned gen = old / nloc;
        if (old + 1u == (gen + 1u) * nloc) {
            __builtin_amdgcn_fence(__ATOMIC_RELEASE, "agent");
            asm volatile("s_waitcnt vmcnt(0)" ::: "memory");
            const unsigned og = xb_add(&bar[XB_TOP], 1u);
            const unsigned tg = og / nx;
            if (og + 1u == (tg + 1u) * nx) xb_add(&bar[XB_TOPGEN], 1u);
            else XB_SPIN(xb_ld(&bar[XB_TOPGEN]) == tg, bar);
            __builtin_amdgcn_fence(__ATOMIC_ACQUIRE, "agent");
            xb_add(&bar[XB_XGEN(b.x)], 1u);
            asm volatile("s_waitcnt vmcnt(0)" ::: "memory");
        } else {
            XB_SPIN(xb_ld(&bar[XB_XGEN(b.x)]) == gen, bar);
            __builtin_amdgcn_fence(__ATOMIC_ACQUIRE, "agent");
            asm volatile("s_waitcnt vmcnt(0)" ::: "memory");
        }
    }
    __syncthreads();
}

constexpr int NWAVES = 8;
#ifndef MK_PER_PHASE
#define MK_PER_PHASE 0
#endif

constexpr int BATCH = 8, SEQ = 8192, D = 1024, FF = 4096, DEPTH = 2;
constexpr int M = BATCH * SEQ;
constexpr int CHUNK = 64, NCH = SEQ / CHUNK;
constexpr int NP_SRC = 2576;
constexpr int NP = 2816;
constexpr int C_POOL = 0, C_DQ = 256, C_DK = 768, C_DV = 1280, C_GQ = 1792, C_GK = 1920, C_GV = 2048, C_GR = 2304, C_GG = 2560;
constexpr float EPS = 1e-6f;
static_assert(NP == attn2::PIN && D == attn2::POUT && attn2::LDS_BYTES <= 131072 && attn2::LDS3_BYTES <= 131072, "attention body geometry");

constexpr size_t MiB = 1u << 20;
constexpr size_t WS_CTL = 0, CTL_ZERO_BYTES = 1 * MiB;
constexpr size_t WS_WPOOL = 1 * MiB;
constexpr size_t WS_W = 2 * MiB, W_LAYER = 24 * MiB;
constexpr size_t WO_IN = 0, WO_OUT = 6 * MiB, WO_1 = 8 * MiB, WO_2 = 16 * MiB;
constexpr size_t WS_SSA = 50 * MiB, WS_SSB = 54 * MiB;
constexpr size_t WS_GDEC = 58 * MiB;
constexpr size_t WS_GKV = 60 * MiB;
constexpr size_t WS_HB = 96 * MiB;
constexpr size_t WS_PROJ = 224 * MiB;
constexpr size_t WS_OATT = 576 * MiB;
constexpr size_t WS_MIX = 704 * MiB;
constexpr size_t WS_HID = 224 * MiB;
constexpr size_t WS_END = 832 * MiB;
static_assert(WS_W + DEPTH * W_LAYER <= WS_SSA && WS_GKV + (size_t)BATCH * 4 * NCH * 2048 * 4 <= WS_HB && WS_HB + (size_t)M * D * 2 <= WS_PROJ && WS_PROJ + (size_t)M * NP * 2 <= WS_OATT && WS_HID + (size_t)M * FF * 2 <= WS_END, "d_ws map");
constexpr int CW_TMO = 0, CW_CODE = 1;
constexpr int CW_BAR = 4096;

constexpr int RING_OFF = 0, RING_BYTES = 131072;
constexpr int LDSCTL_OFF = RING_BYTES, MISC_OFF = LDSCTL_OFF + 320;
constexpr int RST_OFF = MISC_OFF + 128, RST_MAXU = 16;
constexpr int LDS_BYTES = 155648;
static_assert(RST_OFF % 16 == 0 && RST_OFF + RST_MAXU * 256 * 4 <= LDS_BYTES, "LDS map");

struct Frame {
    LAS unsigned char* lds;
    volatile LAS unsigned* MISC;
    gu32* ctl;
    int tid, lane, wave;
    int vcu, G;
};
typedef float f32x16 __attribute__((ext_vector_type(16)));
typedef unsigned u32x2v __attribute__((ext_vector_type(2)));
__device__ __forceinline__ float wave_sum(float v) {
#pragma unroll
    for (int o = 1; o < 64; o <<= 1) v += __shfl_xor(v, o);
    return v;
}
__device__ __forceinline__ float bf2f(unsigned short b) { return __uint_as_float((unsigned)b << 16); }
typedef float f32x2_c __attribute__((ext_vector_type(2))); typedef __bf16 bf16x2_c __attribute__((ext_vector_type(2)));
__device__ __forceinline__ unsigned cvtpk(float lo, float hi) { f32x2_c v = {lo, hi}; bf16x2_c b = __builtin_convertvector(v, bf16x2_c); return __builtin_bit_cast(unsigned, b); }
__device__ __forceinline__ bf16x8 pack8(const float (&v)[8]) { v4u w; w.x = cvtpk(v[0], v[1]); w.y = cvtpk(v[2], v[3]); w.z = cvtpk(v[4], v[5]); w.w = cvtpk(v[6], v[7]); return __builtin_bit_cast(bf16x8, w); }
__device__ __forceinline__ void unpack8(v4u w, float (&v)[8]) {
    v[0] = __uint_as_float(w.x << 16); v[1] = __uint_as_float(w.x & 0xffff0000u); v[2] = __uint_as_float(w.y << 16); v[3] = __uint_as_float(w.y & 0xffff0000u);
    v[4] = __uint_as_float(w.z << 16); v[5] = __uint_as_float(w.z & 0xffff0000u); v[6] = __uint_as_float(w.w << 16); v[7] = __uint_as_float(w.w & 0xffff0000u); }
__device__ __forceinline__ int crow(int r, int hi) { return (r & 3) + 8 * (r >> 2) + 4 * hi; }
__device__ __forceinline__ float logsig(float x) { return __builtin_fminf(x, 0.f) - __logf(1.f + __expf(-__builtin_fabsf(x))); }

__device__ __forceinline__ void p0_item_out(bf16* WT, int K, int row_off, int k0, int n0, LAS float* scr, int lane) {
    LDS_WAIT(); asm volatile("" ::: "memory");
    const int c = lane & 7;
#pragma unroll
    for (int j = 0; j < 4; ++j) { const int n = (lane >> 3) + 8 * j; const LAS float* s = scr + (8 * c) * 33 + n;
        v4u o; o.x = pk2(s[0 * 33], s[1 * 33]); o.y = pk2(s[2 * 33], s[3 * 33]); o.z = pk2(s[4 * 33], s[5 * 33]); o.w = pk2(s[6 * 33], s[7 * 33]);
        *(GAS v4u*)(WT + (size_t)(row_off + n0 + n) * K + k0 + 8 * c) = o; }
    LDS_WAIT(); asm volatile("" ::: "memory");
}
__device__ __forceinline__ void p0_transpose_item(const float* W, int K, int ldw, int col_off, int ncols, const float* gk, bf16* WT, int row_off, LAS float* scr, int item, int lane) {
    const int nblk = ncols / 32, kb = item / nblk, nb = item % nblk, k0 = 64 * kb, n0 = 32 * nb;
    const int kr = lane >> 3, nc = (lane & 7) * 4;
    f32x4 v[8]; float g[8];
#pragma unroll
    for (int j = 0; j < 8; ++j) { v[j] = *(const GAS f32x4*)(W + (size_t)(k0 + 8 * j + kr) * ldw + col_off + n0 + nc); g[j] = gk ? gk[k0 + 8 * j + kr] : 1.f; }
#pragma unroll
    for (int j = 0; j < 8; ++j) { LAS float* d = scr + (8 * j + kr) * 33 + nc; d[0] = v[j][0] * g[j]; d[1] = v[j][1] * g[j]; d[2] = v[j][2] * g[j]; d[3] = v[j][3] * g[j]; }
    p0_item_out(WT, K, row_off, k0, n0, scr, lane);
}
__device__ __forceinline__ void p0_gate_item(const float* Win, const float* wg2, const float* gk, bf16* WT, int row_off, LAS float* scr, int item, int lane) {
    const int kb = item / 4, nb = item % 4, k0 = 64 * kb, n0 = 32 * nb; const int c = n0 + (lane & 31);
    float w2[16];
#pragma unroll
    for (int r = 0; r < 16; ++r) w2[r] = wg2[r * 128 + c];
#pragma unroll 4
    for (int i = 0; i < 32; ++i) { const int kk = 2 * i + (lane >> 5); const float* wr_ = Win + (size_t)(k0 + kk) * NP_SRC + C_GG; float a = 0.f;
#pragma unroll
        for (int r = 0; r < 16; ++r) a += wr_[r] * w2[r];
        scr[kk * 33 + (lane & 31)] = a * gk[k0 + kk]; }
    p0_item_out(WT, D, row_off, k0, n0, scr, lane);
}
template <int R> __device__ __forceinline__ void x_rows_to_bf16(const float* x, bf16* hb, float* ss, int row0, int rstride, int lane) {
    f32x4 v[R][4];
#pragma unroll
    for (int r = 0; r < R; ++r) { const GAS f32x4* xr = (const GAS f32x4*)(x + (size_t)(row0 + r * rstride) * D) + lane;
#pragma unroll
        for (int j = 0; j < 4; ++j) v[r][j] = xr[64 * j]; }
#pragma unroll
    for (int r = 0; r < R; ++r) { float s2 = 0.f;
#pragma unroll
        for (int j = 0; j < 4; ++j) s2 += (v[r][j].x * v[r][j].x + v[r][j].y * v[r][j].y) + (v[r][j].z * v[r][j].z + v[r][j].w * v[r][j].w);
        s2 = wave_sum(s2);
        GAS unsigned long long* o8 = (GAS unsigned long long*)(hb + (size_t)(row0 + r * rstride) * D) + lane;
#pragma unroll
        for (int j = 0; j < 4; ++j) o8[64 * j] = (unsigned long long)pk2(v[r][j].x, v[r][j].y) | ((unsigned long long)pk2(v[r][j].z, v[r][j].w) << 32);
        if (lane < 16) ss[(size_t)(row0 + r * rstride) * 16 + lane] = (lane == 0) ? s2 : 0.f; }
}

struct Inputs {
    const float *x, *norm1_g, *w_in, *pool_w, *pool_scale, *lq1, *lk1, *lq2, *lk2, *diff_norm_g, *w_gate2, *b_gate, *gla_norm_g, *w_out, *norm2_g, *w_mlp1, *w_mlp2, *final_g;
};

__device__ __forceinline__ void p0_prologue(Frame& F, const Inputs& I, unsigned char* ws) {
    LAS float* scr = (LAS float*)(F.lds + RING_OFF + F.wave * 16384);
    const int gw = F.vcu * NWAVES + F.wave, NGW = F.G * NWAVES;
    constexpr int I_IN = (D / 64) * (2560 / 32), I_G = (D / 64) * 4, I_O = (D / 64) * (D / 32), I_1 = (D / 64) * (FF / 32), I_2 = (FF / 64) * (D / 32);
    constexpr int NIT = I_IN + I_G + I_O + I_1 + I_2;
    for (int it = gw; it < DEPTH * NIT; it += NGW) {
        const int l = it / NIT; int r = it % NIT;
        unsigned char* wl = ws + WS_W + (size_t)l * W_LAYER;
        const float* win = I.w_in + (size_t)l * D * NP_SRC; const float* g1 = I.norm1_g + l * D; const float* g2 = I.norm2_g + l * D;
        if (r < I_IN) { p0_transpose_item(win, D, NP_SRC, 0, 2560, g1, (bf16*)(wl + WO_IN), 0, scr, r, F.lane); continue; } r -= I_IN;
        if (r < I_G) { p0_gate_item(win, I.w_gate2 + (size_t)l * 16 * 128, g1, (bf16*)(wl + WO_IN), C_GG, scr, r, F.lane); continue; } r -= I_G;
        if (r < I_O) { p0_transpose_item(I.w_out + (size_t)l * D * D, D, D, 0, D, nullptr, (bf16*)(wl + WO_OUT), 0, scr, r, F.lane); continue; } r -= I_O;
        if (r < I_1) { p0_transpose_item(I.w_mlp1 + (size_t)l * D * FF, D, FF, 0, FF, g2, (bf16*)(wl + WO_1), 0, scr, r, F.lane); continue; } r -= I_1;
        p0_transpose_item(I.w_mlp2 + (size_t)l * FF * D, FF, D, 0, D, nullptr, (bf16*)(wl + WO_2), 0, scr, r, F.lane);
    }
    { const int gt = F.vcu * (NWAVES * 64) + F.tid, NT_ = F.G * NWAVES * 64;
      for (int i = gt; i < DEPTH * 16384; i += NT_) { const int l = i / 16384, o = i % 16384;
          *(GAS v4u*)(ws + WS_W + (size_t)l * W_LAYER + WO_IN + (size_t)2688 * D * 2 + (size_t)o * 16) = (v4u){0u, 0u, 0u, 0u}; }
      for (int i = gt; i < DEPTH * 4 * 64 * 64; i += NT_) { const int ch = i & 63, d = (i >> 6) & 63, lg = i >> 12;
          ((bf16*)(ws + WS_WPOOL))[i] = (bf16)f2bf(I.pool_w[(size_t)lg * 4096 + ch * 64 + d]); } }
    { int m = gw; for (; m + 3 * NGW < M; m += 4 * NGW) x_rows_to_bf16<4>(I.x, (bf16*)(ws + WS_HB), (float*)(ws + WS_SSB), m, NGW, F.lane);
      for (; m < M; m += NGW) x_rows_to_bf16<1>(I.x, (bf16*)(ws + WS_HB), (float*)(ws + WS_SSB), m, NGW, F.lane); }
}

__device__ __forceinline__ void gla_scan(float* GKV, const float* GDEC, int gtid, int nthreads) {
    for (int id = gtid; id < BATCH * 4 * 2048; id += nthreads) {
        const int bh = id >> 11, ed = id & 2047;
        float* p = GKV + (size_t)bh * NCH * 2048 + ed; const float* dp = GDEC + (size_t)bh * NCH * 32 + (ed & 31);
        float s = 0.f;
#pragma unroll 1
        for (int n0 = 0; n0 < NCH; n0 += 16) {
            float kv[16], dc[16];
#pragma unroll
            for (int i = 0; i < 16; ++i) { kv[i] = p[(size_t)(n0 + i) * 2048]; dc[i] = dp[(n0 + i) * 32]; }
#pragma unroll
            for (int i = 0; i < 16; ++i) { p[(size_t)(n0 + i) * 2048] = s; s = s * dc[i] + kv[i]; }
        }
    }
}
constexpr int PA_PP = 528, PA_GP = 272;
constexpr int PA_POOL = 0, PA_GATE = 80 * PA_PP, PA_GK = PA_GATE + 64 * PA_GP, PA_GV = PA_GK + 64 * PA_GP, PA_END = PA_GV + 64 * PA_PP;
static_assert(PA_END <= RING_BYTES, "phase A LDS");
constexpr int PA_NPIECE = 79 * 32 + 64 * 16 + 64 * 16 + 64 * 32, PA_NI = (PA_NPIECE + 511) / 512;
__device__ __forceinline__ void pa_piece(int p, int tb, int sb, long& goff, int& loff) {
    if (p < 79 * 32) { const int row = p >> 5, pc = p & 31; loff = PA_POOL + row * PA_PP + pc * 16; goff = (sb - 15 + row >= 0) ? ((long)(tb - 15 + row) * NP + C_POOL + pc * 8) : -1; return; }
    p -= 79 * 32;
    if (p < 64 * 16) { const int row = p >> 4, pc = p & 15; loff = PA_GATE + row * PA_GP + pc * 16; goff = (long)(tb + row) * NP + C_GG + pc * 8; return; }
    p -= 64 * 16;
    if (p < 64 * 16) { const int row = p >> 4, pc = p & 15; loff = PA_GK + row * PA_GP + pc * 16; goff = (long)(tb + row) * NP + C_GK + pc * 8; return; }
    p -= 64 * 16;
    if (p < 64 * 32) { const int row = p >> 5, pc = p & 31; loff = PA_GV + row * PA_PP + pc * 16; goff = (long)(tb + row) * NP + C_GV + pc * 8; return; }
    loff = -1; goff = -1;
}
struct StageA { v4u r[PA_NI]; };
__device__ __forceinline__ void stageA_load(StageA& S, const bf16* PROJ, int ck, int tid) {
    asm volatile("" : "+v"(tid));
    const int tb = ck * CHUNK, sb = (ck % NCH) * CHUNK;
#pragma unroll
    for (int i = 0; i < PA_NI; ++i) { long goff; int loff; pa_piece(tid + 512 * i, tb, sb, goff, loff);
        S.r[i] = (goff >= 0) ? *(const GAS v4u*)(PROJ + goff) : (v4u){0u, 0u, 0u, 0u}; }
}
__device__ __forceinline__ void stageA_store(const StageA& S, LAS unsigned char* lds, int ck, int tid) {
    asm volatile("" : "+v"(tid));
    const int tb = ck * CHUNK, sb = (ck % NCH) * CHUNK;
#pragma unroll
    for (int i = 0; i < PA_NI; ++i) { long goff; int loff; pa_piece(tid + 512 * i, tb, sb, goff, loff);
        if (loff >= 0) *(LAS v4u*)(lds + loff) = S.r[i]; }
}
__device__ __forceinline__ void pool_task2(const LAS unsigned char* lds, const bf16* WpT, const float* pscale, bf16* MIX, int ck, int g, int lane) {
    const int c = lane & 31, hh = lane >> 5; const int tb = ck * CHUNK, sb = (ck % NCH) * CHUNK; const int w = 2 << g;
    const bf16* Wg = WpT + (size_t)g * 4096;
#pragma unroll 1
    for (int tbk = 0; tbk < 2; ++tbk) {
        bf16x8 Bf[4];
        const int s = sb + 32 * tbk + c; const int cnt = (s + 1 < w) ? (s + 1) : w; const float inv = 1.0f / (float)cnt;
        const LAS unsigned char* rp = lds + PA_POOL + (15 + 32 * tbk + c) * PA_PP + (g * 64 + 8 * hh) * 2;
#pragma unroll
        for (int kp = 0; kp < 2; ++kp) {
            float cur[2][8], acc[2][8];
#pragma unroll
            for (int k2 = 0; k2 < 2; ++k2) { unpack8(*(const LAS v4u*)(rp + 32 * (2 * kp + k2)), cur[k2]);
#pragma unroll
                for (int j = 0; j < 8; ++j) acc[k2][j] = cur[k2][j]; }
#pragma unroll 2
            for (int i = 1; i < w; ++i) {
#pragma unroll
                for (int k2 = 0; k2 < 2; ++k2) { float v[8]; unpack8(*(const LAS v4u*)(rp - i * PA_PP + 32 * (2 * kp + k2)), v);
#pragma unroll
                    for (int j = 0; j < 8; ++j) acc[k2][j] += v[j]; }
            }
#pragma unroll
            for (int k2 = 0; k2 < 2; ++k2) { float p[8];
#pragma unroll
                for (int j = 0; j < 8; ++j) p[j] = acc[k2][j] * inv - cur[k2][j];
                Bf[2 * kp + k2] = pack8(p); }
        }
#pragma unroll
        for (int db = 0; db < 2; ++db) {
            f32x16 dacc = {};
#pragma unroll
            for (int ks = 0; ks < 4; ++ks) dacc = __builtin_amdgcn_mfma_f32_32x32x16_bf16(*(const GAS bf16x8*)(Wg + (size_t)(32 * db + c) * 64 + 16 * ks + 8 * hh), Bf[ks], dacc, 0, 0, 0);
            bf16* op = MIX + (size_t)(tb + 32 * tbk + c) * D + g * 64 + 32 * db + 4 * hh;
            const float* sp = pscale + g * 64 + 32 * db + 4 * hh;
#pragma unroll
            for (int q = 0; q < 4; ++q) { const f32x4 sc = *(const f32x4*)(sp + 8 * q);
                u32x2v o; o.x = cvtpk(dacc[4 * q] * sc[0], dacc[4 * q + 1] * sc[1]); o.y = cvtpk(dacc[4 * q + 2] * sc[2], dacc[4 * q + 3] * sc[3]);
                *(GAS u32x2v*)(op + 8 * q) = o; }
        }
    }
}
__device__ __forceinline__ void gla_kv_task2(const LAS unsigned char* lds, const float* bgate, float* GKV, float* GDEC, int ck, int h, int lane) {
    const int d = lane & 31, hh = lane >> 5; const int b = ck / NCH, n = ck % NCH; const int bhn = (b * 4 + h) * NCH + n;
    const float bg = bgate[h * 32 + d];
    const LAS unsigned short* Gp = (const LAS unsigned short*)(lds + PA_GATE) + h * 32 + d;
    const LAS unsigned short* Kp = (const LAS unsigned short*)(lds + PA_GK) + h * 32 + d;
    float bc[4][8], gt[4];
#pragma unroll
    for (int ks = 0; ks < 4; ++ks) { float run = 0.f;
#pragma unroll
        for (int j = 0; j < 8; ++j) { const int t = 16 * ks + 8 * hh + j; run += logsig(bf2f(Gp[t * (PA_GP / 2)]) + bg) * (1.0f / 16.0f); bc[ks][j] = run; }
        gt[ks] = run; }
    float base = 0.f, blast;
    {
        float pt[4];
#pragma unroll
        for (int ks = 0; ks < 4; ++ks) pt[ks] = __shfl_xor(gt[ks], 32);
#pragma unroll
        for (int ks = 0; ks < 4; ++ks) { const float lo = hh ? pt[ks] : gt[ks], hi_ = hh ? gt[ks] : pt[ks];
            const float off = base + (hh ? lo : 0.f);
#pragma unroll
            for (int j = 0; j < 8; ++j) bc[ks][j] += off;
            base += lo + hi_; }
        blast = base;
    }
    bf16x8 Af[4];
#pragma unroll
    for (int ks = 0; ks < 4; ++ks) { float v[8];
#pragma unroll
        for (int j = 0; j < 8; ++j) { const int t = 16 * ks + 8 * hh + j; v[j] = bf2f(Kp[t * (PA_GP / 2)]) * __expf(blast - bc[ks][j]); }
        Af[ks] = pack8(v); }
    const LAS unsigned short* Vp = (const LAS unsigned short*)(lds + PA_GV) + h * 64 + d;
#pragma unroll
    for (int nb = 0; nb < 2; ++nb) {
        f32x16 dacc = {};
#pragma unroll
        for (int ks = 0; ks < 4; ++ks) { v4u w;
            unsigned short e[8];
#pragma unroll
            for (int j = 0; j < 8; ++j) e[j] = Vp[(16 * ks + 8 * hh + j) * (PA_PP / 2) + 32 * nb];
            w.x = e[0] | ((unsigned)e[1] << 16); w.y = e[2] | ((unsigned)e[3] << 16); w.z = e[4] | ((unsigned)e[5] << 16); w.w = e[6] | ((unsigned)e[7] << 16);
            dacc = __builtin_amdgcn_mfma_f32_32x32x16_bf16(Af[ks], __builtin_bit_cast(bf16x8, w), dacc, 0, 0, 0); }
        float* op = GKV + ((size_t)bhn * 64 + 32 * nb + d) * 32 + 4 * hh;
#pragma unroll
        for (int q = 0; q < 4; ++q) *(GAS f32x4*)(op + 8 * q) = (f32x4){dacc[4 * q], dacc[4 * q + 1], dacc[4 * q + 2], dacc[4 * q + 3]};
    }
    if (hh == 0) GDEC[(size_t)bhn * 32 + d] = __expf(blast);
}
constexpr int PC_GATE = 0, PC_GQ = 64 * PA_GP, PC_GK = 2 * 64 * PA_GP, PC_GV = 3 * 64 * PA_GP, PC_SCR = PC_GV + 64 * PA_PP, PC_END = PC_SCR + 4 * 8448;
static_assert(PC_END <= RING_BYTES, "phase C LDS");
constexpr int PC_NPIECE = 3 * 64 * 16 + 64 * 32, PC_NI = PC_NPIECE / 512;
static_assert(PC_NPIECE % 512 == 0, "phase C pieces");
__device__ __forceinline__ void pc_piece(int p, int tb, long& goff, int& loff) {
    if (p < 3 * 64 * 16) { const int reg = p >> 10, q = p & 1023, row = q >> 4, pc = q & 15; loff = reg * 64 * PA_GP + row * PA_GP + pc * 16;
        goff = (long)(tb + row) * NP + (reg == 0 ? C_GG : reg == 1 ? C_GQ : C_GK) + pc * 8; return; }
    p -= 3 * 64 * 16; { const int row = p >> 5, pc = p & 31; loff = PC_GV + row * PA_PP + pc * 16; goff = (long)(tb + row) * NP + C_GV + pc * 8; }
}
struct StageC { v4u r[PC_NI]; };
__device__ __forceinline__ void stageC_load(StageC& S, const bf16* PROJ, int ck, int tid) {
    asm volatile("" : "+v"(tid));
#pragma unroll
    for (int i = 0; i < PC_NI; ++i) { long goff; int loff; pc_piece(tid + 512 * i, ck * CHUNK, goff, loff); S.r[i] = *(const GAS v4u*)(PROJ + goff); }
}
__device__ __forceinline__ void stageC_store(const StageC& S, LAS unsigned char* lds, int ck, int tid) {
    asm volatile("" : "+v"(tid));
#pragma unroll
    for (int i = 0; i < PC_NI; ++i) { long goff; int loff; pc_piece(tid + 512 * i, ck * CHUNK, goff, loff); *(LAS v4u*)(lds + loff) = S.r[i]; }
}
__device__ __forceinline__ void gla_out_task2(LAS unsigned char* lds, const bf16* PROJ, const float* bgate, const float* gnorm, const float* GKV, bf16* MIX, int ck, int h, int ib, int lane) {
    const int c = lane & 31, hh = lane >> 5; const int tb = ck * CHUNK; const int b = ck / NCH, n = ck % NCH; const int bhn = (b * 4 + h) * NCH + n;
    LAS float* scr = (LAS float*)(lds + PC_SCR + h * 8448);
    const int tok = tb + 32 * ib + c;
    const float* Sp = GKV + (size_t)bhn * 2048;
    f32x4 sv[2][2][2];
#pragma unroll
    for (int eb = 0; eb < 2; ++eb)
#pragma unroll
        for (int ks = 0; ks < 2; ++ks) { const float* sp = Sp + (size_t)(32 * eb + c) * 32 + 16 * ks + 8 * hh; sv[eb][ks][0] = *(const GAS f32x4*)sp; sv[eb][ks][1] = *(const GAS f32x4*)(sp + 4); }
    const bf16* rp = PROJ + (size_t)tok * NP + C_GR + h * 64 + 4 * hh;
    u32x2v rw[2][4];
#pragma unroll
    for (int eb = 0; eb < 2; ++eb)
#pragma unroll
        for (int q = 0; q < 4; ++q) rw[eb][q] = *(const GAS u32x2v*)(rp + 32 * eb + 8 * q);
    {
        const float bg = bgate[h * 32 + c];
        const LAS unsigned short* Gp = (const LAS unsigned short*)(lds + PC_GATE) + (32 * hh) * (PA_GP / 2) + h * 32 + c;
        float bc[32]; float run = 0.f;
#pragma unroll
        for (int i = 0; i < 32; ++i) { run += logsig(bf2f(Gp[i * (PA_GP / 2)]) + bg) * (1.0f / 16.0f); bc[i] = run; }
        const float tot0 = __shfl(run, c);
        const float off = hh ? tot0 : 0.f;
#pragma unroll
        for (int i = 0; i < 32; ++i) scr[(32 * hh + i) * 33 + c] = bc[i] + off;
        LDS_WAIT(); asm volatile("" ::: "memory");
    }
    bf16x8 Qf[2], Kf[2][2];
    const float qs = 0.17677669529663687f;
#pragma unroll
    for (int ks = 0; ks < 2; ++ks) { const int i = 32 * ib + c, d0 = 16 * ks + 8 * hh; float q[8], qd[8];
        unpack8(*(const LAS v4u*)(lds + PC_GQ + i * PA_GP + (h * 32 + d0) * 2), q);
#pragma unroll
        for (int j = 0; j < 8; ++j) qd[j] = q[j] * qs * __expf(scr[i * 33 + d0 + j]);
        Qf[ks] = pack8(qd); }
#pragma unroll
    for (int jb = 0; jb < 2; ++jb)
#pragma unroll
        for (int ks = 0; ks < 2; ++ks) { const int i = 32 * jb + c, d0 = 16 * ks + 8 * hh; float k[8], ki[8];
            if (jb <= ib) {
                unpack8(*(const LAS v4u*)(lds + PC_GK + i * PA_GP + (h * 32 + d0) * 2), k);
#pragma unroll
                for (int j = 0; j < 8; ++j) ki[j] = k[j] * __expf(-scr[i * 33 + d0 + j]);
                Kf[jb][ks] = pack8(ki); } }
    const LAS unsigned short* Vp = (const LAS unsigned short*)(lds + PC_GV) + h * 64;
    const float* gn = gnorm + h * 64;
    f32x16 o[2]; o[0] = f32x16{}; o[1] = f32x16{};
    for (int jb = 0; jb <= ib; ++jb) {
        f32x16 at = {};
#pragma unroll
        for (int ks = 0; ks < 2; ++ks) at = __builtin_amdgcn_mfma_f32_32x32x16_bf16(jb == 0 ? Kf[0][ks] : Kf[1][ks], Qf[ks], at, 0, 0, 0);
        if (jb == ib) {
#pragma unroll
            for (int r = 0; r < 16; ++r) if (crow(r, hh) > c) at[r] = 0.f;
        }
#pragma unroll
        for (int s = 0; s < 2; ++s) {
            float pv_[8];
#pragma unroll
            for (int jj = 0; jj < 8; ++jj) pv_[jj] = at[8 * s + jj];
            const bf16x8 Pf = pack8(pv_);
#pragma unroll
            for (int eb = 0; eb < 2; ++eb) { unsigned short e[8];
#pragma unroll
                for (int jj = 0; jj < 8; ++jj) { const int j = 32 * jb + 16 * s + 8 * (jj >> 2) + 4 * hh + (jj & 3); e[jj] = Vp[j * (PA_PP / 2) + 32 * eb + c]; }
                v4u w; w.x = e[0] | ((unsigned)e[1] << 16); w.y = e[2] | ((unsigned)e[3] << 16); w.z = e[4] | ((unsigned)e[5] << 16); w.w = e[6] | ((unsigned)e[7] << 16);
                o[eb] = __builtin_amdgcn_mfma_f32_32x32x16_bf16(__builtin_bit_cast(bf16x8, w), Pf, o[eb], 0, 0, 0); }
        }
    }
#pragma unroll
    for (int eb = 0; eb < 2; ++eb)
#pragma unroll
        for (int ks = 0; ks < 2; ++ks) { const f32x4 s0 = sv[eb][ks][0], s1 = sv[eb][ks][1];
            const float svv[8] = {s0[0], s0[1], s0[2], s0[3], s1[0], s1[1], s1[2], s1[3]};
            o[eb] = __builtin_amdgcn_mfma_f32_32x32x16_bf16(pack8(svv), Qf[ks], o[eb], 0, 0, 0); }
    float ssq = 0.f;
#pragma unroll
    for (int eb = 0; eb < 2; ++eb)
#pragma unroll
        for (int r = 0; r < 16; ++r) ssq += o[eb][r] * o[eb][r];
    ssq += __shfl_xor(ssq, 32);
    const float rstd = __builtin_amdgcn_rsqf(ssq * (1.0f / 64.0f) + EPS);
    bf16* op = MIX + (size_t)tok * D + 768 + h * 64 + 4 * hh;
#pragma unroll
    for (int eb = 0; eb < 2; ++eb)
#pragma unroll
        for (int q = 0; q < 4; ++q) { const int e0 = 32 * eb + 8 * q;
            const u32x2v rww = rw[eb][q]; const f32x4 g4 = *(const f32x4*)(gn + e0 + 4 * hh);
            const float rg[4] = {__uint_as_float(rww.x << 16), __uint_as_float(rww.x & 0xffff0000u), __uint_as_float(rww.y << 16), __uint_as_float(rww.y & 0xffff0000u)};
            float y[4];
#pragma unroll
            for (int k = 0; k < 4; ++k) { const float sil = rg[k] / (1.f + __expf(-rg[k])); y[k] = o[eb][4 * q + k] * rstd * g4[k] * sil; }
            u32x2v ow; ow.x = cvtpk(y[0], y[1]); ow.y = cvtpk(y[2], y[3]); *(GAS u32x2v*)(op + e0) = ow; }
    LDS_WAIT(); asm volatile("" ::: "memory");
}
template <int R> __device__ __forceinline__ void diff_fin_rows(const bf16* OATT, const float* dng, bf16* MIX, int tok0, int tstride, float lam, float oml, int lane) {
    const int hd = lane >> 4, e0 = (lane & 15) * 8;
    v4u w1[R], w2[R];
#pragma unroll
    for (int r = 0; r < R; ++r) { const size_t o = (size_t)(tok0 + r * tstride) * D + hd * 256 + e0; w1[r] = *(const GAS v4u*)(OATT + o); w2[r] = *(const GAS v4u*)(OATT + o + 128); }
    const f32x4 g0 = *(const f32x4*)(dng + hd * 128 + e0), g1 = *(const f32x4*)(dng + hd * 128 + e0 + 4);
#pragma unroll
    for (int r = 0; r < R; ++r) { float a1[8], a2[8], a[8]; unpack8(w1[r], a1); unpack8(w2[r], a2);
        float ss = 0.f;
#pragma unroll
        for (int j = 0; j < 8; ++j) { a[j] = a1[j] - lam * a2[j]; ss += a[j] * a[j]; }
        ss += __shfl_xor(ss, 1); ss += __shfl_xor(ss, 2); ss += __shfl_xor(ss, 4); ss += __shfl_xor(ss, 8);
        const float rstd = __builtin_amdgcn_rsqf(ss * (1.0f / 128.0f) + EPS) * oml;
        float y[8];
#pragma unroll
        for (int j = 0; j < 4; ++j) { y[j] = a[j] * rstd * g0[j]; y[4 + j] = a[4 + j] * rstd * g1[j]; }
        *(GAS bf16x8*)(MIX + (size_t)(tok0 + r * tstride) * D + 256 + hd * 128 + e0) = pack8(y); }
}
template <int R> __device__ __forceinline__ void final_norm_rows(const bf16* hb, float* out, const float* g, int row0, int rstride, int lane) {
    v4u w[R][2];
#pragma unroll
    for (int r = 0; r < R; ++r)
#pragma unroll
        for (int j = 0; j < 2; ++j) w[r][j] = *(const GAS v4u*)(hb + (size_t)(row0 + r * rstride) * D + j * 512 + lane * 8);
    f32x4 g4[2][2];
#pragma unroll
    for (int j = 0; j < 2; ++j) { g4[j][0] = *(const f32x4*)(g + j * 512 + lane * 8); g4[j][1] = *(const f32x4*)(g + j * 512 + lane * 8 + 4); }
#pragma unroll
    for (int r = 0; r < R; ++r) { float v[2][8]; float s2 = 0.f;
#pragma unroll
        for (int j = 0; j < 2; ++j) { unpack8(w[r][j], v[j]);
#pragma unroll
            for (int e = 0; e < 8; ++e) s2 += v[j][e] * v[j][e]; }
        const float rstd = __builtin_amdgcn_rsqf(wave_sum(s2) * (1.0f / D) + EPS);
        float* op = out + (size_t)(row0 + r * rstride) * D + lane * 8;
#pragma unroll
        for (int j = 0; j < 2; ++j) { f32x4 o0, o1;
#pragma unroll
            for (int e = 0; e < 4; ++e) { o0[e] = v[j][e] * rstd * g4[j][0][e]; o1[e] = v[j][4 + e] * rstd * g4[j][1][e]; }
            *(GAS f32x4*)(op + j * 512) = o0; *(GAS f32x4*)(op + j * 512 + 4) = o1; } }
}

template <class Sched> __device__ __forceinline__ void rs_table(LAS float* rst, const float* ss, const Sched& S, int tid) {
    asm volatile("" : "+v"(tid));
    const int row = tid >> 1, half = tid & 1;
    pg8::Unit u;
    for (int i = 0; i < RST_MAXU && S.next(i, u); ++i) {
        const f32x4 a = *(const GAS f32x4*)(ss + ((size_t)u.pm * 256 + row) * 16 + half * 8), b = *(const GAS f32x4*)(ss + ((size_t)u.pm * 256 + row) * 16 + half * 8 + 4);
        float s_ = ((a[0] + a[1]) + (a[2] + a[3])) + ((b[0] + b[1]) + (b[2] + b[3]));
        s_ += __shfl_xor(s_, 1);
        if (half == 0) rst[i * 256 + row] = __builtin_amdgcn_rsqf(s_ * (1.0f / 1024.0f) + EPS);
    }
    __syncthreads();
}
constexpr int PH_PER_LAYER = 7, N_PHASES = 1 + DEPTH * PH_PER_LAYER + 1;
struct Args { const float* in[18]; float* out; unsigned char* ws; int ph_lo, ph_hi; };
__global__ void __launch_bounds__(NWAVES * 64, 2) fwd_kernel(Args args) {
    extern __shared__ __attribute__((aligned(16))) unsigned char lds[];
    Frame F;
    F.lds = (LAS unsigned char*)lds;
    F.MISC = (volatile LAS unsigned*)(F.lds + MISC_OFF);
    F.tid = threadIdx.x; F.lane = F.tid & 63; F.wave = __builtin_amdgcn_readfirstlane(F.tid >> 6);
    F.G = gridDim.x; { const int bx = blockIdx.x; F.vcu = (F.G % 8 == 0) ? (bx % 8) * (F.G / 8) + bx / 8 : bx; }
    unsigned char* ws = args.ws;
    F.ctl = (gu32*)(ws + WS_CTL);
    Inputs I;
    I.x = args.in[0]; I.norm1_g = args.in[1]; I.w_in = args.in[2]; I.pool_w = args.in[3]; I.pool_scale = args.in[4]; I.lq1 = args.in[5]; I.lk1 = args.in[6]; I.lq2 = args.in[7]; I.lk2 = args.in[8];
    I.diff_norm_g = args.in[9]; I.w_gate2 = args.in[10]; I.b_gate = args.in[11]; I.gla_norm_g = args.in[12]; I.w_out = args.in[13]; I.norm2_g = args.in[14]; I.w_mlp1 = args.in[15]; I.w_mlp2 = args.in[16]; I.final_g = args.in[17];
    for (int u = F.tid; u < (LDS_BYTES - LDSCTL_OFF) / 4; u += NWAVES * 64) ((LAS unsigned*)(F.lds + LDSCTL_OFF))[u] = 0u;
    __syncthreads();
    XcdBarrier bar; bar.bar = (unsigned*)(F.ctl + CW_BAR); bar.x = 0; bar.st = nullptr;
    if (!MK_PER_PHASE) bar = xcd_barrier_post((unsigned*)(F.ctl + CW_BAR), F.MISC + 8);
#define GRID_BAR() do { if (!MK_PER_PHASE) xcd_barrier(bar); } while (0)
    const int lo = args.ph_lo, hi = args.ph_hi;
#define IN(k) (lo <= (k) && (k) < hi)
#define BOTH(k) (IN(k) && IN((k) + 1))
    bf16* const HB = (bf16*)(ws + WS_HB); bf16* const PROJ = (bf16*)(ws + WS_PROJ); bf16* const OATT = (bf16*)(ws + WS_OATT); bf16* const MIX = (bf16*)(ws + WS_MIX); bf16* const HID = (bf16*)(ws + WS_HID);
    float* const SSA = (float*)(ws + WS_SSA); float* const SSB = (float*)(ws + WS_SSB); float* const GKV = (float*)(ws + WS_GKV); float* const GDEC = (float*)(ws + WS_GDEC);
#define REFRESH() do { int t_ = threadIdx.x; asm volatile("" : "+v"(t_)); F.tid = t_; F.lane = t_ & 63; F.wave = __builtin_amdgcn_readfirstlane(t_ >> 6); } while (0)
    const int NGW = F.G * NWAVES;

    if (IN(0)) { p0_prologue(F, I, ws); if (BOTH(0)) GRID_BAR(); }

#pragma unroll 1
    for (int l = 0; l < DEPTH; ++l) {
        const int pb = 1 + l * PH_PER_LAYER;
        unsigned char* wl = ws + WS_W + (size_t)l * W_LAYER;
        const float lambda_init = (l == 0) ? 0.2f : 0.35550906759096927f;
        if (IN(pb + 0)) {
            pg8::Gemm g{HB, (const bf16*)(wl + WO_IN), M, NP, D}; pg8::StaticOrder S; S.init(M, NP, F.G, (int)blockIdx.x);
            rs_table((LAS float*)(F.lds + RST_OFF), SSB, S, threadIdx.x);
            pg8::EpiRs<0> E{PROJ, NP, (const LAS float*)(F.lds + RST_OFF), 1, 3, attn2::C2};
            pg8::gemm_phase<pg8::EpiRs<0>, pg8::StaticOrder, true, true>(F.lds + RING_OFF, g, S, E);
            if (BOTH(pb + 0)) GRID_BAR();
        }
        if (IN(pb + 1)) {
            REFRESH();
            {
                StageA SA; int ck = F.vcu;
                stageA_load(SA, PROJ, ck, F.tid);
                for (; ck < M / CHUNK; ck += F.G) {
                    stageA_store(SA, F.lds + RING_OFF, ck, F.tid);
                    __syncthreads();
                    stageA_load(SA, PROJ, (ck + F.G < M / CHUNK) ? ck + F.G : ck, F.tid);
                    if (F.wave < 4) pool_task2(F.lds + RING_OFF, (const bf16*)(ws + WS_WPOOL) + (size_t)l * 4 * 4096, I.pool_scale + l * 256, MIX, ck, F.wave, F.lane);
                    else gla_kv_task2(F.lds + RING_OFF, I.b_gate + l * 128, GKV, GDEC, ck, F.wave - 4, F.lane);
                    __syncthreads();
                }
            }
            if (BOTH(pb + 1)) GRID_BAR();
        }
        if (IN(pb + 2)) {
            REFRESH();
            if (F.tid < 256) gla_scan(GKV, GDEC, F.vcu * 256 + F.tid, F.G * 256);
            __syncthreads();
            attn2::attn_phase3((char*)lds + RING_OFF, (const attn2::bf16*)PROJ, (attn2::bf16*)OATT, F.vcu, C_DQ, C_DK, C_DV);
            if (BOTH(pb + 2)) GRID_BAR();
        }
        if (IN(pb + 3)) {
            REFRESH(); const int gw = F.vcu * NWAVES + F.wave;
            {
                { StageC SC; int ck = F.vcu;
                  stageC_load(SC, PROJ, ck, F.tid);
                  for (; ck < M / CHUNK; ck += F.G) {
                      stageC_store(SC, F.lds + RING_OFF, ck, F.tid);
                      __syncthreads();
                      stageC_load(SC, PROJ, (ck + F.G < M / CHUNK) ? ck + F.G : ck, F.tid);
                      gla_out_task2(F.lds + RING_OFF, PROJ, I.b_gate + l * 128, I.gla_norm_g + l * 256, GKV, MIX, ck, F.wave & 3, F.wave >> 2, F.lane);
                      __syncthreads();
                  } }
                const float s1 = wave_sum(I.lq1[l * 64 + F.lane] * I.lk1[l * 64 + F.lane]), s2 = wave_sum(I.lq2[l * 64 + F.lane] * I.lk2[l * 64 + F.lane]);
                const float lam = __expf(s1) - __expf(s2) + lambda_init;
                int tok = gw;
                for (; tok + 3 * NGW < M; tok += 4 * NGW) diff_fin_rows<4>(OATT, I.diff_norm_g + l * 512, MIX, tok, NGW, lam, 1.0f - lambda_init, F.lane);
                for (; tok < M; tok += NGW) diff_fin_rows<1>(OATT, I.diff_norm_g + l * 512, MIX, tok, NGW, lam, 1.0f - lambda_init, F.lane);
            }
            if (BOTH(pb + 3)) GRID_BAR();
        }
        if (IN(pb + 4)) {
            pg8::Gemm g{MIX, (const bf16*)(wl + WO_OUT), M, D, D}; pg8::StaticOrder S; S.init(M, D, F.G, (int)blockIdx.x);
            pg8::EpiRes E{HB, SSA, D};
            pg8::gemm_phase<pg8::EpiRes, pg8::StaticOrder, true, true>(F.lds + RING_OFF, g, S, E);
            if (BOTH(pb + 4)) GRID_BAR();
        }
        if (IN(pb + 5)) {
            pg8::Gemm g{HB, (const bf16*)(wl + WO_1), M, FF, D}; pg8::StaticOrder S; S.init(M, FF, F.G, (int)blockIdx.x);
            rs_table((LAS float*)(F.lds + RST_OFF), SSA, S, threadIdx.x);
            pg8::EpiRs<2> E{HID, FF, (const LAS float*)(F.lds + RST_OFF), 0, 0, 1.f};
            pg8::gemm_phase<pg8::EpiRs<2>, pg8::StaticOrder, true, true>(F.lds + RING_OFF, g, S, E);
            if (BOTH(pb + 5)) GRID_BAR();
        }
        if (IN(pb + 6)) {
            pg8::Gemm g{HID, (const bf16*)(wl + WO_2), M, D, FF}; pg8::StaticOrder S; S.init(M, D, F.G, (int)blockIdx.x);
            pg8::EpiRes E{HB, SSB, D};
            pg8::gemm_phase<pg8::EpiRes, pg8::StaticOrder, true, true>(F.lds + RING_OFF, g, S, E);
            if (BOTH(pb + 6)) GRID_BAR();
        }
    }
    if (IN(N_PHASES - 1)) { REFRESH(); const int gw = F.vcu * NWAVES + F.wave; int m = gw; for (; m + 3 * NGW < M; m += 4 * NGW) final_norm_rows<4>(HB, args.out, I.final_g, m, NGW, F.lane);
        for (; m < M; m += NGW) final_norm_rows<1>(HB, args.out, I.final_g, m, NGW, F.lane); }
#undef IN
#undef BOTH
#undef GRID_BAR
#undef REFRESH
}

extern "C" void kernel_launch(void* const* d_in, const int* in_sizes, int n_in, void* d_out, int out_size, void* d_ws, size_t ws_size, hipStream_t stream) {
    static int grid = 0;
    if (grid == 0) {
        if (n_in != 18 || in_sizes[0] != M * D || out_size != M * D || ws_size < WS_END) { fprintf(stderr, "kernel_launch: unexpected shapes: n_in %d, in0 %d, out %d, ws %zu (need %zu); nothing launched\n", n_in, n_in > 0 ? in_sizes[0] : -1, out_size, ws_size, (size_t)WS_END); grid = -1; return; }
        int dev = 0, cus = 0, per_cu = 0;
        if (hipGetDevice(&dev) != hipSuccess || hipDeviceGetAttribute(&cus, hipDeviceAttributeMultiprocessorCount, dev) != hipSuccess) { grid = -1; return; }
        if (hipFuncSetAttribute((const void*)fwd_kernel, hipFuncAttributeMaxDynamicSharedMemorySize, LDS_BYTES) != hipSuccess) { fprintf(stderr, "kernel_launch: hipFuncSetAttribute failed\n"); grid = -1; return; }
        if (hipOccupancyMaxActiveBlocksPerMultiprocessor(&per_cu, (const void*)fwd_kernel, NWAVES * 64, LDS_BYTES) != hipSuccess || per_cu < 1) { fprintf(stderr, "kernel_launch: occupancy query reports %d workgroups per CU\n", per_cu); }
        (void)hipGetLastError();
        grid = cus;
    }
    if (grid < 0) return;
    if (hipMemsetAsync((char*)d_ws + WS_CTL, 0, CTL_ZERO_BYTES, stream) != hipSuccess) return;
    Args a{};
    for (int i = 0; i < 18; ++i) a.in[i] = (const float*)d_in[i];
    a.out = (float*)d_out; a.ws = (unsigned char*)d_ws;
#if MK_PER_PHASE
    for (int p = 0; p < N_PHASES; ++p) { a.ph_lo = p; a.ph_hi = p + 1; hipLaunchKernelGGL(fwd_kernel, dim3(grid), dim3(NWAVES * 64), LDS_BYTES, stream, a); }
#else
    a.ph_lo = 0; a.ph_hi = N_PHASES;
    hipLaunchKernelGGL(fwd_kernel, dim3(grid), dim3(NWAVES * 64), LDS_BYTES, stream, a);
#endif
}
```

```cpp
#include <hip/hip_runtime.h>
#include <cstdio>
#include <cstdint>
namespace pg8 {
#define PG8_LAS __attribute__((address_space(3)))
typedef unsigned short bf16_t;
typedef short bf16x8 __attribute__((ext_vector_type(8)));
typedef float f32x4 __attribute__((ext_vector_type(4)));
typedef unsigned u32x4 __attribute__((ext_vector_type(4)));
constexpr int BM = 256, BK = 64, HALF = 128, HTB = HALF * BK * 2  , STAGE_BYTES = 8 * HTB, NXCD = 8, WGM = 8;

__host__ __device__ __forceinline__ int lds_byte(int r, int c) { const int st = (r >> 4) * 2 + (c >> 5), rr = r & 15, cc = c & 31, ob = rr * 64 + cc * 2; return st * 1024 + (ob ^ (((ob >> 9) & 1) << 5)); }
__host__ __device__ __forceinline__ void stage_rc(int b, int& R, int& C) { const int st = b / 1024, sb = b % 1024, swz = sb ^ (((sb >> 9) & 1) << 5); R = (st >> 1) * 16 + swz / 64; C = (st & 1) * 32 + (swz % 64) / 2; }
__host__ __device__ __forceinline__ int perm32(int rho) { const int n = rho >> 4, i = rho & 15; return 8 * (i >> 2) + 4 * n + (i & 3); }

struct Unit { int pm, pn; };
struct Gemm { const bf16_t* A; const bf16_t* Bt; int M, N, K; };

struct StaticOrder {
    int nM, nN, nwg, G, c;
    __host__ __device__ void init(int M, int N, int G_, int c_) { nM = M / BM; nN = N / BM; nwg = nM * nN; G = G_; c = c_; }
    __host__ __device__ bool next(int i, Unit& u) const {
        const long L = (long)i * G + c; if (L >= nwg) return false;
        int wgid = (int)L; { const int q = nwg / NXCD, r = nwg % NXCD, xcd = wgid % NXCD, off = wgid / NXCD; wgid = (xcd < r ? xcd * (q + 1) : r * (q + 1) + (xcd - r) * q) + off; }
        const int nig = WGM * nN, gid = wgid / nig, fm = gid * WGM, gsz = (nM - fm) < WGM ? (nM - fm) : WGM;
        u.pm = fm + ((wgid % nig) % gsz); u.pn = (wgid % nig) / gsz; return true;
    }
    __device__ __forceinline__ void a_ready(const Unit&) const {}
    __device__ __forceinline__ void done(const Unit&) const {}
};

__device__ __forceinline__ unsigned cvt_pk_bf16(float lo, float hi) { unsigned r; asm volatile("v_cvt_pk_bf16_f32 %0, %1, %2" : "=v"(r) : "v"(lo), "v"(hi)); return r; }
typedef float f32x2 __attribute__((ext_vector_type(2)));
typedef float f32x2 __attribute__((ext_vector_type(2)));
typedef unsigned u32x2 __attribute__((ext_vector_type(2)));
__device__ __forceinline__ float row_rs(const float* ss, int row, int fq, float eps) {
    const f32x4 p = *(const f32x4*)(ss + (size_t)row * 16 + fq * 4);
    float s = (p[0] + p[1]) + (p[2] + p[3]);
    s += __shfl_xor(s, 16); s += __shfl_xor(s, 32);
    return __builtin_amdgcn_rsqf(s * (1.0f / 1024.0f) + eps);
}
template <int ACT> struct EpiRs {
    static constexpr bool PERM = true, AFTER_DRAIN = false;
    bf16_t* O; int ldc; const PG8_LAS float* rst; int sc_lo, sc_hi; float tile_scale;
    __device__ __forceinline__ void operator()(const f32x4 (&acc)[2][2][4][2], const Unit& u, int ui, int wr, int wc, int fr, int fq) const {
        const int row0 = u.pm * BM + wr * 64 + fr; const int col0 = u.pn * BM + wc * 32 + 8 * fq;
        const float sc = (u.pn >= sc_lo && u.pn < sc_hi) ? tile_scale : 1.f;
        float rs[2][4];
#pragma unroll
        for (int ai = 0; ai < 2; ++ai)
#pragma unroll
            for (int m = 0; m < 4; ++m) rs[ai][m] = rst[ui * BM + wr * 64 + fr + ai * HALF + m * 16] * sc;
#pragma unroll
        for (int ai = 0; ai < 2; ++ai)
#pragma unroll
            for (int m = 0; m < 4; ++m) { bf16_t* rowp = O + (size_t)(row0 + ai * HALF + m * 16) * ldc + col0; const float r = rs[ai][m];
#pragma unroll
                for (int bj = 0; bj < 2; ++bj) { f32x4 v0 = acc[ai][bj][m][0] * r, v1 = acc[ai][bj][m][1] * r;
                    if (ACT == 2) {
#pragma unroll
                        for (int e = 0; e < 4; ++e) { const float a = __builtin_fmaxf(v0[e], 0.f), b = __builtin_fmaxf(v1[e], 0.f); v0[e] = a * a; v1[e] = b * b; } }
                    u32x4 w; w.x = cvt_pk_bf16(v0[0], v0[1]); w.y = cvt_pk_bf16(v0[2], v0[3]); w.z = cvt_pk_bf16(v1[0], v1[1]); w.w = cvt_pk_bf16(v1[2], v1[3]);
                    __builtin_nontemporal_store(w, (u32x4*)(rowp + bj * HALF)); } }
    }
};
struct EpiRes {
    static constexpr bool PERM = true, AFTER_DRAIN = false;
    bf16_t* hb; float* ss; int ldc;
    __device__ __forceinline__ void operator()(const f32x4 (&acc)[2][2][4][2], const Unit& u, int ui, int wr, int wc, int fr, int fq) const {
        const int row0 = u.pm * BM + wr * 64 + fr; const int col0 = u.pn * BM + wc * 32 + 8 * fq;
        u32x4 b[2][4][2];
#pragma unroll
        for (int ai = 0; ai < 2; ++ai)
#pragma unroll
            for (int m = 0; m < 4; ++m)
#pragma unroll
                for (int bj = 0; bj < 2; ++bj) b[ai][m][bj] = *(const u32x4*)(hb + (size_t)(row0 + ai * HALF + m * 16) * ldc + col0 + bj * HALF);
#pragma unroll
        for (int ai = 0; ai < 2; ++ai)
#pragma unroll
            for (int m = 0; m < 4; ++m) { const int row = row0 + ai * HALF + m * 16; bf16_t* rowp = hb + (size_t)row * ldc + col0; float sq = 0.f;
#pragma unroll
                for (int bj = 0; bj < 2; ++bj) { const u32x4 bb = b[ai][m][bj];
                    f32x4 o0, o1;
                    o0[0] = __uint_as_float(bb.x << 16) + acc[ai][bj][m][0][0]; o0[1] = __uint_as_float(bb.x & 0xffff0000u) + acc[ai][bj][m][0][1];
                    o0[2] = __uint_as_float(bb.y << 16) + acc[ai][bj][m][0][2]; o0[3] = __uint_as_float(bb.y & 0xffff0000u) + acc[ai][bj][m][0][3];
                    o1[0] = __uint_as_float(bb.z << 16) + acc[ai][bj][m][1][0]; o1[1] = __uint_as_float(bb.z & 0xffff0000u) + acc[ai][bj][m][1][1];
                    o1[2] = __uint_as_float(bb.w << 16) + acc[ai][bj][m][1][2]; o1[3] = __uint_as_float(bb.w & 0xffff0000u) + acc[ai][bj][m][1][3];
                    u32x4 w; w.x = cvt_pk_bf16(o0[0], o0[1]); w.y = cvt_pk_bf16(o0[2], o0[3]); w.z = cvt_pk_bf16(o1[0], o1[1]); w.w = cvt_pk_bf16(o1[2], o1[3]);
                    *(u32x4*)(rowp + bj * HALF) = w;
                    sq += ((o0[0] * o0[0] + o0[1] * o0[1]) + (o0[2] * o0[2] + o0[3] * o0[3])) + ((o1[0] * o1[0] + o1[1] * o1[1]) + (o1[2] * o1[2] + o1[3] * o1[3])); }
                sq += __shfl_xor(sq, 16); sq += __shfl_xor(sq, 32);
                if (fq == 0) ss[(size_t)row * 16 + u.pn * 4 + wc] = sq; }
    }
};
template <class Epi, class Sched, bool ALIGN_EPI = false, bool SP2 = false>
__device__ __forceinline__ void gemm_phase(PG8_LAS unsigned char* lds, const Gemm g, const Sched& S, const Epi& E) {
    int tid_ = threadIdx.x; asm volatile("" : "+v"(tid_));
    const int tid = tid_, wid = __builtin_amdgcn_readfirstlane(tid >> 6), lane = tid & 63, wr = wid >> 2, wc = wid & 3, fr = lane & 15, fq = lane >> 4;
    const int K = g.K, nt = K / BK;
    unsigned voffA[2], voffB[2];
#pragma unroll
    for (int i = 0; i < 2; ++i) { int R, C; stage_rc(tid * 16 + i * 8192, R, C); const int Rb = Epi::PERM ? ((R & ~31) + perm32(R & 31)) : R;
        voffA[i] = (unsigned)(R * K + C) * 2u; voffB[i] = (unsigned)(Rb * K + C) * 2u; }
    const size_t kstep = (size_t)(BK * 2);
    const size_t hstep = (size_t)HALF * K * 2;
    const size_t tstep = 2 * hstep;
    const unsigned ldsw = (unsigned)wid * 1024u;
    const int aoff = lds_byte(wr * 64 + fr, fq * 8), boff = lds_byte(wc * 32 + fr, fq * 8);
#define PG8_SA(b, h) (((b) * 2 + (h)) * HTB)
#define PG8_SB(b, h) ((4 + (b) * 2 + (h)) * HTB)
#define PG8_STAGE(bufoff, gbase, voff) do { _Pragma("unroll") for (int _i = 0; _i < 2; ++_i) \
        __builtin_amdgcn_global_load_lds((const unsigned*)((const char*)(gbase) + (voff)[_i]), (PG8_LAS unsigned*)(lds + (bufoff) + ldsw + _i * 8192), 16, 0, 0); } while (0)
#define PG8_LDA(dst, b, h) do { _Pragma("unroll") for (int m = 0; m < 4; ++m) _Pragma("unroll") for (int k = 0; k < 2; ++k) dst[m][k] = *(const PG8_LAS bf16x8*)(lds + PG8_SA(b, h) + aoff + m * 2048 + k * 1024); } while (0)
#define PG8_LDB(dst, b, h) do { _Pragma("unroll") for (int n = 0; n < 2; ++n) _Pragma("unroll") for (int k = 0; k < 2; ++k) dst[n][k] = *(const PG8_LAS bf16x8*)(lds + PG8_SB(b, h) + boff + n * 2048 + k * 1024); } while (0)
#define PG8_MMA(ai, bj, At, Bt) do { __builtin_amdgcn_s_setprio(1); _Pragma("unroll") for (int m = 0; m < 4; ++m) _Pragma("unroll") for (int n = 0; n < 2; ++n) _Pragma("unroll") for (int k = 0; k < 2; ++k) \
        acc[ai][bj][m][n] = __builtin_amdgcn_mfma_f32_16x16x32_bf16(Bt[n][k], At[m][k], acc[ai][bj][m][n], 0, 0, 0); __builtin_amdgcn_s_setprio(0); } while (0)
#define PG8_WAIT_V(n) asm volatile("s_waitcnt vmcnt(" #n ")" ::: "memory")
#define PG8_WAIT_L(n) asm volatile("s_waitcnt lgkmcnt(" #n ")" ::: "memory")
#define PG8_BAR __builtin_amdgcn_s_barrier()
#define PG8_SCHED __builtin_amdgcn_sched_barrier(0)
    Unit cur, nxt; int ui = 0;
    if (!S.next(0, cur)) return;
    f32x4 acc[2][2][4][2];
#pragma unroll
    for (int a = 0; a < 2; ++a)
#pragma unroll
        for (int b = 0; b < 2; ++b)
#pragma unroll
            for (int m = 0; m < 4; ++m)
#pragma unroll
                for (int n = 0; n < 2; ++n) acc[a][b][m][n] = (f32x4){0.f, 0.f, 0.f, 0.f};
    bf16x8 At[4][2], B0[2][2], B1[2][2];
    const char* cA = (const char*)g.A + (size_t)cur.pm * tstep; const char* cB = (const char*)g.Bt + (size_t)cur.pn * tstep;
    S.a_ready(cur);
    if constexpr (SP2) {
        PG8_STAGE(PG8_SB(0, 0), cB, voffB); PG8_STAGE(PG8_SB(0, 1), cB + hstep, voffB); PG8_STAGE(PG8_SA(0, 0), cA, voffA); PG8_STAGE(PG8_SA(0, 1), cA + hstep, voffA);
        if (wr == 1) PG8_BAR;
        PG8_WAIT_V(2); PG8_BAR;
        PG8_STAGE(PG8_SB(1, 0), cB + kstep, voffB); PG8_STAGE(PG8_SA(1, 0), cA + kstep, voffA); PG8_STAGE(PG8_SB(1, 1), cB + hstep + kstep, voffB);
        PG8_WAIT_V(6); PG8_BAR;
    } else {
        PG8_STAGE(PG8_SB(0, 0), cB, voffB); PG8_STAGE(PG8_SA(0, 0), cA, voffA); PG8_STAGE(PG8_SB(0, 1), cB + hstep, voffB); PG8_STAGE(PG8_SA(0, 1), cA + hstep, voffA);
        if (wr == 1) PG8_BAR;
        PG8_WAIT_V(4); PG8_BAR;
        PG8_STAGE(PG8_SB(1, 0), cB + kstep, voffB); PG8_STAGE(PG8_SA(1, 0), cA + kstep, voffA); PG8_STAGE(PG8_SB(1, 1), cB + hstep + kstep, voffB);
        PG8_WAIT_V(6); PG8_BAR;
    }
    for (;;) {
        const bool has_next = S.next(ui + 1, nxt);
        const char* nA = has_next ? (const char*)g.A + (size_t)nxt.pm * tstep : cA; const char* nB = has_next ? (const char*)g.Bt + (size_t)nxt.pn * tstep : cB;
        for (int t = 0; t < nt; t += 2) {
            const bool last = (t == nt - 2);
            const char* a1 = cA + (size_t)(t + 1) * kstep;
            const char* a2 = last ? nA : cA + (size_t)(t + 2) * kstep; const char* b2 = last ? nB : cB + (size_t)(t + 2) * kstep;
            const char* a3 = a2 + kstep; const char* b3 = b2 + kstep;
            if (last && has_next) S.a_ready(nxt);
            if constexpr (SP2) {
            PG8_LDB(B0, 0, 0); PG8_LDB(B1, 0, 1); PG8_SCHED; PG8_LDA(At, 0, 0); PG8_STAGE(PG8_SA(1, 1), a1 + hstep, voffA);
            PG8_WAIT_V(8); PG8_WAIT_L(0); PG8_BAR; PG8_MMA(0, 0, At, B0); PG8_MMA(0, 1, At, B1); PG8_BAR; PG8_SCHED;
            PG8_LDA(At, 0, 1); PG8_STAGE(PG8_SB(0, 0), b2, voffB); PG8_STAGE(PG8_SB(0, 1), b2 + hstep, voffB); PG8_STAGE(PG8_SA(0, 0), a2, voffA);
            PG8_WAIT_V(8); PG8_WAIT_L(0); PG8_BAR; PG8_MMA(1, 0, At, B0); PG8_MMA(1, 1, At, B1); PG8_BAR; PG8_SCHED;
            PG8_LDB(B0, 1, 0); PG8_LDB(B1, 1, 1); PG8_SCHED; PG8_LDA(At, 1, 0); PG8_STAGE(PG8_SA(0, 1), a2 + hstep, voffA);
            PG8_WAIT_V(8); PG8_WAIT_L(0); PG8_BAR; PG8_MMA(0, 0, At, B0); PG8_MMA(0, 1, At, B1); PG8_BAR; PG8_SCHED;
            PG8_LDA(At, 1, 1); PG8_STAGE(PG8_SB(1, 0), b3, voffB); PG8_STAGE(PG8_SB(1, 1), b3 + hstep, voffB); PG8_STAGE(PG8_SA(1, 0), a3, voffA);
            PG8_WAIT_V(8); PG8_WAIT_L(0); PG8_BAR; PG8_MMA(1, 0, At, B0); PG8_MMA(1, 1, At, B1); PG8_BAR; PG8_SCHED;
            } else {
            PG8_LDB(B0, 0, 0); PG8_SCHED; PG8_LDA(At, 0, 0); PG8_STAGE(PG8_SA(1, 1), a1 + hstep, voffA);
            PG8_WAIT_L(8); PG8_BAR; PG8_WAIT_L(0); PG8_MMA(0, 0, At, B0); PG8_BAR; PG8_SCHED;
            PG8_LDB(B1, 0, 1); PG8_STAGE(PG8_SB(0, 0), b2, voffB);
            PG8_BAR; PG8_WAIT_L(0); PG8_MMA(0, 1, At, B1); PG8_BAR;
            PG8_LDA(At, 0, 1); PG8_STAGE(PG8_SA(0, 0), a2, voffA);
            PG8_BAR; PG8_WAIT_L(0); PG8_MMA(1, 0, At, B0); PG8_BAR; PG8_SCHED;
            PG8_STAGE(PG8_SB(0, 1), b2 + hstep, voffB);
            PG8_WAIT_V(6); PG8_BAR; PG8_MMA(1, 1, At, B1); PG8_BAR;
            PG8_LDB(B0, 1, 0); PG8_SCHED; PG8_LDA(At, 1, 0); PG8_STAGE(PG8_SA(0, 1), a2 + hstep, voffA);
            PG8_WAIT_L(8); PG8_BAR; PG8_WAIT_L(0); PG8_MMA(0, 0, At, B0); PG8_BAR; PG8_SCHED;
            PG8_LDB(B1, 1, 1); PG8_STAGE(PG8_SB(1, 0), b3, voffB);
            PG8_BAR; PG8_WAIT_L(0); PG8_MMA(0, 1, At, B1); PG8_BAR;
            PG8_LDA(At, 1, 1); PG8_STAGE(PG8_SA(1, 0), a3, voffA);
            PG8_BAR; PG8_WAIT_L(0); PG8_MMA(1, 0, At, B0); PG8_BAR; PG8_SCHED;
            PG8_STAGE(PG8_SB(1, 1), b3 + hstep, voffB);
            PG8_WAIT_V(6); PG8_BAR; PG8_MMA(1, 1, At, B1); PG8_BAR;
            }
        }
        if constexpr (ALIGN_EPI) { if (wr == 0) PG8_BAR; }
        if constexpr (!Epi::AFTER_DRAIN) { E(acc, cur, ui, wr, wc, fr, fq); S.done(cur); }
        if (!has_next) break;
#pragma unroll
        for (int a = 0; a < 2; ++a)
#pragma unroll
            for (int b = 0; b < 2; ++b)
#pragma unroll
                for (int m = 0; m < 4; ++m)
#pragma unroll
                    for (int n = 0; n < 2; ++n) acc[a][b][m][n] = (f32x4){0.f, 0.f, 0.f, 0.f};
        cur = nxt; cA = nA; cB = nB; ++ui;
        if constexpr (ALIGN_EPI) { if (wr == 1) PG8_BAR; }
    }
    PG8_WAIT_V(0);
    if constexpr (!ALIGN_EPI) { if (wr == 0) PG8_BAR; }
    PG8_BAR;
    if constexpr (Epi::AFTER_DRAIN) { E.fused(acc, cur, wr, wc, fr, fq, lds, wid, lane); S.done(cur); }
#undef PG8_SA
#undef PG8_SB
#undef PG8_STAGE
#undef PG8_LDA
#undef PG8_LDB
#undef PG8_MMA
#undef PG8_WAIT_V
#undef PG8_WAIT_L
#undef PG8_BAR
#undef PG8_SCHED
}
}

#ifndef PG8_SP2
#define PG8_SP2 true
#endif
#ifndef PG8_ALIGN
#define PG8_ALIGN true
#endif
namespace attn2 {
using bf16 = unsigned short;
typedef short bf16x8 __attribute__((ext_vector_type(8)));
typedef short s16x4 __attribute__((ext_vector_type(4)));
typedef float f32x16 __attribute__((ext_vector_type(16)));
typedef unsigned u32x4 __attribute__((ext_vector_type(4)));
constexpr int SEQ = 8192, DQ = 64, DV = 128, PIN = 2816, POUT = 1024;
constexpr int NW = 8, QBLK = 32, KVBLK = 64, QB = NW * QBLK;
constexpr int SHM_V = KVBLK * DV * 2, SHM_K = KVBLK * DQ * 2;
constexpr int LDS_BYTES = 2 * SHM_V + 2 * SHM_K + NW * 64 * 4;
#ifndef A2_ILV
#define A2_ILV 1
#endif
constexpr float THR = 8.f;
constexpr float C2 = 0.125f * 1.4426950408889634f;
#define A2_KSWZ(row, colB) ((row) * 128 + ((colB) ^ ((((row) >> 1) & 7) << 4)))
#define A2_SBAR() __builtin_amdgcn_sched_barrier(0)
__device__ __forceinline__ int v_rd_base(int lane) { return ((lane & 3) << 3) | (((lane >> 2) & 3) << 6) | (((lane >> 4) & 1) << 5) | (((lane >> 5) & 1) << 8); }
constexpr int v_rd_off(int d0, int ks, int half) { return d0 * 512 + ks * 4096 + half * 2048; }
__device__ __forceinline__ int crow(int r, int hi) { return (r & 3) + 8 * (r >> 2) + 4 * hi; }
typedef float f32x2_a __attribute__((ext_vector_type(2))); typedef __bf16 bf16x2_a __attribute__((ext_vector_type(2)));
__device__ __forceinline__ unsigned cvtpk(float lo, float hi) { f32x2_a v = {lo, hi}; bf16x2_a b = __builtin_convertvector(v, bf16x2_a); return __builtin_bit_cast(unsigned, b); }
typedef short v4i16_t __attribute__((ext_vector_type(4)));
typedef __attribute__((address_space(3))) const char* lds_cptr;
__device__ __forceinline__ s16x4 vtr(lds_cptr p) { return __builtin_bit_cast(s16x4, __builtin_amdgcn_ds_read_tr16_b64_v4i16((__attribute__((address_space(3))) v4i16_t*)p)); }
template <int VB>
__device__ __forceinline__ void pv_tile(f32x16* o, int vb0, bf16x8 pa0, bf16x8 pa1, bf16x8 pa2, bf16x8 pa3, bool act) {
    if (!act) return;
#define A2_TRRD(dst, off) asm volatile("ds_read_b64_tr_b16 %0, %1 offset:%2" : "=&v"(dst) : "v"(vb0), "i"(off) : "memory")
#define A2_PV_D0(d0) do { s16x4 l0, l1, l2, l3, h0, h1, h2, h3; constexpr int b_ = VB * SHM_V + v_rd_off(d0, 0, 0); \
        A2_TRRD(l0, b_); A2_TRRD(h0, b_ + 2048); A2_TRRD(l1, b_ + 4096); A2_TRRD(h1, b_ + 6144); A2_TRRD(l2, b_ + 8192); A2_TRRD(h2, b_ + 10240); A2_TRRD(l3, b_ + 12288); A2_TRRD(h3, b_ + 14336); \
        asm volatile("s_waitcnt lgkmcnt(0)" ::: "memory"); A2_SBAR();   \
        o[d0] = __builtin_amdgcn_mfma_f32_32x32x16_bf16(pa0, (bf16x8){l0[0], l0[1], l0[2], l0[3], h0[0], h0[1], h0[2], h0[3]}, o[d0], 0, 0, 0);   \
        o[d0] = __builtin_amdgcn_mfma_f32_32x32x16_bf16(pa1, (bf16x8){l1[0], l1[1], l1[2], l1[3], h1[0], h1[1], h1[2], h1[3]}, o[d0], 0, 0, 0);   \
        o[d0] = __builtin_amdgcn_mfma_f32_32x32x16_bf16(pa2, (bf16x8){l2[0], l2[1], l2[2], l2[3], h2[0], h2[1], h2[2], h2[3]}, o[d0], 0, 0, 0);   \
        o[d0] = __builtin_amdgcn_mfma_f32_32x32x16_bf16(pa3, (bf16x8){l3[0], l3[1], l3[2], l3[3], h3[0], h3[1], h3[2], h3[3]}, o[d0], 0, 0, 0); } while (0)
    A2_PV_D0(0); A2_PV_D0(1); A2_PV_D0(2); A2_PV_D0(3);
#undef A2_PV_D0
#undef A2_TRRD
}
struct BlockRef { const bf16* Q; const bf16* K; const bf16* V; bf16* O; int P0; };
__device__ __forceinline__ BlockRef unit_ref(int vcu, int i, const bf16* P, bf16* O, int cq, int ck, int cv) {
    const int s = vcu & 7, hs = i >> 2, k = i & 3, hm = (vcu >> 3) + 32 * hs, qb = (k == 0) ? s : (k == 1) ? 15 - s : (k == 2) ? 16 + s : 31 - s;
    const int m = hm & 1, h = (hm >> 1) & 3, b = hm >> 3;
    const bf16* base = P + (size_t)b * SEQ * PIN;
    BlockRef r; r.Q = base + (size_t)qb * QB * PIN + cq + (2 * h + m) * 64; r.K = base + ck + (2 * h + m) * 64; r.V = base + cv + h * 128;
    r.O = O + ((size_t)b * SEQ + (size_t)qb * QB) * POUT + h * 256 + m * 128; r.P0 = qb * QB; return r;
}
template <int KB>
__device__ __forceinline__ void qkt_rel(f32x16& p0, f32x16& p1, const char* K_lds, int r32, int hi, const bf16x8* qr, const f32x16& negm, bool act) {
    if (!act) { const float NEG = -__builtin_inff();
#pragma unroll
        for (int r = 0; r < 16; ++r) { p0[r] = NEG; p1[r] = NEG; } return; }
#pragma unroll
    for (int d0 = 0; d0 < 4; ++d0) { const char* a = K_lds + KB * SHM_K + A2_KSWZ(r32, (d0 * 16 + hi * 8) * 2);
        bf16x8 b0 = *reinterpret_cast<const bf16x8*>(a);
        bf16x8 b1 = *reinterpret_cast<const bf16x8*>(a + 32 * 128);
        if (d0 == 0) { p0 = __builtin_amdgcn_mfma_f32_32x32x16_bf16(b0, qr[0], negm, 0, 0, 0); p1 = __builtin_amdgcn_mfma_f32_32x32x16_bf16(b1, qr[0], negm, 0, 0, 0); }
        else { p0 = __builtin_amdgcn_mfma_f32_32x32x16_bf16(b0, qr[d0], p0, 0, 0, 0); p1 = __builtin_amdgcn_mfma_f32_32x32x16_bf16(b1, qr[d0], p1, 0, 0, 0); } }
}
__device__ __forceinline__ void partialSM_rel(f32x16& p0, f32x16& p1, float& mhat, f32x16& negm, float& alpha, bool first) {
    float pmax = p0[0];
#pragma unroll
    for (int r = 1; r < 16; ++r) pmax = fmaxf(pmax, p0[r]);
#pragma unroll
    for (int r = 0; r < 16; ++r) pmax = fmaxf(pmax, p1[r]);
    { auto rr = __builtin_amdgcn_permlane32_swap(__float_as_uint(pmax), __float_as_uint(pmax), false, false);
      pmax = fmaxf(__uint_as_float(rr[0]), __uint_as_float(rr[1])); }
    alpha = 1.f;
    if (first || __any(pmax > THR)) { const float dl = first ? pmax : fmaxf(pmax, 0.f); mhat += dl;
#pragma unroll
        for (int r = 0; r < 16; ++r) { p0[r] -= dl; p1[r] -= dl; }
#pragma unroll
        for (int r = 0; r < 16; ++r) negm[r] = -mhat;
        asm volatile("" : "+v"(negm));
        if (!first) alpha = __builtin_amdgcn_exp2f(-dl); }
#pragma unroll
    for (int r = 0; r < 16; ++r) p0[r] = __builtin_amdgcn_exp2f(p0[r]);
}
typedef float f32x2_s __attribute__((ext_vector_type(2)));
__device__ __forceinline__ void finishSM2(f32x16& p0, f32x16& p1, float alpha, float& l_reg, bf16x8& pa0, bf16x8& pa1, bf16x8& pa2, bf16x8& pa3) {
#pragma unroll
    for (int r = 0; r < 16; ++r) p1[r] = __builtin_amdgcn_exp2f(p1[r]);
    f32x2_s sa = {p0[0], p0[1]}, sb = {p0[2], p0[3]};
#pragma unroll
    for (int r = 4; r < 16; r += 4) { sa += (f32x2_s){p0[r], p0[r + 1]}; sb += (f32x2_s){p0[r + 2], p0[r + 3]}; }
#pragma unroll
    for (int r = 0; r < 16; r += 4) { sa += (f32x2_s){p1[r], p1[r + 1]}; sb += (f32x2_s){p1[r + 2], p1[r + 3]}; }
    sa += sb; float ps = sa[0] + sa[1];
    { auto rr = __builtin_amdgcn_permlane32_swap(__float_as_uint(ps), __float_as_uint(ps), false, false);
      ps = __uint_as_float(rr[0]) + __uint_as_float(rr[1]); }
    l_reg = l_reg * alpha + ps;
#define A2_PK4(P, B_, OUT) do { u32x4 w = {cvtpk(P[B_+0], P[B_+1]), cvtpk(P[B_+2], P[B_+3]), cvtpk(P[B_+4], P[B_+5]), cvtpk(P[B_+6], P[B_+7])}; OUT = *reinterpret_cast<bf16x8*>(&w); } while (0)
    A2_PK4(p0, 0, pa0); A2_PK4(p0, 8, pa1); A2_PK4(p1, 0, pa2); A2_PK4(p1, 8, pa3);
#undef A2_PK4
}
constexpr int R_V = 0, R_K = 3 * SHM_V, R_WS = R_K + 3 * SHM_K, LDS3_BYTES = R_WS + NW * 64 * 4;
typedef __attribute__((address_space(3))) unsigned char* lds_ptr;
#define A3_WAITBAR(N) asm volatile("s_waitcnt vmcnt(" #N ") lgkmcnt(0)\n\ts_barrier" ::: "memory")
struct Dma { const bf16* ks; const bf16* va; const bf16* vb; };
__device__ __forceinline__ Dma dma_src(const bf16* Kh, const bf16* Vh, int wid, int lane) {
    Dma d;
    { const int p = wid * 64 + lane, row = p >> 3, slot = p & 7, c = slot ^ ((row >> 1) & 7); d.ks = Kh + (size_t)row * PIN + c * 8; }
#pragma unroll
    for (int j = 0; j < 2; ++j) { const int st = (2 * wid + j) * 2 + (lane >> 5), kk = (st >> 2) * 8 + ((lane & 31) >> 2), c = (st & 3) * 32 + (lane & 3) * 8;
        const int key = kk;
        const bf16* p_ = Vh + (size_t)key * PIN + c; if (j == 0) d.va = p_; else d.vb = p_; }
    return d;
}
__device__ __forceinline__ void glds16(const void* gsrc, unsigned lds_dst) { unsigned keep;
    asm volatile("s_mov_b32 %0, m0\n\ts_mov_b32 m0, %2\n\ts_nop 0\n\tglobal_load_lds_dwordx4 %1, off\n\ts_mov_b32 m0, %0" : "=&s"(keep) : "v"(gsrc), "s"(lds_dst) : "memory"); }
#define A3_DMA_K(D, t, slot) glds16((D).ks + (size_t)(t) * KVBLK * PIN, (unsigned)__builtin_amdgcn_readfirstlane(lds0 + R_K + (slot) * SHM_K + wid * 1024))
#define A3_DMA_V(D, t, slot) do { glds16((D).va + (size_t)(t) * KVBLK * PIN, (unsigned)__builtin_amdgcn_readfirstlane(lds0 + R_V + (slot) * SHM_V + wid * 2048)); \
                                  glds16((D).vb + (size_t)(t) * KVBLK * PIN, (unsigned)__builtin_amdgcn_readfirstlane(lds0 + R_V + (slot) * SHM_V + wid * 2048 + 1024)); } while (0)
struct Seam3 { bf16x8 qr[4]; };
__device__ __forceinline__ void prime3(const BlockRef& cur, char* lds, Seam3& S) {
    int tid_ = threadIdx.x; asm volatile("" : "+v"(tid_));
    const int tid = tid_, wid = __builtin_amdgcn_readfirstlane(tid >> 6), lane = tid & 63, r32 = lane & 31, hi = lane >> 5;
    const unsigned lds0 = (unsigned)(uintptr_t)lds;
    const Dma D = dma_src(cur.K, cur.V, wid, lane);
    A3_DMA_K(D, 0, 0); A3_DMA_K(D, 1, 1); A2_SBAR();
#pragma unroll
    for (int d0 = 0; d0 < 4; ++d0) S.qr[d0] = *(const bf16x8*)(cur.Q + (size_t)(wid * QBLK + r32) * PIN + d0 * 16 + hi * 8);
    A2_SBAR();
    A3_WAITBAR(5);
    A3_DMA_V(D, 0, 0);
}
__device__ __forceinline__ void block3(const BlockRef& cur, const BlockRef& nxt, char* lds, Seam3& S) {
    int tid_ = threadIdx.x; asm volatile("" : "+v"(tid_));
    const int tid = tid_, wid = __builtin_amdgcn_readfirstlane(tid >> 6), lane = tid & 63, r32 = lane & 31, hi = lane >> 5;
    const int NT = (cur.P0 + QB) / KVBLK;
    const int wchunk = (cur.P0 + wid * QBLK) >> 6;
    const unsigned lds0 = (unsigned)(uintptr_t)lds;
    char* V_lds = lds + R_V; char* K_lds = lds + R_K;
    float* ws = (float*)(lds + R_WS) + wid * 64; float* li_l = ws, * al_l = ws + 32;
    float mhat = 0.f, l_reg = 0; f32x16 o[4] = {}; f32x16 negm = {}; asm volatile("" : "+v"(negm));
    const int vb0 = (int)(uintptr_t)V_lds + v_rd_base(lane);
    const lds_cptr vb3 = (lds_cptr)V_lds + v_rd_base(lane);
    const Dma D = dma_src(cur.K, cur.V, wid, lane);
    int s0 = 0, s1 = 1, s2 = 2;
#define A3_ROT() do { const int t_ = s0; s0 = s1; s1 = s2; s2 = t_; } while (0)
#define A2_RESC(a) do { if (__any((a) < 1.f)) { if (hi == 0) al_l[r32] = (a); asm volatile("s_waitcnt lgkmcnt(0)" ::: "memory");              \
                     _Pragma("unroll") for (int d_ = 0; d_ < 4; ++d_) _Pragma("unroll") for (int r = 0; r < 16; ++r) o[d_][r] *= al_l[crow(r, hi)]; } } while (0)
#define A2_ACT(t) ((t) <= wchunk)
    f32x16 pA0, pA1, pB0, pB1; float mnA, mnB, alA, alB; bf16x8 pa0, pa1, pa2, pa3;
    A2_SBAR(); qkt_rel<0>(pA0, pA1, K_lds, r32, hi, S.qr, negm, true);
    A3_DMA_K(D, 2, 2); A3_DMA_V(D, 1, 1);
    partialSM_rel(pA0, pA1, mhat, negm, alA, true);
    A2_SBAR(); A3_WAITBAR(3);
#define A2_VFR(i) (bf16x8){vl[(i) & 3][0], vl[(i) & 3][1], vl[(i) & 3][2], vl[(i) & 3][3], vh[(i) & 3][0], vh[(i) & 3][1], vh[(i) & 3][2], vh[(i) & 3][3]}
#define A2_VRD(i, VBP) do { vl[(i) & 3] = vtr((VBP) + ((i) & 3) * 512 + ((i) >> 2) * 4096); vh[(i) & 3] = vtr((VBP) + ((i) & 3) * 512 + ((i) >> 2) * 4096 + 2048); } while (0)
#define A2_PAK(i) (((i) >> 2) == 0 ? pa0 : ((i) >> 2) == 1 ? pa1 : ((i) >> 2) == 2 ? pa2 : pa3)
#define A2_GAP(i, PX0, PX1, mnX, alX, VBP) do {                                                                               \
        if ((i) + 2 < 16) A2_VRD((i) + 2, VBP);                                                                               \
        o[(i) & 3] = __builtin_amdgcn_mfma_f32_32x32x16_bf16(A2_PAK(i), A2_VFR(i), o[(i) & 3], 0, 0, 0);                     \
        if ((i) < 4) { const int j_ = 4 * (i);                                                                               \
            if ((i) == 0) { mxa = __builtin_fmaxf(PX0[0], PX0[1]); mxb = __builtin_fmaxf(PX0[2], PX0[3]); }                  \
            else { mxa = __builtin_fmaxf(__builtin_fmaxf(mxa, PX0[j_]), PX0[j_ + 1]); mxb = __builtin_fmaxf(__builtin_fmaxf(mxb, PX0[j_ + 2]), PX0[j_ + 3]); } \
            mxa = __builtin_fmaxf(__builtin_fmaxf(mxa, PX1[j_]), PX1[j_ + 1]); mxb = __builtin_fmaxf(__builtin_fmaxf(mxb, PX1[j_ + 2]), PX1[j_ + 3]);         \
            asm volatile("" : "+v"(mxa), "+v"(mxb)); }                                                                       \
        else if ((i) == 4) { float pmax = __builtin_fmaxf(mxa, mxb);                                                         \
            { auto rr = __builtin_amdgcn_permlane32_swap(__float_as_uint(pmax), __float_as_uint(pmax), false, false); pmax = __builtin_fmaxf(__uint_as_float(rr[0]), __uint_as_float(rr[1])); } \
            alX = 1.f;                                                                                                       \
            if (__builtin_expect(__any(pmax > THR), 0)) { const float dl_ = __builtin_fmaxf(pmax, 0.f); mhat += dl_;          \
                _Pragma("unroll") for (int r_ = 0; r_ < 16; ++r_) { PX0[r_] -= dl_; PX1[r_] -= dl_; }                         \
                _Pragma("unroll") for (int r_ = 0; r_ < 16; ++r_) negm[r_] = -mhat;                                           \
                asm volatile("" : "+v"(negm)); alX = __builtin_amdgcn_exp2f(-dl_); }                                          \
            asm volatile("" : "+v"(alX), "+v"(PX0), "+v"(PX1)); }                                                            \
        else if ((i) < 13) { const int k_ = 2 * ((i) - 5);                                                                   \
            PX0[k_] = __builtin_amdgcn_exp2f(PX0[k_]); PX0[k_ + 1] = __builtin_amdgcn_exp2f(PX0[k_ + 1]);                     \
            asm volatile("" : "+v"(PX0)); }                                                                                  \
        A2_SBAR(); } while (0)
#define A2_PVSM(PX0, PX1, mnX, alX, VBP) do { s16x4 vl[4], vh[4]; float mxa, mxb;                                             \
        A2_VRD(0, VBP); A2_VRD(1, VBP); A2_SBAR();                                                                             \
        A2_GAP(0, PX0, PX1, mnX, alX, VBP); A2_GAP(1, PX0, PX1, mnX, alX, VBP); A2_GAP(2, PX0, PX1, mnX, alX, VBP); A2_GAP(3, PX0, PX1, mnX, alX, VBP);       \
        A2_GAP(4, PX0, PX1, mnX, alX, VBP); A2_GAP(5, PX0, PX1, mnX, alX, VBP); A2_GAP(6, PX0, PX1, mnX, alX, VBP); A2_GAP(7, PX0, PX1, mnX, alX, VBP);       \
        A2_GAP(8, PX0, PX1, mnX, alX, VBP); A2_GAP(9, PX0, PX1, mnX, alX, VBP); A2_GAP(10, PX0, PX1, mnX, alX, VBP); A2_GAP(11, PX0, PX1, mnX, alX, VBP);     \
        A2_GAP(12, PX0, PX1, mnX, alX, VBP); A2_GAP(13, PX0, PX1, mnX, alX, VBP); A2_GAP(14, PX0, PX1, mnX, alX, VBP); A2_GAP(15, PX0, PX1, mnX, alX, VBP);   \
    } while (0)
#define A2_SG(mask, n) __builtin_amdgcn_sched_group_barrier(mask, n, 0)
#define A3_FAST_STEP(PX0, PX1, mnX, alX, PY0, PY1, alY, t) do {                                                      \
        A2_SBAR(); qkt_rel<0>(PX0, PX1, K_lds + s1 * SHM_K, r32, hi, S.qr, negm, true);                                             \
        finishSM2(PY0, PY1, alY, l_reg, pa0, pa1, pa2, pa3);                                                           \
        A3_DMA_K(D, (t) + 2, s0); A3_DMA_V(D, (t) + 1, s2);                                               \
        asm volatile("" : "+v"(pa0), "+v"(pa1), "+v"(pa2), "+v"(pa3), "+v"(l_reg)); asm volatile("" : "+v"(PX0), "+v"(PX1));         \
        A2_SG(0x100, 4); _Pragma("unroll") for (int g_ = 0; g_ < 8; ++g_) { A2_SG(0x008, 1); A2_SG(0x002, 5); A2_SG(0x400, 2); A2_SG(0x100, 1); }      \
        A2_SBAR();                                                                                                            \
        { const lds_cptr vbs_ = vb3 + s0 * SHM_V; A2_PVSM(PX0, PX1, mnX, alX, vbs_); }                                        \
        A2_SBAR(); A2_RESC(alX);                                                                                              \
        A3_WAITBAR(3); A3_ROT(); } while (0)
#define A3_BAND_STEP(PX0, PX1, mnX, alX, PY0, PY1, alY, t) do {                                                      \
        f32x16 cn_ = negm; if (!A2_ACT(t)) { _Pragma("unroll") for (int r_ = 0; r_ < 16; ++r_) cn_[r_] = -__builtin_inff(); }   \
        A2_SBAR(); qkt_rel<0>(PX0, PX1, K_lds + s1 * SHM_K, r32, hi, S.qr, cn_, true);                                             \
        finishSM2(PY0, PY1, alY, l_reg, pa0, pa1, pa2, pa3);                                                           \
        if ((t) + 2 < NT) A3_DMA_K(D, (t) + 2, s0);                                                                           \
        if ((t) + 1 < NT) A3_DMA_V(D, (t) + 1, s2);                                                                           \
        asm volatile("" : "+v"(pa0), "+v"(pa1), "+v"(pa2), "+v"(pa3), "+v"(l_reg)); asm volatile("" : "+v"(PX0), "+v"(PX1));         \
        A2_SBAR();                                                                                                            \
        { const lds_cptr vbs_ = vb3 + s0 * SHM_V; A2_PVSM(PX0, PX1, mnX, alX, vbs_); }                                        \
        A2_SBAR(); A2_RESC(alX);                                                                                              \
        if ((t) + 2 < NT) A3_WAITBAR(3); else if ((t) + 1 < NT) A3_WAITBAR(2); else A3_WAITBAR(0);                            \
        A3_ROT(); } while (0)
    int t = 1;
    for (; t + 1 < NT - 4; t += 2) {
        A3_FAST_STEP(pB0, pB1, mnB, alB, pA0, pA1, alA, t);
        A3_FAST_STEP(pA0, pA1, mnA, alA, pB0, pB1, alB, t + 1);
    }
    for (; t + 1 < NT; t += 2) {
        A3_BAND_STEP(pB0, pB1, mnB, alB, pA0, pA1, alA, t);
        A3_BAND_STEP(pA0, pA1, mnA, alA, pB0, pB1, alB, t + 1);
    }
    A2_SBAR(); qkt_rel<0>(pB0, pB1, K_lds + s1 * SHM_K, r32, hi, S.qr, negm, A2_ACT(NT - 1));
    finishSM2(pA0, pA1, alA, l_reg, pa0, pa1, pa2, pa3); A2_SBAR();
    pv_tile<0>(o, vb0 + s0 * SHM_V, pa0, pa1, pa2, pa3, A2_ACT(NT - 2)); partialSM_rel(pB0, pB1, mhat, negm, alB, false);
    A2_SBAR(); A2_RESC(alB);
    A3_WAITBAR(0);
    const Dma Dn = dma_src(nxt.K, nxt.V, wid, lane);
    A3_DMA_K(Dn, 0, 0); A3_DMA_K(Dn, 1, 1); A2_SBAR();
#pragma unroll
    for (int d0 = 0; d0 < 4; ++d0) S.qr[d0] = *(const bf16x8*)(nxt.Q + (size_t)(wid * QBLK + r32) * PIN + d0 * 16 + hi * 8);
    A2_SBAR();
    finishSM2(pB0, pB1, alB, l_reg, pa0, pa1, pa2, pa3); A2_SBAR(); pv_tile<0>(o, vb0 + s1 * SHM_V, pa0, pa1, pa2, pa3, A2_ACT(NT - 1));
    A2_SBAR();
    if (hi == 0) li_l[r32] = l_reg; asm volatile("s_waitcnt lgkmcnt(0)" ::: "memory");
    float rli[16];
#pragma unroll
    for (int r = 0; r < 16; ++r) rli[r] = __builtin_amdgcn_rcpf(li_l[crow(r, hi)]);
    A2_SBAR();
    asm volatile("s_waitcnt vmcnt(5)" ::: "memory");
    A2_SBAR();
    bf16* Ow = cur.O + (size_t)(wid * QBLK) * POUT;
#pragma unroll
    for (int r = 0; r < 16; ++r) { const int orow = crow(r, hi);
#pragma unroll
        for (int d0 = 0; d0 < 4; ++d0) { const float v = o[d0][r] * rli[r];
            const float vn = __shfl_xor(v, 1);
            if ((r32 & 1) == 0) *(unsigned*)(Ow + (size_t)orow * POUT + d0 * 32 + r32) = cvtpk(v, vn); } }
    A2_SBAR();
    asm volatile("s_waitcnt lgkmcnt(0)\n\ts_barrier" ::: "memory");
    A3_DMA_V(Dn, 0, 0);
#undef A3_ROT
#undef A2_RESC
#undef A2_ACT
#undef A2_VFR
#undef A2_VRD
#undef A2_PAK
#undef A2_GAP
#undef A2_PVSM
#undef A2_SG
#undef A3_FAST_STEP
#undef A3_BAND_STEP
}
__device__ __forceinline__ void attn_phase3(char* lds, const bf16* P, bf16* O, int vcu, int cq, int ck, int cv) {
    Seam3 S; BlockRef cur = unit_ref(vcu, 0, P, O, cq, ck, cv);
    prime3(cur, lds, S);
    for (int i = 0; i < 8; ++i) { const BlockRef nxt = (i + 1 < 8) ? unit_ref(vcu, i + 1, P, O, cq, ck, cv) : cur;
        block3(cur, nxt, lds, S); cur = nxt; }
    asm volatile("s_waitcnt vmcnt(0)\n\ts_barrier" ::: "memory");
}
#undef A2_KSWZ
#undef A2_SBAR
#undef A2_VMW
#undef A2_VMWN
#undef A2_SLOAD
#undef A2_SWRITE_K
#undef A2_SWRITE_V
}
#define GAS __attribute__((address_space(1)))
#define LAS __attribute__((address_space(3)))
typedef unsigned short bf16;
typedef unsigned v4u __attribute__((ext_vector_type(4)));
typedef float f32x4 __attribute__((ext_vector_type(4)));
typedef short bf16x8 __attribute__((ext_vector_type(8)));
typedef GAS unsigned gu32;
typedef GAS unsigned long long gu64;
#define RLX_AGENT __ATOMIC_RELAXED, __HIP_MEMORY_SCOPE_AGENT
#define LDS_WAIT() asm volatile("s_waitcnt lgkmcnt(0)" ::: "memory")
#define VM_WAIT() asm volatile("s_waitcnt vmcnt(0)" ::: "memory")
__device__ __forceinline__ unsigned long long rt() { return __builtin_amdgcn_s_memrealtime(); }
__device__ __forceinline__ unsigned f2bf(float f) { unsigned u = __builtin_bit_cast(unsigned, f); return (u + 0x7fffu + ((u >> 16) & 1u)) >> 16; }
__device__ __forceinline__ unsigned pk2(float lo, float hi) { return f2bf(lo) | (f2bf(hi) << 16); }

#define XB_TMO      128
#define XB_XCNT(j)  (256  + 64 * (j))
#define XB_XSUB(j)  (1280 + 64 * (j))
#define XB_XGEN(j)  (2304 + 64 * (j))
#define XB_TOP      3328
#define XB_TOPGEN   3392
#define XCD_BAR_WORDS 3456
#define XB_SPIN_CAP (1u << 18)

__device__ __forceinline__ unsigned xb_ld(unsigned* p)              { return __hip_atomic_load(p, __ATOMIC_RELAXED, __HIP_MEMORY_SCOPE_AGENT); }
__device__ __forceinline__ unsigned xb_add(unsigned* p, unsigned v) { return __hip_atomic_fetch_add(p, v, __ATOMIC_RELAXED, __HIP_MEMORY_SCOPE_AGENT); }
__device__ __forceinline__ unsigned xb_xcc_id() { return (unsigned)__builtin_amdgcn_s_getreg((3 << 11) | 20) & 0xFu; }
#define XB_SPIN(cond, bar) do { unsigned _sp = 0; while (cond) { __builtin_amdgcn_s_sleep(1); \
    if ((++_sp & 255u) == 0u) { if (xb_ld(&(bar)[XB_TMO])) break; if (_sp > XB_SPIN_CAP) { atomicAdd(&(bar)[XB_TMO], 1u); break; } } } } while (0)

struct XcdBarrier {
    unsigned* bar; unsigned x;
    volatile LAS unsigned* st;
};

__device__ __forceinline__ XcdBarrier xcd_barrier_post(unsigned* bar, volatile LAS unsigned* st) {
    XcdBarrier b; b.bar = bar; b.x = xb_xcc_id(); b.st = st;
    if (threadIdx.x == 0) (void)xb_add(&bar[XB_XCNT(b.x)], 1u);
    return b;
}
__device__ __forceinline__ void xcd_barrier_complete(unsigned* bar, unsigned x, unsigned& nloc, unsigned& nx) {
    const unsigned G = gridDim.x * gridDim.y * gridDim.z;
    unsigned sum, cnt, mine, sp = 0u;
    for (;;) {
        sum = 0u; cnt = 0u; mine = 0u;
#pragma unroll
        for (unsigned j = 0; j < 16; ++j) { const unsigned c = xb_ld(&bar[XB_XCNT(j)]); sum += c; cnt += (c > 0u) ? 1u : 0u; mine = (j == x) ? c : mine; }
        if (sum == G) break;
        __builtin_amdgcn_s_sleep(1);
        if ((++sp & 255u) == 0u) { if (xb_ld(&bar[XB_TMO])) break; if (sp > XB_SPIN_CAP) { atomicAdd(&bar[XB_TMO], 1u); break; } }
    }
    nloc = mine > 0u ? mine : 1u; nx = cnt > 0u ? cnt : 1u;
}

__device__ __forceinline__ void xcd_barrier(const XcdBarrier& b) {
    asm volatile("s_waitcnt vmcnt(0)" ::: "memory");
    __syncthreads();
    if (threadIdx.x == 0) {
        unsigned* bar = b.bar;
        __builtin_amdgcn_s_waitcnt(0);
        unsigned nloc = b.st[0], nx = b.st[1];
        if (nloc == 0u) { xcd_barrier_complete(bar, b.x, nloc, nx); b.st[0] = nloc; b.st[1] = nx; }
        const unsigned old = xb_add(&bar[XB_XSUB(b.x)], 1u);
        const unsigned gen = old / nloc;
        if (old + 1u == (gen + 1u) * nloc) {
            __builtin_amdgcn_fence(__ATOMIC_RELEASE, "agent");
            asm volatile("s_waitcnt vmcnt(0)" ::: "memory");
            const unsigned og = xb_add(&bar[XB_TOP], 1u);
            const unsigned tg = og / nx;
            if (og + 1u == (tg + 1u) * nx) xb_add(&bar[XB_TOPGEN], 1u);
            else XB_SPIN(xb_ld(&bar[XB_TOPGEN]) == tg, bar);
            __builtin_amdgcn_fence(__ATOMIC_ACQUIRE, "agent");
            xb_add(&bar[XB_XGEN(b.x)], 1u);
            asm volatile("s_waitcnt vmcnt(0)" ::: "memory");
        } else {
            XB_SPIN(xb_ld(&bar[XB_XGEN(b.x)]) == gen, bar);
            __builtin_amdgcn_fence(__ATOMIC_ACQUIRE, "agent");
            asm volatile("s_waitcnt vmcnt(0)" ::: "memory");
        }
    }
    __syncthreads();
}

constexpr int NWAVES = 8;
#ifndef MK_PER_PHASE
#define MK_PER_PHASE 0
#endif

constexpr int BATCH = 8, SEQ = 8192, D = 1024, FF = 4096, DEPTH = 2;
constexpr int M = BATCH * SEQ;
constexpr int CHUNK = 64, NCH = SEQ / CHUNK;
constexpr int NP_SRC = 2576;
constexpr int NP = 2816;
constexpr int C_POOL = 0, C_DQ = 256, C_DK = 768, C_DV = 1280, C_GQ = 1792, C_GK = 1920, C_GV = 2048, C_GR = 2304, C_GG = 2560;
constexpr float EPS = 1e-6f;
static_assert(NP == attn2::PIN && D == attn2::POUT && attn2::LDS_BYTES <= 131072 && attn2::LDS3_BYTES <= 131072, "attention body geometry");

constexpr size_t MiB = 1u << 20;
constexpr size_t WS_CTL = 0, CTL_ZERO_BYTES = 1 * MiB;
constexpr size_t WS_WPOOL = 1 * MiB;
constexpr size_t WS_W = 2 * MiB, W_LAYER = 24 * MiB;
constexpr size_t WO_IN = 0, WO_OUT = 6 * MiB, WO_1 = 8 * MiB, WO_2 = 16 * MiB;
constexpr size_t WS_SSA = 50 * MiB, WS_SSB = 54 * MiB;
constexpr size_t WS_GDEC = 58 * MiB;
constexpr size_t WS_GKV = 60 * MiB;
constexpr size_t WS_HB = 96 * MiB;
constexpr size_t WS_PROJ = 224 * MiB;
constexpr size_t WS_OATT = 576 * MiB;
constexpr size_t WS_MIX = 704 * MiB;
constexpr size_t WS_HID = 224 * MiB;
constexpr size_t WS_END = 832 * MiB;
static_assert(WS_W + DEPTH * W_LAYER <= WS_SSA && WS_GKV + (size_t)BATCH * 4 * NCH * 2048 * 4 <= WS_HB && WS_HB + (size_t)M * D * 2 <= WS_PROJ && WS_PROJ + (size_t)M * NP * 2 <= WS_OATT && WS_HID + (size_t)M * FF * 2 <= WS_END, "d_ws map");
constexpr int CW_TMO = 0, CW_CODE = 1;
constexpr int CW_BAR = 4096;

constexpr int RING_OFF = 0, RING_BYTES = 131072;
constexpr int LDSCTL_OFF = RING_BYTES, MISC_OFF = LDSCTL_OFF + 320;
constexpr int RST_OFF = MISC_OFF + 128, RST_MAXU = 16;
constexpr int LDS_BYTES = 155648;
static_assert(RST_OFF % 16 == 0 && RST_OFF + RST_MAXU * 256 * 4 <= LDS_BYTES, "LDS map");

struct Frame {
    LAS unsigned char* lds;
    volatile LAS unsigned* MISC;
    gu32* ctl;
    int tid, lane, wave;
    int vcu, G;
};
typedef float f32x16 __attribute__((ext_vector_type(16)));
typedef unsigned u32x2v __attribute__((ext_vector_type(2)));
__device__ __forceinline__ float wave_sum(float v) {
#pragma unroll
    for (int o = 1; o < 64; o <<= 1) v += __shfl_xor(v, o);
    return v;
}
__device__ __forceinline__ float bf2f(unsigned short b) { return __uint_as_float((unsigned)b << 16); }
typedef float f32x2_c __attribute__((ext_vector_type(2))); typedef __bf16 bf16x2_c __attribute__((ext_vector_type(2)));
__device__ __forceinline__ unsigned cvtpk(float lo, float hi) { f32x2_c v = {lo, hi}; bf16x2_c b = __builtin_convertvector(v, bf16x2_c); return __builtin_bit_cast(unsigned, b); }
__device__ __forceinline__ bf16x8 pack8(const float (&v)[8]) { v4u w; w.x = cvtpk(v[0], v[1]); w.y = cvtpk(v[2], v[3]); w.z = cvtpk(v[4], v[5]); w.w = cvtpk(v[6], v[7]); return __builtin_bit_cast(bf16x8, w); }
__device__ __forceinline__ void unpack8(v4u w, float (&v)[8]) {
    v[0] = __uint_as_float(w.x << 16); v[1] = __uint_as_float(w.x & 0xffff0000u); v[2] = __uint_as_float(w.y << 16); v[3] = __uint_as_float(w.y & 0xffff0000u);
    v[4] = __uint_as_float(w.z << 16); v[5] = __uint_as_float(w.z & 0xffff0000u); v[6] = __uint_as_float(w.w << 16); v[7] = __uint_as_float(w.w & 0xffff0000u); }
__device__ __forceinline__ int crow(int r, int hi) { return (r & 3) + 8 * (r >> 2) + 4 * hi; }
__device__ __forceinline__ float ex2(float x) { return __builtin_amdgcn_exp2f(x); }
__device__ __forceinline__ float ls16(float x) { const float L2E = 1.4426950408889634f;
    return (__builtin_fminf(x, 0.f) * L2E - __builtin_amdgcn_logf(1.f + ex2(-__builtin_fabsf(x) * L2E))) * (1.0f / 16.0f); }

__device__ __forceinline__ void p0_item_out(bf16* WT, int K, int row_off, int k0, int n0, LAS float* scr, int lane) {
    LDS_WAIT(); asm volatile("" ::: "memory");
    const int c = lane & 7;
#pragma unroll
    for (int j = 0; j < 4; ++j) { const int n = (lane >> 3) + 8 * j; const LAS float* s = scr + (8 * c) * 33 + n;
        v4u o; o.x = pk2(s[0 * 33], s[1 * 33]); o.y = pk2(s[2 * 33], s[3 * 33]); o.z = pk2(s[4 * 33], s[5 * 33]); o.w = pk2(s[6 * 33], s[7 * 33]);
        *(GAS v4u*)(WT + (size_t)(row_off + n0 + n) * K + k0 + 8 * c) = o; }
    LDS_WAIT(); asm volatile("" ::: "memory");
}
__device__ __forceinline__ void p0_transpose_item(const float* W, int K, int ldw, int col_off, int ncols, const float* gk, bf16* WT, int row_off, LAS float* scr, int item, int lane) {
    const int nblk = ncols / 32, kb = item / nblk, nb = item % nblk, k0 = 64 * kb, n0 = 32 * nb;
    const int kr = lane >> 3, nc = (lane & 7) * 4;
    f32x4 v[8]; float g[8];
#pragma unroll
    for (int j = 0; j < 8; ++j) { v[j] = *(const GAS f32x4*)(W + (size_t)(k0 + 8 * j + kr) * ldw + col_off + n0 + nc); g[j] = gk ? gk[k0 + 8 * j + kr] : 1.f; }
#pragma unroll
    for (int j = 0; j < 8; ++j) { LAS float* d = scr + (8 * j + kr) * 33 + nc; d[0] = v[j][0] * g[j]; d[1] = v[j][1] * g[j]; d[2] = v[j][2] * g[j]; d[3] = v[j][3] * g[j]; }
    p0_item_out(WT, K, row_off, k0, n0, scr, lane);
}
__device__ __forceinline__ void p0_gate_item(const float* Win, const float* wg2, const float* gk, bf16* WT, int row_off, LAS float* scr, int item, int lane) {
    const int kb = item / 4, nb = item % 4, k0 = 64 * kb, n0 = 32 * nb; const int c = n0 + (lane & 31);
    float w2[16];
#pragma unroll
    for (int r = 0; r < 16; ++r) w2[r] = wg2[r * 128 + c];
#pragma unroll 4
    for (int i = 0; i < 32; ++i) { const int kk = 2 * i + (lane >> 5); const float* wr_ = Win + (size_t)(k0 + kk) * NP_SRC + C_GG; float a = 0.f;
#pragma unroll
        for (int r = 0; r < 16; ++r) a += wr_[r] * w2[r];
        scr[kk * 33 + (lane & 31)] = a * gk[k0 + kk]; }
    p0_item_out(WT, D, row_off, k0, n0, scr, lane);
}
template <int R> __device__ __forceinline__ void x_rows_to_bf16(const float* x, bf16* hb, float* ss, int row0, int rstride, int lane) {
    f32x4 v[R][4];
#pragma unroll
    for (int r = 0; r < R; ++r) { const GAS f32x4* xr = (const GAS f32x4*)(x + (size_t)(row0 + r * rstride) * D) + lane;
#pragma unroll
        for (int j = 0; j < 4; ++j) v[r][j] = xr[64 * j]; }
#pragma unroll
    for (int r = 0; r < R; ++r) { float s2 = 0.f;
#pragma unroll
        for (int j = 0; j < 4; ++j) s2 += (v[r][j].x * v[r][j].x + v[r][j].y * v[r][j].y) + (v[r][j].z * v[r][j].z + v[r][j].w * v[r][j].w);
        s2 = wave_sum(s2);
        GAS unsigned long long* o8 = (GAS unsigned long long*)(hb + (size_t)(row0 + r * rstride) * D) + lane;
#pragma unroll
        for (int j = 0; j < 4; ++j) o8[64 * j] = (unsigned long long)pk2(v[r][j].x, v[r][j].y) | ((unsigned long long)pk2(v[r][j].z, v[r][j].w) << 32);
        if (lane < 16) ss[(size_t)(row0 + r * rstride) * 16 + lane] = (lane == 0) ? s2 : 0.f; }
}

struct Inputs {
    const float *x, *norm1_g, *w_in, *pool_w, *pool_scale, *lq1, *lk1, *lq2, *lk2, *diff_norm_g, *w_gate2, *b_gate, *gla_norm_g, *w_out, *norm2_g, *w_mlp1, *w_mlp2, *final_g;
};

__device__ __forceinline__ void p0_prologue(Frame& F, const Inputs& I, unsigned char* ws) {
    LAS float* scr = (LAS float*)(F.lds + RING_OFF + F.wave * 16384);
    const int gw = F.vcu * NWAVES + F.wave, NGW = F.G * NWAVES;
    constexpr int I_IN = (D / 64) * (2560 / 32), I_G = (D / 64) * 4, I_O = (D / 64) * (D / 32), I_1 = (D / 64) * (FF / 32), I_2 = (FF / 64) * (D / 32);
    constexpr int NIT = I_IN + I_G + I_O + I_1 + I_2;
    for (int it = gw; it < DEPTH * NIT; it += NGW) {
        const int l = it / NIT; int r = it % NIT;
        unsigned char* wl = ws + WS_W + (size_t)l * W_LAYER;
        const float* win = I.w_in + (size_t)l * D * NP_SRC; const float* g1 = I.norm1_g + l * D; const float* g2 = I.norm2_g + l * D;
        if (r < I_IN) { p0_transpose_item(win, D, NP_SRC, 0, 2560, g1, (bf16*)(wl + WO_IN), 0, scr, r, F.lane); continue; } r -= I_IN;
        if (r < I_G) { p0_gate_item(win, I.w_gate2 + (size_t)l * 16 * 128, g1, (bf16*)(wl + WO_IN), C_GG, scr, r, F.lane); continue; } r -= I_G;
        if (r < I_O) { p0_transpose_item(I.w_out + (size_t)l * D * D, D, D, 0, D, nullptr, (bf16*)(wl + WO_OUT), 0, scr, r, F.lane); continue; } r -= I_O;
        if (r < I_1) { p0_transpose_item(I.w_mlp1 + (size_t)l * D * FF, D, FF, 0, FF, g2, (bf16*)(wl + WO_1), 0, scr, r, F.lane); continue; } r -= I_1;
        p0_transpose_item(I.w_mlp2 + (size_t)l * FF * D, FF, D, 0, D, nullptr, (bf16*)(wl + WO_2), 0, scr, r, F.lane);
    }
    { const int gt = F.vcu * (NWAVES * 64) + F.tid, NT_ = F.G * NWAVES * 64;
      for (int i = gt; i < DEPTH * 16384; i += NT_) { const int l = i / 16384, o = i % 16384;
          *(GAS v4u*)(ws + WS_W + (size_t)l * W_LAYER + WO_IN + (size_t)2688 * D * 2 + (size_t)o * 16) = (v4u){0u, 0u, 0u, 0u}; }
      for (int i = gt; i < DEPTH * 4 * 64 * 64; i += NT_) { const int ch = i & 63, d = (i >> 6) & 63, lg = i >> 12;
          ((bf16*)(ws + WS_WPOOL))[i] = (bf16)f2bf(I.pool_w[(size_t)lg * 4096 + ch * 64 + d] * I.pool_scale[(size_t)lg * 64 + d]); } }
    { int m = gw; for (; m + 3 * NGW < M; m += 4 * NGW) x_rows_to_bf16<4>(I.x, (bf16*)(ws + WS_HB), (float*)(ws + WS_SSB), m, NGW, F.lane);
      for (; m < M; m += NGW) x_rows_to_bf16<1>(I.x, (bf16*)(ws + WS_HB), (float*)(ws + WS_SSB), m, NGW, F.lane); }
}

__device__ __forceinline__ void gla_scan(float* GKV, const float* GDEC, int gtid, int nthreads) {
    for (int id = gtid; id < BATCH * 4 * 2048; id += nthreads) {
        const int bh = id >> 11, ed = id & 2047;
        float* p = GKV + (size_t)bh * NCH * 2048 + ed; const float* dp = GDEC + (size_t)bh * NCH * 32 + (ed & 31);
        float s = 0.f;
#pragma unroll 1
        for (int n0 = 0; n0 < NCH; n0 += 16) {
            float kv[16], dc[16];
#pragma unroll
            for (int i = 0; i < 16; ++i) { kv[i] = p[(size_t)(n0 + i) * 2048]; dc[i] = dp[(n0 + i) * 32]; }
#pragma unroll
            for (int i = 0; i < 16; ++i) { p[(size_t)(n0 + i) * 2048] = s; s = s * dc[i] + kv[i]; }
        }
    }
}
constexpr int PA_PP = 528, PA_GP = 272;
constexpr int PA_POOL = 0, PA_GATE = 80 * PA_PP, PA_GK = PA_GATE + 64 * PA_GP, PA_GV = PA_GK + 64 * PA_GP, PA_END = PA_GV + 64 * PA_PP;
static_assert(PA_END <= RING_BYTES, "phase A LDS");
constexpr int PA_NPIECE = 79 * 32 + 64 * 16 + 64 * 16 + 64 * 32, PA_NI = (PA_NPIECE + 511) / 512;
__device__ __forceinline__ void pa_piece(int p, int tb, int sb, long& goff, int& loff) {
    if (p < 79 * 32) { const int row = p >> 5, pc = p & 31; loff = PA_POOL + row * PA_PP + pc * 16; goff = (sb - 15 + row >= 0) ? ((long)(tb - 15 + row) * NP + C_POOL + pc * 8) : -1; return; }
    p -= 79 * 32;
    if (p < 64 * 16) { const int row = p >> 4, pc = p & 15; loff = PA_GATE + row * PA_GP + pc * 16; goff = (long)(tb + row) * NP + C_GG + pc * 8; return; }
    p -= 64 * 16;
    if (p < 64 * 16) { const int row = p >> 4, pc = p & 15; loff = PA_GK + row * PA_GP + pc * 16; goff = (long)(tb + row) * NP + C_GK + pc * 8; return; }
    p -= 64 * 16;
    if (p < 64 * 32) { const int row = p >> 5, pc = p & 31; loff = PA_GV + row * PA_PP + pc * 16; goff = (long)(tb + row) * NP + C_GV + pc * 8; return; }
    loff = -1; goff = -1;
}
struct StageA { v4u r[PA_NI]; };
__device__ __forceinline__ void stageA_load(StageA& S, const bf16* PROJ, int ck, int tid) {
    asm volatile("" : "+v"(tid));
    const int tb = ck * CHUNK, sb = (ck % NCH) * CHUNK;
#pragma unroll
    for (int i = 0; i < PA_NI; ++i) { long goff; int loff; pa_piece(tid + 512 * i, tb, sb, goff, loff);
        S.r[i] = (goff >= 0) ? *(const GAS v4u*)(PROJ + goff) : (v4u){0u, 0u, 0u, 0u}; }
}
__device__ __forceinline__ void stageA_store(const StageA& S, LAS unsigned char* lds, int ck, int tid) {
    asm volatile("" : "+v"(tid));
    const int tb = ck * CHUNK, sb = (ck % NCH) * CHUNK;
#pragma unroll
    for (int i = 0; i < PA_NI; ++i) { long goff; int loff; pa_piece(tid + 512 * i, tb, sb, goff, loff);
        if (loff >= 0) *(LAS v4u*)(lds + loff) = S.r[i]; }
}
struct PoolW { bf16x8 Af[2][4]; };
__device__ __forceinline__ void pool_w_load(PoolW& W, const bf16* WpT, int g, int lane) {
    const int c = lane & 31, hh = lane >> 5; const bf16* Wg = WpT + (size_t)g * 4096;
#pragma unroll
    for (int db = 0; db < 2; ++db)
#pragma unroll
        for (int ks = 0; ks < 4; ++ks) W.Af[db][ks] = *(const GAS bf16x8*)(Wg + (size_t)(32 * db + c) * 64 + 16 * ks + 8 * hh);
}
__device__ __forceinline__ void pool_task2(const LAS unsigned char* lds, const PoolW& W, bf16* MIX, int ck, int g, int tbk0, int tbk1, int lane) {
    const int c = lane & 31, hh = lane >> 5; const int tb = ck * CHUNK, sb = (ck % NCH) * CHUNK; const int w = 2 << g;
#pragma unroll 1
    for (int tbk = tbk0; tbk < tbk1; ++tbk) {
        bf16x8 Bf[4];
        const int s = sb + 32 * tbk + c; const int cnt = (s + 1 < w) ? (s + 1) : w; const float inv = __builtin_amdgcn_rcpf((float)cnt);
        const LAS unsigned char* rp = lds + PA_POOL + (15 + 32 * tbk + c) * PA_PP + (g * 64 + 8 * hh) * 2;
#pragma unroll
        for (int kp = 0; kp < 2; ++kp) {
            float cur[2][8], acc[2][8];
#pragma unroll
            for (int k2 = 0; k2 < 2; ++k2) { unpack8(*(const LAS v4u*)(rp + 32 * (2 * kp + k2)), cur[k2]);
#pragma unroll
                for (int j = 0; j < 8; ++j) acc[k2][j] = cur[k2][j]; }
#pragma unroll 2
            for (int i = 1; i < w; ++i) {
#pragma unroll
                for (int k2 = 0; k2 < 2; ++k2) { float v[8]; unpack8(*(const LAS v4u*)(rp - i * PA_PP + 32 * (2 * kp + k2)), v);
#pragma unroll
                    for (int j = 0; j < 8; ++j) acc[k2][j] += v[j]; }
            }
#pragma unroll
            for (int k2 = 0; k2 < 2; ++k2) { float p[8];
#pragma unroll
                for (int j = 0; j < 8; ++j) p[j] = acc[k2][j] * inv - cur[k2][j];
                Bf[2 * kp + k2] = pack8(p); }
        }
#pragma unroll
        for (int db = 0; db < 2; ++db) {
            f32x16 dacc = {};
#pragma unroll
            for (int ks = 0; ks < 4; ++ks) dacc = __builtin_amdgcn_mfma_f32_32x32x16_bf16(W.Af[db][ks], Bf[ks], dacc, 0, 0, 0);
            bf16* op = MIX + (size_t)(tb + 32 * tbk + c) * D + g * 64 + 32 * db + 4 * hh;
#pragma unroll
            for (int q = 0; q < 4; ++q) { u32x2v o; o.x = cvtpk(dacc[4 * q], dacc[4 * q + 1]); o.y = cvtpk(dacc[4 * q + 2], dacc[4 * q + 3]);
                *(GAS u32x2v*)(op + 8 * q) = o; }
        }
    }
}
__device__ __forceinline__ void gla_kv_task2(const LAS unsigned char* lds, float bg, float* GKV, float* GDEC, int ck, int h, int lane) {
    const int d = lane & 31, hh = lane >> 5; const int b = ck / NCH, n = ck % NCH; const int bhn = (b * 4 + h) * NCH + n;
    const LAS unsigned short* Gp = (const LAS unsigned short*)(lds + PA_GATE) + h * 32 + d;
    const LAS unsigned short* Kp = (const LAS unsigned short*)(lds + PA_GK) + h * 32 + d;
    float bc[4][8], gt[4];
#pragma unroll
    for (int ks = 0; ks < 4; ++ks) { float run = 0.f;
#pragma unroll
        for (int j = 0; j < 8; ++j) { const int t = 16 * ks + 8 * hh + j; run += ls16(bf2f(Gp[t * (PA_GP / 2)]) + bg); bc[ks][j] = run; }
        gt[ks] = run; }
    float base = 0.f, blast;
    {
        float pt[4];
#pragma unroll
        for (int ks = 0; ks < 4; ++ks) pt[ks] = __shfl_xor(gt[ks], 32);
#pragma unroll
        for (int ks = 0; ks < 4; ++ks) { const float lo = hh ? pt[ks] : gt[ks], hi_ = hh ? gt[ks] : pt[ks];
            const float off = base + (hh ? lo : 0.f);
#pragma unroll
            for (int j = 0; j < 8; ++j) bc[ks][j] += off;
            base += lo + hi_; }
        blast = base;
    }
    bf16x8 Af[4];
#pragma unroll
    for (int ks = 0; ks < 4; ++ks) { float v[8];
#pragma unroll
        for (int j = 0; j < 8; ++j) { const int t = 16 * ks + 8 * hh + j; v[j] = bf2f(Kp[t * (PA_GP / 2)]) * ex2(blast - bc[ks][j]); }
        Af[ks] = pack8(v); }
    const LAS unsigned short* Vp = (const LAS unsigned short*)(lds + PA_GV) + h * 64 + d;
#pragma unroll
    for (int nb = 0; nb < 2; ++nb) {
        f32x16 dacc = {};
#pragma unroll
        for (int ks = 0; ks < 4; ++ks) { v4u w;
            unsigned short e[8];
#pragma unroll
            for (int j = 0; j < 8; ++j) e[j] = Vp[(16 * ks + 8 * hh + j) * (PA_PP / 2) + 32 * nb];
            w.x = e[0] | ((unsigned)e[1] << 16); w.y = e[2] | ((unsigned)e[3] << 16); w.z = e[4] | ((unsigned)e[5] << 16); w.w = e[6] | ((unsigned)e[7] << 16);
            dacc = __builtin_amdgcn_mfma_f32_32x32x16_bf16(Af[ks], __builtin_bit_cast(bf16x8, w), dacc, 0, 0, 0); }
        float* op = GKV + ((size_t)bhn * 64 + 32 * nb + d) * 32 + 4 * hh;
#pragma unroll
        for (int q = 0; q < 4; ++q) *(GAS f32x4*)(op + 8 * q) = (f32x4){dacc[4 * q], dacc[4 * q + 1], dacc[4 * q + 2], dacc[4 * q + 3]};
    }
    if (hh == 0) GDEC[(size_t)bhn * 32 + d] = ex2(blast);
}
constexpr int PC_GATE = 0, PC_GQ = 64 * PA_GP, PC_GK = 2 * 64 * PA_GP, PC_GV = 3 * 64 * PA_GP, PC_SCR = PC_GV + 64 * PA_PP, PC_GN = PC_SCR + 4 * 8448, PC_END = PC_GN + 1024;
static_assert(PC_END <= RING_BYTES, "phase C LDS");
constexpr int PC_NPIECE = 3 * 64 * 16 + 64 * 32, PC_NI = PC_NPIECE / 512;
static_assert(PC_NPIECE % 512 == 0, "phase C pieces");
__device__ __forceinline__ void pc_piece(int p, int tb, long& goff, int& loff) {
    if (p < 3 * 64 * 16) { const int reg = p >> 10, q = p & 1023, row = q >> 4, pc = q & 15; loff = reg * 64 * PA_GP + row * PA_GP + pc * 16;
        goff = (long)(tb + row) * NP + (reg == 0 ? C_GG : reg == 1 ? C_GQ : C_GK) + pc * 8; return; }
    p -= 3 * 64 * 16; { const int row = p >> 5, pc = p & 31; loff = PC_GV + row * PA_PP + pc * 16; goff = (long)(tb + row) * NP + C_GV + pc * 8; }
}
struct StageC { v4u r[PC_NI]; };
__device__ __forceinline__ void stageC_load(StageC& S, const bf16* PROJ, int ck, int tid) {
    asm volatile("" : "+v"(tid));
#pragma unroll
    for (int i = 0; i < PC_NI; ++i) { long goff; int loff; pc_piece(tid + 512 * i, ck * CHUNK, goff, loff); S.r[i] = *(const GAS v4u*)(PROJ + goff); }
}
__device__ __forceinline__ void stageC_store(const StageC& S, LAS unsigned char* lds, int ck, int tid) {
    asm volatile("" : "+v"(tid));
#pragma unroll
    for (int i = 0; i < PC_NI; ++i) { long goff; int loff; pc_piece(tid + 512 * i, ck * CHUNK, goff, loff); *(LAS v4u*)(lds + loff) = S.r[i]; }
}
__device__ __forceinline__ void gla_out_task2(LAS unsigned char* lds, const bf16* PROJ, float bg, const float* GKV, bf16* MIX, int ck, int h, int ib, int lane) {
    const int c = lane & 31, hh = lane >> 5; const int tb = ck * CHUNK; const int b = ck / NCH, n = ck % NCH; const int bhn = (b * 4 + h) * NCH + n;
    LAS float* scr = (LAS float*)(lds + PC_SCR + h * 8448);
    const int tok = tb + 32 * ib + c;
    const float* Sp = GKV + (size_t)bhn * 2048;
    f32x4 sv[2][2][2];
#pragma unroll
    for (int eb = 0; eb < 2; ++eb)
#pragma unroll
        for (int ks = 0; ks < 2; ++ks) { const float* sp = Sp + (size_t)(32 * eb + c) * 32 + 16 * ks + 8 * hh; sv[eb][ks][0] = *(const GAS f32x4*)sp; sv[eb][ks][1] = *(const GAS f32x4*)(sp + 4); }
    const bf16* rp = PROJ + (size_t)tok * NP + C_GR + h * 64 + 4 * hh;
    u32x2v rw[2][4];
#pragma unroll
    for (int eb = 0; eb < 2; ++eb)
#pragma unroll
        for (int q = 0; q < 4; ++q) rw[eb][q] = *(const GAS u32x2v*)(rp + 32 * eb + 8 * q);
    {
        const LAS unsigned short* Gp = (const LAS unsigned short*)(lds + PC_GATE) + (32 * hh) * (PA_GP / 2) + h * 32 + c;
        float bc[32]; float run = 0.f;
#pragma unroll
        for (int i = 0; i < 32; ++i) { run += ls16(bf2f(Gp[i * (PA_GP / 2)]) + bg); bc[i] = run; }
        const float tot0 = __shfl(run, c);
        const float off = hh ? tot0 : 0.f;
#pragma unroll
        for (int i = 0; i < 32; ++i) scr[(32 * hh + i) * 33 + c] = bc[i] + off;
        LDS_WAIT(); asm volatile("" ::: "memory");
    }
    bf16x8 Qf[2], Kf[2][2];
    const float qs = 0.17677669529663687f;
#pragma unroll
    for (int ks = 0; ks < 2; ++ks) { const int i = 32 * ib + c, d0 = 16 * ks + 8 * hh; float q[8], qd[8];
        unpack8(*(const LAS v4u*)(lds + PC_GQ + i * PA_GP + (h * 32 + d0) * 2), q);
#pragma unroll
        for (int j = 0; j < 8; ++j) qd[j] = q[j] * qs * ex2(scr[i * 33 + d0 + j]);
        Qf[ks] = pack8(qd); }
#pragma unroll
    for (int jb = 0; jb < 2; ++jb)
#pragma unroll
        for (int ks = 0; ks < 2; ++ks) { const int i = 32 * jb + c, d0 = 16 * ks + 8 * hh; float k[8], ki[8];
            if (jb <= ib) {
                unpack8(*(const LAS v4u*)(lds + PC_GK + i * PA_GP + (h * 32 + d0) * 2), k);
#pragma unroll
                for (int j = 0; j < 8; ++j) ki[j] = k[j] * ex2(-scr[i * 33 + d0 + j]);
                Kf[jb][ks] = pack8(ki); } }
    const LAS unsigned short* Vp = (const LAS unsigned short*)(lds + PC_GV) + h * 64;
    const LAS float* gn = (const LAS float*)(lds + PC_GN) + h * 64;
    f32x16 o[2]; o[0] = f32x16{}; o[1] = f32x16{};
    for (int jb = 0; jb <= ib; ++jb) {
        f32x16 at = {};
#pragma unroll
        for (int ks = 0; ks < 2; ++ks) at = __builtin_amdgcn_mfma_f32_32x32x16_bf16(jb == 0 ? Kf[0][ks] : Kf[1][ks], Qf[ks], at, 0, 0, 0);
        if (jb == ib) {
#pragma unroll
            for (int r = 0; r < 16; ++r) if (crow(r, hh) > c) at[r] = 0.f;
        }
#pragma unroll
        for (int s = 0; s < 2; ++s) {
            float pv_[8];
#pragma unroll
            for (int jj = 0; jj < 8; ++jj) pv_[jj] = at[8 * s + jj];
            const bf16x8 Pf = pack8(pv_);
#pragma unroll
            for (int eb = 0; eb < 2; ++eb) { unsigned short e[8];
#pragma unroll
                for (int jj = 0; jj < 8; ++jj) { const int j = 32 * jb + 16 * s + 8 * (jj >> 2) + 4 * hh + (jj & 3); e[jj] = Vp[j * (PA_PP / 2) + 32 * eb + c]; }
                v4u w; w.x = e[0] | ((unsigned)e[1] << 16); w.y = e[2] | ((unsigned)e[3] << 16); w.z = e[4] | ((unsigned)e[5] << 16); w.w = e[6] | ((unsigned)e[7] << 16);
                o[eb] = __builtin_amdgcn_mfma_f32_32x32x16_bf16(__builtin_bit_cast(bf16x8, w), Pf, o[eb], 0, 0, 0); }
        }
    }
#pragma unroll
    for (int eb = 0; eb < 2; ++eb)
#pragma unroll
        for (int ks = 0; ks < 2; ++ks) { const f32x4 s0 = sv[eb][ks][0], s1 = sv[eb][ks][1];
            const float svv[8] = {s0[0], s0[1], s0[2], s0[3], s1[0], s1[1], s1[2], s1[3]};
            o[eb] = __builtin_amdgcn_mfma_f32_32x32x16_bf16(pack8(svv), Qf[ks], o[eb], 0, 0, 0); }
    float ssq = 0.f;
#pragma unroll
    for (int eb = 0; eb < 2; ++eb)
#pragma unroll
        for (int r = 0; r < 16; ++r) ssq += o[eb][r] * o[eb][r];
    ssq += __shfl_xor(ssq, 32);
    const float rstd = __builtin_amdgcn_rsqf(ssq * (1.0f / 64.0f) + EPS);
    bf16* op = MIX + (size_t)tok * D + 768 + h * 64 + 4 * hh;
#pragma unroll
    for (int eb = 0; eb < 2; ++eb)
#pragma unroll
        for (int q = 0; q < 4; ++q) { const int e0 = 32 * eb + 8 * q;
            const u32x2v rww = rw[eb][q]; const f32x4 g4 = *(const LAS f32x4*)(gn + e0 + 4 * hh);
            const float rg[4] = {__uint_as_float(rww.x << 16), __uint_as_float(rww.x & 0xffff0000u), __uint_as_float(rww.y << 16), __uint_as_float(rww.y & 0xffff0000u)};
            float y[4];
#pragma unroll
            for (int k = 0; k < 4; ++k) { const float sil = rg[k] * __builtin_amdgcn_rcpf(1.f + ex2(-1.4426950408889634f * rg[k])); y[k] = o[eb][4 * q + k] * rstd * g4[k] * sil; }
            u32x2v ow; ow.x = cvtpk(y[0], y[1]); ow.y = cvtpk(y[2], y[3]); *(GAS u32x2v*)(op + e0) = ow; }
    LDS_WAIT(); asm volatile("" ::: "memory");
}
template <int R> __device__ __forceinline__ void diff_fin_rows(const bf16* OATT, const float* dng, bf16* MIX, int tok0, int tstride, float lam, float oml, int lane) {
    const int hd = lane >> 4, e0 = (lane & 15) * 8;
    v4u w1[R], w2[R];
#pragma unroll
    for (int r = 0; r < R; ++r) { const size_t o = (size_t)(tok0 + r * tstride) * D + hd * 256 + e0; w1[r] = *(const GAS v4u*)(OATT + o); w2[r] = *(const GAS v4u*)(OATT + o + 128); }
    const f32x4 g0 = *(const f32x4*)(dng + hd * 128 + e0), g1 = *(const f32x4*)(dng + hd * 128 + e0 + 4);
#pragma unroll
    for (int r = 0; r < R; ++r) { float a1[8], a2[8], a[8]; unpack8(w1[r], a1); unpack8(w2[r], a2);
        float ss = 0.f;
#pragma unroll
        for (int j = 0; j < 8; ++j) { a[j] = a1[j] - lam * a2[j]; ss += a[j] * a[j]; }
        ss += __shfl_xor(ss, 1); ss += __shfl_xor(ss, 2); ss += __shfl_xor(ss, 4); ss += __shfl_xor(ss, 8);
        const float rstd = __builtin_amdgcn_rsqf(ss * (1.0f / 128.0f) + EPS) * oml;
        float y[8];
#pragma unroll
        for (int j = 0; j < 4; ++j) { y[j] = a[j] * rstd * g0[j]; y[4 + j] = a[4 + j] * rstd * g1[j]; }
        *(GAS bf16x8*)(MIX + (size_t)(tok0 + r * tstride) * D + 256 + hd * 128 + e0) = pack8(y); }
}
template <int R> __device__ __forceinline__ void final_norm_rows(const bf16* hb, float* out, const float* g, int row0, int rstride, int lane) {
    v4u w[R][2];
#pragma unroll
    for (int r = 0; r < R; ++r)
#pragma unroll
        for (int j = 0; j < 2; ++j) w[r][j] = *(const GAS v4u*)(hb + (size_t)(row0 + r * rstride) * D + j * 512 + lane * 8);
    f32x4 g4[2][2];
#pragma unroll
    for (int j = 0; j < 2; ++j) { g4[j][0] = *(const f32x4*)(g + j * 512 + lane * 8); g4[j][1] = *(const f32x4*)(g + j * 512 + lane * 8 + 4); }
#pragma unroll
    for (int r = 0; r < R; ++r) { float v[2][8]; float s2 = 0.f;
#pragma unroll
        for (int j = 0; j < 2; ++j) { unpack8(w[r][j], v[j]);
#pragma unroll
            for (int e = 0; e < 8; ++e) s2 += v[j][e] * v[j][e]; }
        const float rstd = __builtin_amdgcn_rsqf(wave_sum(s2) * (1.0f / D) + EPS);
        float* op = out + (size_t)(row0 + r * rstride) * D + lane * 8;
#pragma unroll
        for (int j = 0; j < 2; ++j) { f32x4 o0, o1;
#pragma unroll
            for (int e = 0; e < 4; ++e) { o0[e] = v[j][e] * rstd * g4[j][0][e]; o1[e] = v[j][4 + e] * rstd * g4[j][1][e]; }
            *(GAS f32x4*)(op + j * 512) = o0; *(GAS f32x4*)(op + j * 512 + 4) = o1; } }
}

template <class Sched> __device__ __forceinline__ void rs_table(LAS float* rst, const float* ss, const Sched& S, int tid) {
    asm volatile("" : "+v"(tid));
    const int row = tid >> 1, half = tid & 1;
    pg8::Unit u;
    for (int i = 0; i < RST_MAXU && S.next(i, u); ++i) {
        const f32x4 a = *(const GAS f32x4*)(ss + ((size_t)u.pm * 256 + row) * 16 + half * 8), b = *(const GAS f32x4*)(ss + ((size_t)u.pm * 256 + row) * 16 + half * 8 + 4);
        float s_ = ((a[0] + a[1]) + (a[2] + a[3])) + ((b[0] + b[1]) + (b[2] + b[3]));
        s_ += __shfl_xor(s_, 1);
        if (half == 0) rst[i * 256 + row] = __builtin_amdgcn_rsqf(s_ * (1.0f / 1024.0f) + EPS);
    }
    __syncthreads();
}
constexpr int PH_PER_LAYER = 7, N_PHASES = 1 + DEPTH * PH_PER_LAYER + 1;
struct Args { const float* in[18]; float* out; unsigned char* ws; int ph_lo, ph_hi; };
__global__ void __launch_bounds__(NWAVES * 64, 2) fwd_kernel(Args args) {
    extern __shared__ __attribute__((aligned(16))) unsigned char lds[];
    Frame F;
    F.lds = (LAS unsigned char*)lds;
    F.MISC = (volatile LAS unsigned*)(F.lds + MISC_OFF);
    F.tid = threadIdx.x; F.lane = F.tid & 63; F.wave = __builtin_amdgcn_readfirstlane(F.tid >> 6);
    F.G = gridDim.x; { const int bx = blockIdx.x; F.vcu = (F.G % 8 == 0) ? (bx % 8) * (F.G / 8) + bx / 8 : bx; }
    unsigned char* ws = args.ws;
    F.ctl = (gu32*)(ws + WS_CTL);
    Inputs I;
    I.x = args.in[0]; I.norm1_g = args.in[1]; I.w_in = args.in[2]; I.pool_w = args.in[3]; I.pool_scale = args.in[4]; I.lq1 = args.in[5]; I.lk1 = args.in[6]; I.lq2 = args.in[7]; I.lk2 = args.in[8];
    I.diff_norm_g = args.in[9]; I.w_gate2 = args.in[10]; I.b_gate = args.in[11]; I.gla_norm_g = args.in[12]; I.w_out = args.in[13]; I.norm2_g = args.in[14]; I.w_mlp1 = args.in[15]; I.w_mlp2 = args.in[16]; I.final_g = args.in[17];
    for (int u = F.tid; u < (LDS_BYTES - LDSCTL_OFF) / 4; u += NWAVES * 64) ((LAS unsigned*)(F.lds + LDSCTL_OFF))[u] = 0u;
    __syncthreads();
    XcdBarrier bar; bar.bar = (unsigned*)(F.ctl + CW_BAR); bar.x = 0; bar.st = nullptr;
    if (!MK_PER_PHASE) bar = xcd_barrier_post((unsigned*)(F.ctl + CW_BAR), F.MISC + 8);
#define GRID_BAR() do { if (!MK_PER_PHASE) xcd_barrier(bar); } while (0)
    const int lo = args.ph_lo, hi = args.ph_hi;
#define IN(k) (lo <= (k) && (k) < hi)
#define BOTH(k) (IN(k) && IN((k) + 1))
    bf16* const HB = (bf16*)(ws + WS_HB); bf16* const PROJ = (bf16*)(ws + WS_PROJ); bf16* const OATT = (bf16*)(ws + WS_OATT); bf16* const MIX = (bf16*)(ws + WS_MIX); bf16* const HID = (bf16*)(ws + WS_HID);
    float* const SSA = (float*)(ws + WS_SSA); float* const SSB = (float*)(ws + WS_SSB); float* const GKV = (float*)(ws + WS_GKV); float* const GDEC = (float*)(ws + WS_GDEC);
#define REFRESH() do { int t_ = threadIdx.x; asm volatile("" : "+v"(t_)); F.tid = t_; F.lane = t_ & 63; F.wave = __builtin_amdgcn_readfirstlane(t_ >> 6); } while (0)
    const int NGW = F.G * NWAVES;

    if (IN(0)) { p0_prologue(F, I, ws); if (BOTH(0)) GRID_BAR(); }

#pragma unroll 1
    for (int l = 0; l < DEPTH; ++l) {
        const int pb = 1 + l * PH_PER_LAYER;
        unsigned char* wl = ws + WS_W + (size_t)l * W_LAYER;
        const float lambda_init = (l == 0) ? 0.2f : 0.35550906759096927f;
        if (IN(pb + 0)) {
            pg8::Gemm g{HB, (const bf16*)(wl + WO_IN), M, NP, D}; pg8::StaticOrder S; S.init(M, NP, F.G, (int)blockIdx.x);
            rs_table((LAS float*)(F.lds + RST_OFF), SSB, S, threadIdx.x);
            pg8::EpiRs<0> E{PROJ, NP, (const LAS float*)(F.lds + RST_OFF), 1, 3, attn2::C2};
            pg8::gemm_phase<pg8::EpiRs<0>, pg8::StaticOrder, true, true>(F.lds + RING_OFF, g, S, E);
            if (BOTH(pb + 0)) GRID_BAR();
        }
        if (IN(pb + 1)) {
            REFRESH();
            {
                StageA SA; int ck = F.vcu;
                const float bgA = I.b_gate[l * 128 + (F.wave & 3) * 32 + (F.lane & 31)];
                PoolW PW; pool_w_load(PW, (const bf16*)(ws + WS_WPOOL) + (size_t)l * 4 * 4096, (F.wave < 2) ? 3 : (F.wave == 2) ? 2 : (F.wave == 3) ? 1 : 0, F.lane);
                stageA_load(SA, PROJ, ck, F.tid);
                for (; ck < M / CHUNK; ck += F.G) {
                    stageA_store(SA, F.lds + RING_OFF, ck, F.tid);
                    __syncthreads();
                    stageA_load(SA, PROJ, (ck + F.G < M / CHUNK) ? ck + F.G : ck, F.tid);
                    if (F.wave < 2) pool_task2(F.lds + RING_OFF, PW, MIX, ck, 3, F.wave, F.wave + 1, F.lane);
                    else if (F.wave == 2) pool_task2(F.lds + RING_OFF, PW, MIX, ck, 2, 0, 2, F.lane);
                    else if (F.wave == 3) pool_task2(F.lds + RING_OFF, PW, MIX, ck, 1, 0, 2, F.lane);
                    else { gla_kv_task2(F.lds + RING_OFF, bgA, GKV, GDEC, ck, F.wave - 4, F.lane);
                           if (F.wave < 6) pool_task2(F.lds + RING_OFF, PW, MIX, ck, 0, F.wave - 4, F.wave - 3, F.lane); }
                    __syncthreads();
                }
            }
            if (BOTH(pb + 1)) GRID_BAR();
        }
        if (IN(pb + 2)) {
            REFRESH();
            if (F.tid < 256) gla_scan(GKV, GDEC, F.vcu * 256 + F.tid, F.G * 256);
            __syncthreads();
            attn2::attn_phase3((char*)lds + RING_OFF, (const attn2::bf16*)PROJ, (attn2::bf16*)OATT, F.vcu, C_DQ, C_DK, C_DV);
            if (BOTH(pb + 2)) GRID_BAR();
        }
        if (IN(pb + 3)) {
            REFRESH(); const int gw = F.vcu * NWAVES + F.wave;
            {
                const float bgC = I.b_gate[l * 128 + (F.wave & 3) * 32 + (F.lane & 31)];
                if (F.tid < 256) ((LAS float*)(F.lds + RING_OFF + PC_GN))[F.tid] = I.gla_norm_g[l * 256 + F.tid];
                { StageC SC; int ck = F.vcu;
                  stageC_load(SC, PROJ, ck, F.tid);
                  for (; ck < M / CHUNK; ck += F.G) {
                      stageC_store(SC, F.lds + RING_OFF, ck, F.tid);
                      __syncthreads();
                      stageC_load(SC, PROJ, (ck + F.G < M / CHUNK) ? ck + F.G : ck, F.tid);
                      gla_out_task2(F.lds + RING_OFF, PROJ, bgC, GKV, MIX, ck, F.wave & 3, F.wave >> 2, F.lane);
                      __syncthreads();
                  } }
                const float s1 = wave_sum(I.lq1[l * 64 + F.lane] * I.lk1[l * 64 + F.lane]), s2 = wave_sum(I.lq2[l * 64 + F.lane] * I.lk2[l * 64 + F.lane]);
                const float lam = __expf(s1) - __expf(s2) + lambda_init;
                int tok = gw;
                for (; tok + 3 * NGW < M; tok += 4 * NGW) diff_fin_rows<4>(OATT, I.diff_norm_g + l * 512, MIX, tok, NGW, lam, 1.0f - lambda_init, F.lane);
                for (; tok < M; tok += NGW) diff_fin_rows<1>(OATT, I.diff_norm_g + l * 512, MIX, tok, NGW, lam, 1.0f - lambda_init, F.lane);
            }
            if (BOTH(pb + 3)) GRID_BAR();
        }
        if (IN(pb + 4)) {
            pg8::Gemm g{MIX, (const bf16*)(wl + WO_OUT), M, D, D}; pg8::StaticOrder S; S.init(M, D, F.G, (int)blockIdx.x);
            pg8::EpiRes E{HB, SSA, D};
            pg8::gemm_phase<pg8::EpiRes, pg8::StaticOrder, true, true>(F.lds + RING_OFF, g, S, E);
            if (BOTH(pb + 4)) GRID_BAR();
        }
        if (IN(pb + 5)) {
            pg8::Gemm g{HB, (const bf16*)(wl + WO_1), M, FF, D}; pg8::StaticOrder S; S.init(M, FF, F.G, (int)blockIdx.x);
            rs_table((LAS float*)(F.lds + RST_OFF), SSA, S, threadIdx.x);
            pg8::EpiRs<2> E{HID, FF, (const LAS float*)(F.lds + RST_OFF), 0, 0, 1.f};
            pg8::gemm_phase<pg8::EpiRs<2>, pg8::StaticOrder, true, true>(F.lds + RING_OFF, g, S, E);
            if (BOTH(pb + 5)) GRID_BAR();
        }
        if (IN(pb + 6)) {
            pg8::Gemm g{HID, (const bf16*)(wl + WO_2), M, D, FF}; pg8::StaticOrder S; S.init(M, D, F.G, (int)blockIdx.x);
            pg8::EpiRes E{HB, SSB, D};
            pg8::gemm_phase<pg8::EpiRes, pg8::StaticOrder, true, true>(F.lds + RING_OFF, g, S, E);
            if (BOTH(pb + 6)) GRID_BAR();
        }
    }
    if (IN(N_PHASES - 1)) { REFRESH(); const int gw = F.vcu * NWAVES + F.wave; int m = gw; for (; m + 3 * NGW < M; m += 4 * NGW) final_norm_rows<4>(HB, args.out, I.final_g, m, NGW, F.lane);
        for (; m < M; m += NGW) final_norm_rows<1>(HB, args.out, I.final_g, m, NGW, F.lane); }
#undef IN
#undef BOTH
#undef GRID_BAR
#undef REFRESH
}

extern "C" void kernel_launch(void* const* d_in, const int* in_sizes, int n_in, void* d_out, int out_size, void* d_ws, size_t ws_size, hipStream_t stream) {
    static int grid = 0;
    if (grid == 0) {
        if (n_in != 18 || in_sizes[0] != M * D || out_size != M * D || ws_size < WS_END) { fprintf(stderr, "kernel_launch: unexpected shapes: n_in %d, in0 %d, out %d, ws %zu (need %zu); nothing launched\n", n_in, n_in > 0 ? in_sizes[0] : -1, out_size, ws_size, (size_t)WS_END); grid = -1; return; }
        int dev = 0, cus = 0, per_cu = 0;
        if (hipGetDevice(&dev) != hipSuccess || hipDeviceGetAttribute(&cus, hipDeviceAttributeMultiprocessorCount, dev) != hipSuccess) { grid = -1; return; }
        if (hipFuncSetAttribute((const void*)fwd_kernel, hipFuncAttributeMaxDynamicSharedMemorySize, LDS_BYTES) != hipSuccess) { fprintf(stderr, "kernel_launch: hipFuncSetAttribute failed\n"); grid = -1; return; }
        if (hipOccupancyMaxActiveBlocksPerMultiprocessor(&per_cu, (const void*)fwd_kernel, NWAVES * 64, LDS_BYTES) != hipSuccess || per_cu < 1) { fprintf(stderr, "kernel_launch: occupancy query reports %d workgroups per CU\n", per_cu); }
        (void)hipGetLastError();
        grid = cus;
    }
    if (grid < 0) return;
    if (hipMemsetAsync((char*)d_ws + WS_CTL, 0, CTL_ZERO_BYTES, stream) != hipSuccess) return;
    Args a{};
    for (int i = 0; i < 18; ++i) a.in[i] = (const float*)d_in[i];
    a.out = (float*)d_out; a.ws = (unsigned char*)d_ws;
#if MK_PER_PHASE
    for (int p = 0; p < N_PHASES; ++p) { a.ph_lo = p; a.ph_hi = p + 1; hipLaunchKernelGGL(fwd_kernel, dim3(grid), dim3(NWAVES * 64), LDS_BYTES, stream, a); }
#else
    a.ph_lo = 0; a.ph_hi = N_PHASES;
    hipLaunchKernelGGL(fwd_kernel, dim3(grid), dim3(NWAVES * 64), LDS_BYTES, stream, a);
#endif
}
```

```cpp
#include <hip/hip_runtime.h>
#include <cstdio>
#include <cstdint>
namespace pg8 {
#define PG8_LAS __attribute__((address_space(3)))
typedef unsigned short bf16_t;
typedef short bf16x8 __attribute__((ext_vector_type(8)));
typedef float f32x4 __attribute__((ext_vector_type(4)));
typedef unsigned u32x4 __attribute__((ext_vector_type(4)));
constexpr int BM = 256, BK = 64, HALF = 128, HTB = HALF * BK * 2  , STAGE_BYTES = 8 * HTB, NXCD = 8, WGM = 8;

__host__ __device__ __forceinline__ int lds_byte(int r, int c) { const int st = (r >> 4) * 2 + (c >> 5), rr = r & 15, cc = c & 31, ob = rr * 64 + cc * 2; return st * 1024 + (ob ^ (((ob >> 9) & 1) << 5)); }
__host__ __device__ __forceinline__ void stage_rc(int b, int& R, int& C) { const int st = b / 1024, sb = b % 1024, swz = sb ^ (((sb >> 9) & 1) << 5); R = (st >> 1) * 16 + swz / 64; C = (st & 1) * 32 + (swz % 64) / 2; }
__host__ __device__ __forceinline__ int perm32(int rho) { const int n = rho >> 4, i = rho & 15; return 8 * (i >> 2) + 4 * n + (i & 3); }

struct Unit { int pm, pn; };
struct Gemm { const bf16_t* A; const bf16_t* Bt; int M, N, K; };

struct StaticOrder {
    int nM, nN, nwg, G, c;
    __host__ __device__ void init(int M, int N, int G_, int c_) { nM = M / BM; nN = N / BM; nwg = nM * nN; G = G_; c = c_; }
    __host__ __device__ bool next(int i, Unit& u) const {
        const long L = (long)i * G + c; if (L >= nwg) return false;
        int wgid = (int)L; { const int q = nwg / NXCD, r = nwg % NXCD, xcd = wgid % NXCD, off = wgid / NXCD; wgid = (xcd < r ? xcd * (q + 1) : r * (q + 1) + (xcd - r) * q) + off; }
        const int nig = WGM * nN, gid = wgid / nig, fm = gid * WGM, gsz = (nM - fm) < WGM ? (nM - fm) : WGM;
        u.pm = fm + ((wgid % nig) % gsz); u.pn = (wgid % nig) / gsz; return true;
    }
    __device__ __forceinline__ void a_ready(const Unit&) const {}
    __device__ __forceinline__ void done(const Unit&) const {}
};

__device__ __forceinline__ unsigned cvt_pk_bf16(float lo, float hi) { unsigned r; asm volatile("v_cvt_pk_bf16_f32 %0, %1, %2" : "=v"(r) : "v"(lo), "v"(hi)); return r; }
typedef float f32x2 __attribute__((ext_vector_type(2)));
typedef float f32x2 __attribute__((ext_vector_type(2)));
typedef unsigned u32x2 __attribute__((ext_vector_type(2)));
__device__ __forceinline__ float row_rs(const float* ss, int row, int fq, float eps) {
    const f32x4 p = *(const f32x4*)(ss + (size_t)row * 16 + fq * 4);
    float s = (p[0] + p[1]) + (p[2] + p[3]);
    s += __shfl_xor(s, 16); s += __shfl_xor(s, 32);
    return __builtin_amdgcn_rsqf(s * (1.0f / 1024.0f) + eps);
}
template <int ACT> struct EpiRs {
    static constexpr bool PERM = true, AFTER_DRAIN = false;
    bf16_t* O; int ldc; const PG8_LAS float* rst; int sc_lo, sc_hi; float tile_scale;
    __device__ __forceinline__ void operator()(const f32x4 (&acc)[2][2][4][2], const Unit& u, int ui, int wr, int wc, int fr, int fq) const {
        const int row0 = u.pm * BM + wr * 64 + fr; const int col0 = u.pn * BM + wc * 32 + 8 * fq;
        const float sc = (u.pn >= sc_lo && u.pn < sc_hi) ? tile_scale : 1.f;
        float rs[2][4];
#pragma unroll
        for (int ai = 0; ai < 2; ++ai)
#pragma unroll
            for (int m = 0; m < 4; ++m) rs[ai][m] = rst[ui * BM + wr * 64 + fr + ai * HALF + m * 16] * sc;
#pragma unroll
        for (int ai = 0; ai < 2; ++ai)
#pragma unroll
            for (int m = 0; m < 4; ++m) { bf16_t* rowp = O + (size_t)(row0 + ai * HALF + m * 16) * ldc + col0; const float r = rs[ai][m];
#pragma unroll
                for (int bj = 0; bj < 2; ++bj) { f32x4 v0 = acc[ai][bj][m][0] * r, v1 = acc[ai][bj][m][1] * r;
                    if (ACT == 2) {
#pragma unroll
                        for (int e = 0; e < 4; ++e) { const float a = __builtin_fmaxf(v0[e], 0.f), b = __builtin_fmaxf(v1[e], 0.f); v0[e] = a * a; v1[e] = b * b; } }
                    u32x4 w; w.x = cvt_pk_bf16(v0[0], v0[1]); w.y = cvt_pk_bf16(v0[2], v0[3]); w.z = cvt_pk_bf16(v1[0], v1[1]); w.w = cvt_pk_bf16(v1[2], v1[3]);
                    __builtin_nontemporal_store(w, (u32x4*)(rowp + bj * HALF)); } }
    }
};
struct EpiRes {
    static constexpr bool PERM = true, AFTER_DRAIN = false;
    bf16_t* hb; float* ss; int ldc;
    __device__ __forceinline__ void operator()(const f32x4 (&acc)[2][2][4][2], const Unit& u, int ui, int wr, int wc, int fr, int fq) const {
        const int row0 = u.pm * BM + wr * 64 + fr; const int col0 = u.pn * BM + wc * 32 + 8 * fq;
        u32x4 b[2][4][2];
#pragma unroll
        for (int ai = 0; ai < 2; ++ai)
#pragma unroll
            for (int m = 0; m < 4; ++m)
#pragma unroll
                for (int bj = 0; bj < 2; ++bj) b[ai][m][bj] = *(const u32x4*)(hb + (size_t)(row0 + ai * HALF + m * 16) * ldc + col0 + bj * HALF);
#pragma unroll
        for (int ai = 0; ai < 2; ++ai)
#pragma unroll
            for (int m = 0; m < 4; ++m) { const int row = row0 + ai * HALF + m * 16; bf16_t* rowp = hb + (size_t)row * ldc + col0; float sq = 0.f;
#pragma unroll
                for (int bj = 0; bj < 2; ++bj) { const u32x4 bb = b[ai][m][bj];
                    f32x4 o0, o1;
                    o0[0] = __uint_as_float(bb.x << 16) + acc[ai][bj][m][0][0]; o0[1] = __uint_as_float(bb.x & 0xffff0000u) + acc[ai][bj][m][0][1];
                    o0[2] = __uint_as_float(bb.y << 16) + acc[ai][bj][m][0][2]; o0[3] = __uint_as_float(bb.y & 0xffff0000u) + acc[ai][bj][m][0][3];
                    o1[0] = __uint_as_float(bb.z << 16) + acc[ai][bj][m][1][0]; o1[1] = __uint_as_float(bb.z & 0xffff0000u) + acc[ai][bj][m][1][1];
                    o1[2] = __uint_as_float(bb.w << 16) + acc[ai][bj][m][1][2]; o1[3] = __uint_as_float(bb.w & 0xffff0000u) + acc[ai][bj][m][1][3];
                    u32x4 w; w.x = cvt_pk_bf16(o0[0], o0[1]); w.y = cvt_pk_bf16(o0[2], o0[3]); w.z = cvt_pk_bf16(o1[0], o1[1]); w.w = cvt_pk_bf16(o1[2], o1[3]);
                    *(u32x4*)(rowp + bj * HALF) = w;
                    sq += ((o0[0] * o0[0] + o0[1] * o0[1]) + (o0[2] * o0[2] + o0[3] * o0[3])) + ((o1[0] * o1[0] + o1[1] * o1[1]) + (o1[2] * o1[2] + o1[3] * o1[3])); }
                sq += __shfl_xor(sq, 16); sq += __shfl_xor(sq, 32);
                if (fq == 0) ss[(size_t)row * 16 + u.pn * 4 + wc] = sq; }
    }
};
template <class Epi, class Sched, bool ALIGN_EPI = false, bool SP2 = false>
__device__ __forceinline__ void gemm_phase(PG8_LAS unsigned char* lds, const Gemm g, const Sched& S, const Epi& E) {
    int tid_ = threadIdx.x; asm volatile("" : "+v"(tid_));
    const int tid = tid_, wid = __builtin_amdgcn_readfirstlane(tid >> 6), lane = tid & 63, wr = wid >> 2, wc = wid & 3, fr = lane & 15, fq = lane >> 4;
    const int K = g.K, nt = K / BK;
    unsigned voffA[2], voffB[2];
#pragma unroll
    for (int i = 0; i < 2; ++i) { int R, C; stage_rc(tid * 16 + i * 8192, R, C); const int Rb = Epi::PERM ? ((R & ~31) + perm32(R & 31)) : R;
        voffA[i] = (unsigned)(R * K + C) * 2u; voffB[i] = (unsigned)(Rb * K + C) * 2u; }
    const size_t kstep = (size_t)(BK * 2);
    const size_t hstep = (size_t)HALF * K * 2;
    const size_t tstep = 2 * hstep;
    const unsigned ldsw = (unsigned)wid * 1024u;
    const int aoff = lds_byte(wr * 64 + fr, fq * 8), boff = lds_byte(wc * 32 + fr, fq * 8);
#define PG8_SA(b, h) (((b) * 2 + (h)) * HTB)
#define PG8_SB(b, h) ((4 + (b) * 2 + (h)) * HTB)
#define PG8_STAGE(bufoff, gbase, voff) do { _Pragma("unroll") for (int _i = 0; _i < 2; ++_i) \
        __builtin_amdgcn_global_load_lds((const unsigned*)((const char*)(gbase) + (voff)[_i]), (PG8_LAS unsigned*)(lds + (bufoff) + ldsw + _i * 8192), 16, 0, 0); } while (0)
#define PG8_LDA(dst, b, h) do { _Pragma("unroll") for (int m = 0; m < 4; ++m) _Pragma("unroll") for (int k = 0; k < 2; ++k) dst[m][k] = *(const PG8_LAS bf16x8*)(lds + PG8_SA(b, h) + aoff + m * 2048 + k * 1024); } while (0)
#define PG8_LDB(dst, b, h) do { _Pragma("unroll") for (int n = 0; n < 2; ++n) _Pragma("unroll") for (int k = 0; k < 2; ++k) dst[n][k] = *(const PG8_LAS bf16x8*)(lds + PG8_SB(b, h) + boff + n * 2048 + k * 1024); } while (0)
#define PG8_MMA(ai, bj, At, Bt) do { __builtin_amdgcn_s_setprio(1); _Pragma("unroll") for (int m = 0; m < 4; ++m) _Pragma("unroll") for (int n = 0; n < 2; ++n) _Pragma("unroll") for (int k = 0; k < 2; ++k) \
        acc[ai][bj][m][n] = __builtin_amdgcn_mfma_f32_16x16x32_bf16(Bt[n][k], At[m][k], acc[ai][bj][m][n], 0, 0, 0); __builtin_amdgcn_s_setprio(0); } while (0)
#define PG8_WAIT_V(n) asm volatile("s_waitcnt vmcnt(" #n ")" ::: "memory")
#define PG8_WAIT_L(n) asm volatile("s_waitcnt lgkmcnt(" #n ")" ::: "memory")
#define PG8_BAR __builtin_amdgcn_s_barrier()
#define PG8_SCHED __builtin_amdgcn_sched_barrier(0)
    Unit cur, nxt; int ui = 0;
    if (!S.next(0, cur)) return;
    f32x4 acc[2][2][4][2];
#pragma unroll
    for (int a = 0; a < 2; ++a)
#pragma unroll
        for (int b = 0; b < 2; ++b)
#pragma unroll
            for (int m = 0; m < 4; ++m)
#pragma unroll
                for (int n = 0; n < 2; ++n) acc[a][b][m][n] = (f32x4){0.f, 0.f, 0.f, 0.f};
    bf16x8 At[4][2], B0[2][2], B1[2][2];
    const char* cA = (const char*)g.A + (size_t)cur.pm * tstep; const char* cB = (const char*)g.Bt + (size_t)cur.pn * tstep;
    S.a_ready(cur);
    if constexpr (SP2) {
        PG8_STAGE(PG8_SB(0, 0), cB, voffB); PG8_STAGE(PG8_SB(0, 1), cB + hstep, voffB); PG8_STAGE(PG8_SA(0, 0), cA, voffA); PG8_STAGE(PG8_SA(0, 1), cA + hstep, voffA);
        if (wr == 1) PG8_BAR;
        PG8_WAIT_V(2); PG8_BAR;
        PG8_STAGE(PG8_SB(1, 0), cB + kstep, voffB); PG8_STAGE(PG8_SA(1, 0), cA + kstep, voffA); PG8_STAGE(PG8_SB(1, 1), cB + hstep + kstep, voffB);
        PG8_WAIT_V(6); PG8_BAR;
    } else {
        PG8_STAGE(PG8_SB(0, 0), cB, voffB); PG8_STAGE(PG8_SA(0, 0), cA, voffA); PG8_STAGE(PG8_SB(0, 1), cB + hstep, voffB); PG8_STAGE(PG8_SA(0, 1), cA + hstep, voffA);
        if (wr == 1) PG8_BAR;
        PG8_WAIT_V(4); PG8_BAR;
        PG8_STAGE(PG8_SB(1, 0), cB + kstep, voffB); PG8_STAGE(PG8_SA(1, 0), cA + kstep, voffA); PG8_STAGE(PG8_SB(1, 1), cB + hstep + kstep, voffB);
        PG8_WAIT_V(6); PG8_BAR;
    }
    for (;;) {
        const bool has_next = S.next(ui + 1, nxt);
        const char* nA = has_next ? (const char*)g.A + (size_t)nxt.pm * tstep : cA; const char* nB = has_next ? (const char*)g.Bt + (size_t)nxt.pn * tstep : cB;
        for (int t = 0; t < nt; t += 2) {
            const bool last = (t == nt - 2);
            const char* a1 = cA + (size_t)(t + 1) * kstep;
            const char* a2 = last ? nA : cA + (size_t)(t + 2) * kstep; const char* b2 = last ? nB : cB + (size_t)(t + 2) * kstep;
            const char* a3 = a2 + kstep; const char* b3 = b2 + kstep;
            if (last && has_next) S.a_ready(nxt);
            if constexpr (SP2) {
            PG8_LDB(B0, 0, 0); PG8_LDB(B1, 0, 1); PG8_SCHED; PG8_LDA(At, 0, 0); PG8_STAGE(PG8_SA(1, 1), a1 + hstep, voffA);
            PG8_WAIT_V(8); PG8_WAIT_L(0); PG8_BAR; PG8_MMA(0, 0, At, B0); PG8_MMA(0, 1, At, B1); PG8_BAR; PG8_SCHED;
            PG8_LDA(At, 0, 1); PG8_STAGE(PG8_SB(0, 0), b2, voffB); PG8_STAGE(PG8_SB(0, 1), b2 + hstep, voffB); PG8_STAGE(PG8_SA(0, 0), a2, voffA);
            PG8_WAIT_V(8); PG8_WAIT_L(0); PG8_BAR; PG8_MMA(1, 0, At, B0); PG8_MMA(1, 1, At, B1); PG8_BAR; PG8_SCHED;
            PG8_LDB(B0, 1, 0); PG8_LDB(B1, 1, 1); PG8_SCHED; PG8_LDA(At, 1, 0); PG8_STAGE(PG8_SA(0, 1), a2 + hstep, voffA);
            PG8_WAIT_V(8); PG8_WAIT_L(0); PG8_BAR; PG8_MMA(0, 0, At, B0); PG8_MMA(0, 1, At, B1); PG8_BAR; PG8_SCHED;
            PG8_LDA(At, 1, 1); PG8_STAGE(PG8_SB(1, 0), b3, voffB); PG8_STAGE(PG8_SB(1, 1), b3 + hstep, voffB); PG8_STAGE(PG8_SA(1, 0), a3, voffA);
            PG8_WAIT_V(8); PG8_WAIT_L(0); PG8_BAR; PG8_MMA(1, 0, At, B0); PG8_MMA(1, 1, At, B1); PG8_BAR; PG8_SCHED;
            } else {
            PG8_LDB(B0, 0, 0); PG8_SCHED; PG8_LDA(At, 0, 0); PG8_STAGE(PG8_SA(1, 1), a1 + hstep, voffA);
            PG8_WAIT_L(8); PG8_BAR; PG8_WAIT_L(0); PG8_MMA(0, 0, At, B0); PG8_BAR; PG8_SCHED;
            PG8_LDB(B1, 0, 1); PG8_STAGE(PG8_SB(0, 0), b2, voffB);
            PG8_BAR; PG8_WAIT_L(0); PG8_MMA(0, 1, At, B1); PG8_BAR;
            PG8_LDA(At, 0, 1); PG8_STAGE(PG8_SA(0, 0), a2, voffA);
            PG8_BAR; PG8_WAIT_L(0); PG8_MMA(1, 0, At, B0); PG8_BAR; PG8_SCHED;
            PG8_STAGE(PG8_SB(0, 1), b2 + hstep, voffB);
            PG8_WAIT_V(6); PG8_BAR; PG8_MMA(1, 1, At, B1); PG8_BAR;
            PG8_LDB(B0, 1, 0); PG8_SCHED; PG8_LDA(At, 1, 0); PG8_STAGE(PG8_SA(0, 1), a2 + hstep, voffA);
            PG8_WAIT_L(8); PG8_BAR; PG8_WAIT_L(0); PG8_MMA(0, 0, At, B0); PG8_BAR; PG8_SCHED;
            PG8_LDB(B1, 1, 1); PG8_STAGE(PG8_SB(1, 0), b3, voffB);
            PG8_BAR; PG8_WAIT_L(0); PG8_MMA(0, 1, At, B1); PG8_BAR;
            PG8_LDA(At, 1, 1); PG8_STAGE(PG8_SA(1, 0), a3, voffA);
            PG8_BAR; PG8_WAIT_L(0); PG8_MMA(1, 0, At, B0); PG8_BAR; PG8_SCHED;
            PG8_STAGE(PG8_SB(1, 1), b3 + hstep, voffB);
            PG8_WAIT_V(6); PG8_BAR; PG8_MMA(1, 1, At, B1); PG8_BAR;
            }
        }
        if constexpr (ALIGN_EPI) { if (wr == 0) PG8_BAR; }
        if constexpr (!Epi::AFTER_DRAIN) { E(acc, cur, ui, wr, wc, fr, fq); S.done(cur); }
        if (!has_next) break;
#pragma unroll
        for (int a = 0; a < 2; ++a)
#pragma unroll
            for (int b = 0; b < 2; ++b)
#pragma unroll
                for (int m = 0; m < 4; ++m)
#pragma unroll
                    for (int n = 0; n < 2; ++n) acc[a][b][m][n] = (f32x4){0.f, 0.f, 0.f, 0.f};
        cur = nxt; cA = nA; cB = nB; ++ui;
        if constexpr (ALIGN_EPI) { if (wr == 1) PG8_BAR; }
    }
    PG8_WAIT_V(0);
    if constexpr (!ALIGN_EPI) { if (wr == 0) PG8_BAR; }
    PG8_BAR;
    if constexpr (Epi::AFTER_DRAIN) { E.fused(acc, cur, wr, wc, fr, fq, lds, wid, lane); S.done(cur); }
#undef PG8_SA
#undef PG8_SB
#undef PG8_STAGE
#undef PG8_LDA
#undef PG8_LDB
#undef PG8_MMA
#undef PG8_WAIT_V
#undef PG8_WAIT_L
#undef PG8_BAR
#undef PG8_SCHED
}
}

#ifndef PG8_SP2
#define PG8_SP2 true
#endif
#ifndef PG8_ALIGN
#define PG8_ALIGN true
#endif
namespace attn2 {
using bf16 = unsigned short;
typedef short bf16x8 __attribute__((ext_vector_type(8)));
typedef short s16x4 __attribute__((ext_vector_type(4)));
typedef float f32x16 __attribute__((ext_vector_type(16)));
typedef unsigned u32x4 __attribute__((ext_vector_type(4)));
constexpr int SEQ = 8192, DQ = 64, DV = 128, PIN = 2816, POUT = 1024;
constexpr int NW = 8, QBLK = 32, KVBLK = 64, QB = NW * QBLK;
constexpr int SHM_V = KVBLK * DV * 2, SHM_K = KVBLK * DQ * 2;
constexpr int LDS_BYTES = 2 * SHM_V + 2 * SHM_K + NW * 64 * 4;
#ifndef A2_ILV
#define A2_ILV 1
#endif
constexpr float LTHR = 1099511627776.f;
constexpr float C2 = 0.125f * 1.4426950408889634f;
#define A2_KSWZ(row, colB) ((row) * 128 + ((colB) ^ ((((row) >> 1) & 7) << 4)))
#define A2_SBAR() __builtin_amdgcn_sched_barrier(0)
__device__ __forceinline__ int v_rd_base(int lane) { return ((lane & 3) << 3) | (((lane >> 2) & 3) << 6) | (((lane >> 4) & 1) << 5) | (((lane >> 5) & 1) << 8); }
constexpr int v_rd_off(int d0, int ks, int half) { return d0 * 512 + ks * 4096 + half * 2048; }
__device__ __forceinline__ int crow(int r, int hi) { return (r & 3) + 8 * (r >> 2) + 4 * hi; }
typedef float f32x2_a __attribute__((ext_vector_type(2))); typedef __bf16 bf16x2_a __attribute__((ext_vector_type(2)));
__device__ __forceinline__ unsigned cvtpk(float lo, float hi) { f32x2_a v = {lo, hi}; bf16x2_a b = __builtin_convertvector(v, bf16x2_a); return __builtin_bit_cast(unsigned, b); }
typedef short v4i16_t __attribute__((ext_vector_type(4)));
typedef __attribute__((address_space(3))) const char* lds_cptr;
__device__ __forceinline__ s16x4 vtr(lds_cptr p) { return __builtin_bit_cast(s16x4, __builtin_amdgcn_ds_read_tr16_b64_v4i16((__attribute__((address_space(3))) v4i16_t*)p)); }
template <int VB>
__device__ __forceinline__ void pv_tile(f32x16* o, int vb0, bf16x8 pa0, bf16x8 pa1, bf16x8 pa2, bf16x8 pa3, bool act) {
    if (!act) return;
#define A2_TRRD(dst, off) asm volatile("ds_read_b64_tr_b16 %0, %1 offset:%2" : "=&v"(dst) : "v"(vb0), "i"(off) : "memory")
#define A2_PV_D0(d0) do { s16x4 l0, l1, l2, l3, h0, h1, h2, h3; constexpr int b_ = VB * SHM_V + v_rd_off(d0, 0, 0); \
        A2_TRRD(l0, b_); A2_TRRD(h0, b_ + 2048); A2_TRRD(l1, b_ + 4096); A2_TRRD(h1, b_ + 6144); A2_TRRD(l2, b_ + 8192); A2_TRRD(h2, b_ + 10240); A2_TRRD(l3, b_ + 12288); A2_TRRD(h3, b_ + 14336); \
        asm volatile("s_waitcnt lgkmcnt(0)" ::: "memory"); A2_SBAR();   \
        o[d0] = __builtin_amdgcn_mfma_f32_32x32x16_bf16(pa0, (bf16x8){l0[0], l0[1], l0[2], l0[3], h0[0], h0[1], h0[2], h0[3]}, o[d0], 0, 0, 0);   \
        o[d0] = __builtin_amdgcn_mfma_f32_32x32x16_bf16(pa1, (bf16x8){l1[0], l1[1], l1[2], l1[3], h1[0], h1[1], h1[2], h1[3]}, o[d0], 0, 0, 0);   \
        o[d0] = __builtin_amdgcn_mfma_f32_32x32x16_bf16(pa2, (bf16x8){l2[0], l2[1], l2[2], l2[3], h2[0], h2[1], h2[2], h2[3]}, o[d0], 0, 0, 0);   \
        o[d0] = __builtin_amdgcn_mfma_f32_32x32x16_bf16(pa3, (bf16x8){l3[0], l3[1], l3[2], l3[3], h3[0], h3[1], h3[2], h3[3]}, o[d0], 0, 0, 0); } while (0)
    A2_PV_D0(0); A2_PV_D0(1); A2_PV_D0(2); A2_PV_D0(3);
#undef A2_PV_D0
#undef A2_TRRD
}
struct BlockRef { const bf16* Q; const bf16* K; const bf16* V; bf16* O; int P0; };
__device__ __forceinline__ BlockRef unit_ref(int vcu, int i, const bf16* P, bf16* O, int cq, int ck, int cv) {
    const int s = vcu & 7, hs = i >> 2, k = i & 3, hm = (vcu >> 3) + 32 * hs, qb = (k == 0) ? s : (k == 1) ? 15 - s : (k == 2) ? 16 + s : 31 - s;
    const int m = hm & 1, h = (hm >> 1) & 3, b = hm >> 3;
    const bf16* base = P + (size_t)b * SEQ * PIN;
    BlockRef r; r.Q = base + (size_t)qb * QB * PIN + cq + (2 * h + m) * 64; r.K = base + ck + (2 * h + m) * 64; r.V = base + cv + h * 128;
    r.O = O + ((size_t)b * SEQ + (size_t)qb * QB) * POUT + h * 256 + m * 128; r.P0 = qb * QB; return r;
}
template <int KB>
__device__ __forceinline__ void qkt_rel(f32x16& p0, f32x16& p1, const char* K_lds, int r32, int hi, const bf16x8* qr, const f32x16& negm, bool act) {
    if (!act) { const float NEG = -__builtin_inff();
#pragma unroll
        for (int r = 0; r < 16; ++r) { p0[r] = NEG; p1[r] = NEG; } return; }
    bf16x8 b[8];
#pragma unroll
    for (int d0 = 0; d0 < 4; ++d0) { const char* a = K_lds + KB * SHM_K + A2_KSWZ(r32, (d0 * 16 + hi * 8) * 2);
        b[2 * d0] = *reinterpret_cast<const bf16x8*>(a); b[2 * d0 + 1] = *reinterpret_cast<const bf16x8*>(a + 32 * 128); }
    A2_SBAR();
#pragma unroll
    for (int d0 = 0; d0 < 4; ++d0) {
        if (d0 == 0) { p0 = __builtin_amdgcn_mfma_f32_32x32x16_bf16(b[0], qr[0], negm, 0, 0, 0); p1 = __builtin_amdgcn_mfma_f32_32x32x16_bf16(b[1], qr[0], negm, 0, 0, 0); }
        else { p0 = __builtin_amdgcn_mfma_f32_32x32x16_bf16(b[2 * d0], qr[d0], p0, 0, 0, 0); p1 = __builtin_amdgcn_mfma_f32_32x32x16_bf16(b[2 * d0 + 1], qr[d0], p1, 0, 0, 0); } }
}
__device__ __forceinline__ void partialSM_rel(f32x16& p0, f32x16& p1, float& mhat, f32x16& negm, bool first) {
    if (first) {
        float pmax = p0[0];
#pragma unroll
        for (int r = 1; r < 16; ++r) pmax = fmaxf(pmax, p0[r]);
#pragma unroll
        for (int r = 0; r < 16; ++r) pmax = fmaxf(pmax, p1[r]);
        { auto rr = __builtin_amdgcn_permlane32_swap(__float_as_uint(pmax), __float_as_uint(pmax), false, false);
          pmax = fmaxf(__uint_as_float(rr[0]), __uint_as_float(rr[1])); }
        mhat += pmax;
#pragma unroll
        for (int r = 0; r < 16; ++r) { p0[r] -= pmax; p1[r] -= pmax; }
#pragma unroll
        for (int r = 0; r < 16; ++r) negm[r] = -mhat;
        asm volatile("" : "+v"(negm)); }
#pragma unroll
    for (int r = 0; r < 16; ++r) p0[r] = __builtin_amdgcn_exp2f(p0[r]);
}
__device__ __forceinline__ void finishSM3(f32x16& p0, f32x16& p1, bf16x8& pa0, bf16x8& pa1, bf16x8& pa2, bf16x8& pa3) {
#pragma unroll
    for (int r = 0; r < 16; ++r) p1[r] = __builtin_amdgcn_exp2f(p1[r]);
#define A2_PK4(P, B_, OUT) do { u32x4 w = {cvtpk(P[B_+0], P[B_+1]), cvtpk(P[B_+2], P[B_+3]), cvtpk(P[B_+4], P[B_+5]), cvtpk(P[B_+6], P[B_+7])}; OUT = *reinterpret_cast<bf16x8*>(&w); } while (0)
    A2_PK4(p0, 0, pa0); A2_PK4(p0, 8, pa1); A2_PK4(p1, 0, pa2); A2_PK4(p1, 8, pa3);
}
constexpr int R_V = 0, R_K = 4 * SHM_V, R_WS = R_K + 3 * SHM_K, R_Q = R_WS + NW * 64 * 4, R_STG = R_Q + 16, LDS3_BYTES = R_STG + NW * 4096;
typedef __attribute__((address_space(3))) unsigned char* lds_ptr;
#define A3_WAITBAR(N) asm volatile("s_waitcnt vmcnt(" #N ") lgkmcnt(0)\n\ts_barrier" ::: "memory")
struct Dma { const bf16* kb; const bf16* vb; unsigned ko, vao; };
__device__ __forceinline__ Dma dma_src(const bf16* Kh, const bf16* Vh, int wid, int lane) {
    Dma d; d.kb = Kh; d.vb = Vh;
    { const int p = wid * 64 + lane, row = p >> 3, slot = p & 7, c = slot ^ ((row >> 1) & 7); d.ko = (unsigned)(row * PIN + c * 8) * 2u; }
    { const int st = (2 * wid) * 2 + (lane >> 5), kk = (st >> 2) * 8 + ((lane & 31) >> 2), c = (st & 3) * 32 + (lane & 3) * 8;
        const int key = kk;
        d.vao = (unsigned)(key * PIN + c) * 2u; }
    return d;
}
template <int IMM = 0>
__device__ __forceinline__ void glds16(const void* sbase, unsigned voff, unsigned lds_dst) { unsigned keep;
    const unsigned long long b_ = (unsigned long long)(uintptr_t)sbase;
    const unsigned long long sb = ((unsigned long long)(unsigned)__builtin_amdgcn_readfirstlane((int)(b_ >> 32)) << 32) | (unsigned)__builtin_amdgcn_readfirstlane((int)(unsigned)b_);
    asm volatile("s_mov_b32 %0, m0\n\ts_mov_b32 m0, %3\n\ts_nop 0\n\tglobal_load_lds_dwordx4 %1, %2 offset:%4\n\ts_mov_b32 m0, %0" : "=&s"(keep) : "v"(voff), "s"(sb), "s"(lds_dst), "i"(IMM) : "memory"); }
#define A3_DMA_K(D, t, slot) glds16((D).kb + (size_t)(t) * KVBLK * PIN, (D).ko, (unsigned)__builtin_amdgcn_readfirstlane(lds0 + R_K + (slot) * SHM_K + wid * 1024))
#define A3_DMA_V(D, t, slot) do { glds16((D).vb + (size_t)(t) * KVBLK * PIN, (D).vao, (unsigned)__builtin_amdgcn_readfirstlane(lds0 + R_V + (slot) * SHM_V + wid * 2048)); \
                                  glds16<128>((D).vb + (size_t)(t) * KVBLK * PIN, (D).vao, (unsigned)__builtin_amdgcn_readfirstlane(lds0 + R_V + (slot) * SHM_V + wid * 2048 + 1024 - 128)); } while (0)
struct Seam3 { bf16x8 qr[4]; };
typedef float f32x4_l __attribute__((ext_vector_type(4)));
__device__ __forceinline__ void prime3(const BlockRef& cur, char* lds, Seam3& S) {
    int tid_ = threadIdx.x; asm volatile("" : "+v"(tid_));
    const int tid = tid_, wid = __builtin_amdgcn_readfirstlane(tid >> 6), lane = tid & 63, r32 = lane & 31, hi = lane >> 5;
    const unsigned lds0 = (unsigned)(uintptr_t)lds;
    const Dma D = dma_src(cur.K, cur.V, wid, lane);
    A3_DMA_K(D, 0, 0); A3_DMA_K(D, 1, 1); A2_SBAR();
#pragma unroll
    for (int d0 = 0; d0 < 4; ++d0) S.qr[d0] = *(const bf16x8*)(cur.Q + (size_t)(wid * QBLK + r32) * PIN + d0 * 16 + hi * 8);
    A2_SBAR();
    A3_WAITBAR(5);
    A3_DMA_V(D, 0, 0);
}
template <bool LEAD>
__device__ __forceinline__ void block3(const BlockRef& cur, const BlockRef& nxt, char* lds, Seam3& S) {
    int tid_ = threadIdx.x; asm volatile("" : "+v"(tid_));
    const int tid = tid_, wid = __builtin_amdgcn_readfirstlane(tid >> 6), lane = tid & 63, r32 = lane & 31, hi = lane >> 5;
    const int NT = (cur.P0 + QB) / KVBLK;
    const int wchunk = (cur.P0 + wid * QBLK) >> 6;
    const unsigned lds0 = (unsigned)(uintptr_t)lds;
    char* V_lds = lds + R_V; char* K_lds = lds + R_K;
    float* ws = (float*)(lds + R_WS) + wid * 64; float* li_l = ws, * al_l = ws + 32;
    float mhat = 0.f; f32x4_l lacc = {0.f, 0.f, 0.f, 0.f}; f32x16 o[4] = {}; f32x16 negm = {}; asm volatile("" : "+v"(negm));
    const int vb0 = (int)(uintptr_t)V_lds + v_rd_base(lane);
    const lds_cptr vb3 = (lds_cptr)V_lds + v_rd_base(lane);
    const Dma D = dma_src(cur.K, cur.V, wid, lane);
    const bool sel_ = (((lane & 15) == 0) && !((lane >> 4) & 1)) || (((lane & 15) == 1) && ((lane >> 4) & 1));
    bf16x8 bsel; { const unsigned w_ = sel_ ? 0x3f803f80u : 0u; const u32x4 ww = {w_, w_, w_, w_}; bsel = __builtin_bit_cast(bf16x8, ww); } asm volatile("" : "+v"(bsel));
#define A3_LS1(PA) lacc = __builtin_amdgcn_mfma_f32_16x16x32_bf16(PA, bsel, lacc, 0, 0, 0)
#define A3_LSUM() do { A3_LS1(pa0); A3_LS1(pa1); A3_LS1(pa2); A3_LS1(pa3); } while (0)
    int s0 = 0, s1 = 1, s2 = 2;
#define A3_ROT() do { const int t_ = s0; s0 = s1; s1 = s2; s2 = t_; } while (0)
#define A2_LRES(P0, P1) do { const float lm_ = __builtin_fmaxf(__builtin_fmaxf(lacc[0], lacc[1]), __builtin_fmaxf(lacc[2], lacc[3]));                     \
        if (__builtin_expect(__any(lm_ > LTHR), 0)) {                                                                                     \
            if ((lane & 15) < 2) { _Pragma("unroll") for (int e_ = 0; e_ < 4; ++e_) al_l[16 * (lane & 15) + 4 * (lane >> 4) + e_] = __builtin_floorf(__builtin_amdgcn_logf(__builtin_fmaxf(lacc[e_], 1.f))); } \
            asm volatile("s_waitcnt lgkmcnt(0)" ::: "memory");                                                                          \
            const float dl_ = al_l[r32], a_ = __builtin_amdgcn_exp2f(-dl_); mhat += dl_;                                                 \
            _Pragma("unroll") for (int r_ = 0; r_ < 16; ++r_) { P0[r_] *= a_; P1[r_] -= dl_; negm[r_] = -mhat; }                          \
            asm volatile("" : "+v"(negm));                                                                                               \
            _Pragma("unroll") for (int d_ = 0; d_ < 4; ++d_) _Pragma("unroll") for (int r = 0; r < 16; ++r) o[d_][r] *= __builtin_amdgcn_exp2f(-al_l[crow(r, hi)]);      \
            _Pragma("unroll") for (int e_ = 0; e_ < 4; ++e_) lacc[e_] *= __builtin_amdgcn_exp2f(-al_l[(16 * (lane & 15) + 4 * (lane >> 4) + e_) & 31]); } } while (0)
#define A2_ACT(t) ((t) <= wchunk)
    f32x16 pA0, pA1, pB0, pB1; bf16x8 pa0, pa1, pa2, pa3;
    constexpr bool lead = LEAD;
    s16x4 vl[3], vh[3];
    A2_SBAR(); qkt_rel<0>(pA0, pA1, K_lds, r32, hi, S.qr, negm, true);
    A3_DMA_K(D, 2, 2); A3_DMA_V(D, 1, 1);
    if (lead) partialSM_rel(pA0, pA1, mhat, negm, true);
    A2_SBAR(); A3_WAITBAR(3);
#define A2_VFR(i) (bf16x8){vl[(i) % 3][0], vl[(i) % 3][1], vl[(i) % 3][2], vl[(i) % 3][3], vh[(i) % 3][0], vh[(i) % 3][1], vh[(i) % 3][2], vh[(i) % 3][3]}
#define A2_VRD(i, VBP) do { vl[(i) % 3] = vtr((VBP) + ((i) & 3) * 512 + ((i) >> 2) * 4096); vh[(i) % 3] = vtr((VBP) + ((i) & 3) * 512 + ((i) >> 2) * 4096 + 2048); } while (0)
#define A2_PAK(i) (((i) >> 2) == 0 ? pa0 : ((i) >> 2) == 1 ? pa1 : ((i) >> 2) == 2 ? pa2 : pa3)
#define A2_GAP(i, PX0, PX1, VBP) do {                                                                                         \
        if ((i) + 2 < 16) A2_VRD((i) + 2, VBP);                                                                               \
        o[(i) & 3] = __builtin_amdgcn_mfma_f32_32x32x16_bf16(A2_PAK(i), A2_VFR(i), o[(i) & 3], 0, 0, 0);                     \
        if ((i) >= 2 && (i) < 10) { const int k_ = 2 * ((i) - 2);                                                            \
            PX0[k_] = __builtin_amdgcn_exp2f(PX0[k_]); PX0[k_ + 1] = __builtin_amdgcn_exp2f(PX0[k_ + 1]);                     \
            asm volatile("" : "+v"(PX0)); }                                                                                  \
        A2_SBAR(); } while (0)
#define A2_PVSM(PX0, PX1, VBP) do { __builtin_amdgcn_s_setprio(1);                                                            \
        A2_GAP(0, PX0, PX1, VBP); A2_GAP(1, PX0, PX1, VBP); A2_GAP(2, PX0, PX1, VBP); A2_GAP(3, PX0, PX1, VBP);               \
        A2_GAP(4, PX0, PX1, VBP); A2_GAP(5, PX0, PX1, VBP); A2_GAP(6, PX0, PX1, VBP); A2_GAP(7, PX0, PX1, VBP);               \
        A2_GAP(8, PX0, PX1, VBP); A2_GAP(9, PX0, PX1, VBP); A2_GAP(10, PX0, PX1, VBP); A2_GAP(11, PX0, PX1, VBP);             \
        A2_GAP(12, PX0, PX1, VBP); A2_GAP(13, PX0, PX1, VBP); A2_GAP(14, PX0, PX1, VBP); A2_GAP(15, PX0, PX1, VBP);           \
        __builtin_amdgcn_s_setprio(0); } while (0)
#define A2_SG(mask, n) __builtin_amdgcn_sched_group_barrier(mask, n, 0)
#define A3_KRD(g) kf[(g) & 3] = *reinterpret_cast<const bf16x8*>(kb_ + A2_KSWZ(r32, (((g) >> 1) * 16 + hi * 8) * 2) + ((g) & 1) * 4096)
#define A3_EX(PY1, k) PY1[k] = __builtin_amdgcn_exp2f(PY1[k])
#define A3_G1(g, PX0, PX1, CN, PY0, PY1, DK, DV, t, VBP) do {                                                            \
        if ((g) & 1) { if ((g) >> 1) PX1 = __builtin_amdgcn_mfma_f32_32x32x16_bf16(kf[(g) & 3], S.qr[(g) >> 1], PX1, 0, 0, 0); else PX1 = __builtin_amdgcn_mfma_f32_32x32x16_bf16(kf[(g) & 3], S.qr[0], CN, 0, 0, 0); } \
        else         { if ((g) >> 1) PX0 = __builtin_amdgcn_mfma_f32_32x32x16_bf16(kf[(g) & 3], S.qr[(g) >> 1], PX0, 0, 0, 0); else PX0 = __builtin_amdgcn_mfma_f32_32x32x16_bf16(kf[(g) & 3], S.qr[0], CN, 0, 0, 0); } \
        if ((g) + 4 < 8) A3_KRD((g) + 4);                                                                                     \
        if ((g) < 5) { A3_EX(PY1, 3 * (g)); A3_EX(PY1, 3 * (g) + 1); A3_EX(PY1, 3 * (g) + 2); asm volatile("" : "+v"(PY1)); }  \
        if ((g) == 5) { A3_EX(PY1, 15); asm volatile("" : "+v"(PY1)); }                                                       \
        if ((g) == 4) { A2_PK4(PY1, 0, pa2); asm volatile("" : "+v"(pa2)); }                                                  \
        if ((g) == 0) { A3_LS1(pa0); }                                                                                       \
        if ((g) == 1) { A3_LS1(pa1); }                                                                                       \
        if ((g) == 5) { A3_LS1(pa2); }                                                                                       \
        if ((g) == 6) { A2_PK4(PY1, 8, pa3); asm volatile("" : "+v"(pa3)); }                                                  \
        if ((g) == 7) { A3_LS1(pa3); }                                                                                       \
        if ((g) == 3 && (DK)) A3_DMA_K(D, (t) + 2, s0);                                                                       \
        if ((g) == 5 && (DV)) glds16(D.vb + (size_t)((t) + 1) * KVBLK * PIN, D.vao, (unsigned)__builtin_amdgcn_readfirstlane(lds0 + R_V + (((t) + 1) & 3) * SHM_V + wid * 2048));          \
        if ((g) == 6 && (DV)) glds16<128>(D.vb + (size_t)((t) + 1) * KVBLK * PIN, D.vao, (unsigned)__builtin_amdgcn_readfirstlane(lds0 + R_V + (((t) + 1) & 3) * SHM_V + wid * 2048 + 1024 - 128));   \
        if ((g) == 6) A2_VRD(0, VBP);                                                                                         \
        if ((g) == 7) A2_VRD(1, VBP);                                                                                         \
        A2_SBAR(); } while (0)
#define A3_R1(PX0, PX1, CN, PY0, PY1, DK, DV, t, VBP) do { bf16x8 kf[4]; const char* kb_ = K_lds + s1 * SHM_K;    \
        A3_KRD(0); A3_KRD(1); A3_KRD(2); A3_KRD(3);                                                                           \
        A2_PK4(PY0, 0, pa0); A2_PK4(PY0, 8, pa1); asm volatile("" : "+v"(pa0), "+v"(pa1)); A2_SBAR(); \
        A3_G1(0, PX0, PX1, CN, PY0, PY1, DK, DV, t, VBP); A3_G1(1, PX0, PX1, CN, PY0, PY1, DK, DV, t, VBP);         \
        A3_G1(2, PX0, PX1, CN, PY0, PY1, DK, DV, t, VBP); A3_G1(3, PX0, PX1, CN, PY0, PY1, DK, DV, t, VBP);         \
        A3_G1(4, PX0, PX1, CN, PY0, PY1, DK, DV, t, VBP); A3_G1(5, PX0, PX1, CN, PY0, PY1, DK, DV, t, VBP);         \
        A3_G1(6, PX0, PX1, CN, PY0, PY1, DK, DV, t, VBP); A3_G1(7, PX0, PX1, CN, PY0, PY1, DK, DV, t, VBP); } while (0)
#define A3_FAST_STEP(PX0, PX1, PY0, PY1, t) do {                                                      \
        const lds_cptr vbs_ = vb3 + (((t) - 1) & 3) * SHM_V;                                                                  \
        A2_SBAR(); A3_R1(PX0, PX1, negm, PY0, PY1, true, true, t, vbs_);                                                 \
        A2_PVSM(PX0, PX1, vbs_);                                                                                              \
        A2_SBAR(); A2_LRES(PX0, PX1);                                                                                             \
        A3_WAITBAR(3); A3_ROT(); } while (0)
#define A3_BAND_STEP(PX0, PX1, PY0, PY1, t) do {                                                      \
        const lds_cptr vbs_ = vb3 + (((t) - 1) & 3) * SHM_V; const bool dk_ = (t) + 2 < NT, dv_ = (t) + 1 < NT;               \
        A2_SBAR(); A3_R1(PX0, PX1, negm, PY0, PY1, dk_, dv_, t, vbs_);                                                   \
        A2_SBAR(); if (!A2_ACT(t)) { _Pragma("unroll") for (int r_ = 0; r_ < 16; ++r_) { PX0[r_] = -__builtin_inff(); PX1[r_] = -__builtin_inff(); } } A2_SBAR(); \
        A2_PVSM(PX0, PX1, vbs_);                                                                                              \
        A2_SBAR(); A2_LRES(PX0, PX1);                                                                                             \
        if ((t) + 2 < NT) A3_WAITBAR(3); else if ((t) + 1 < NT) A3_WAITBAR(2); else A3_WAITBAR(0);                            \
        A3_ROT(); } while (0)
#define B3_FAST_STEP(PX0, PX1, PY0, PY1, t) do {                                                      \
        const lds_cptr vbp_ = vb3 + (((t) - 2) & 3) * SHM_V, vbn_ = vb3 + (((t) - 1) & 3) * SHM_V;                            \
        A2_SBAR(); A2_PVSM(PY0, PY1, vbp_);                                                                                   \
        A2_SBAR(); A2_LRES(PY0, PY1);                                                                                             \
        A2_SBAR(); A3_R1(PX0, PX1, negm, PY0, PY1, true, true, t, vbn_);                                                 \
        A3_WAITBAR(3); A3_ROT(); } while (0)
#define B3_BAND_STEP(PX0, PX1, PY0, PY1, t) do {                                                      \
        const lds_cptr vbp_ = vb3 + (((t) - 2) & 3) * SHM_V, vbn_ = vb3 + (((t) - 1) & 3) * SHM_V; const bool dk_ = (t) + 2 < NT, dv_ = (t) + 1 < NT; \
        A2_SBAR(); A2_PVSM(PY0, PY1, vbp_);                                                                                   \
        A2_SBAR(); A2_LRES(PY0, PY1);                                                                                             \
        A2_SBAR(); A3_R1(PX0, PX1, negm, PY0, PY1, dk_, dv_, t, vbn_);                                                   \
        A2_SBAR(); if (!A2_ACT(t)) { _Pragma("unroll") for (int r_ = 0; r_ < 16; ++r_) { PX0[r_] = -__builtin_inff(); PX1[r_] = -__builtin_inff(); } } A2_SBAR(); \
        if ((t) + 2 < NT) A3_WAITBAR(3); else if ((t) + 1 < NT) A3_WAITBAR(2); else A3_WAITBAR(0);                            \
        A3_ROT(); } while (0)
    if (lead) {
        int t = 1;
        for (; t + 1 < NT - 4; t += 2) {
            A3_FAST_STEP(pB0, pB1, pA0, pA1, t);
            A3_FAST_STEP(pA0, pA1, pB0, pB1, t + 1);
        }
        for (; t + 1 < NT; t += 2) {
            A3_BAND_STEP(pB0, pB1, pA0, pA1, t);
            A3_BAND_STEP(pA0, pA1, pB0, pB1, t + 1);
        }
        A2_SBAR(); qkt_rel<0>(pB0, pB1, K_lds + s1 * SHM_K, r32, hi, S.qr, negm, A2_ACT(NT - 1));
        finishSM3(pA0, pA1, pa0, pa1, pa2, pa3); A3_LSUM(); A2_SBAR();
        pv_tile<0>(o, vb0 + ((NT - 2) & 3) * SHM_V, pa0, pa1, pa2, pa3, A2_ACT(NT - 2)); partialSM_rel(pB0, pB1, mhat, negm, false);
        A2_SBAR(); A2_LRES(pB0, pB1);
        A3_WAITBAR(0);
    } else {
        partialSM_rel(pA0, pA1, mhat, negm, true);
        { const lds_cptr vbn_ = vb3; A2_SBAR(); A3_R1(pB0, pB1, negm, pA0, pA1, true, true, 1, vbn_); }
        A3_WAITBAR(3); A3_ROT();
        int t = 2;
        for (; t + 1 < NT - 4; t += 2) {
            B3_FAST_STEP(pA0, pA1, pB0, pB1, t);
            B3_FAST_STEP(pB0, pB1, pA0, pA1, t + 1);
        }
        for (; t + 1 < NT; t += 2) {
            B3_BAND_STEP(pA0, pA1, pB0, pB1, t);
            B3_BAND_STEP(pB0, pB1, pA0, pA1, t + 1);
        }
    }
    const Dma Dn = dma_src(nxt.K, nxt.V, wid, lane);
    A3_DMA_K(Dn, 0, 0); A3_DMA_K(Dn, 1, 1); A2_SBAR();
#pragma unroll
    for (int d0 = 0; d0 < 4; ++d0) S.qr[d0] = *(const bf16x8*)(nxt.Q + (size_t)(wid * QBLK + r32) * PIN + d0 * 16 + hi * 8);
    A2_SBAR();
    if (!lead) { const lds_cptr vbp_ = vb3 + ((NT - 2) & 3) * SHM_V; A2_SBAR(); A2_PVSM(pB0, pB1, vbp_); A2_SBAR(); A2_LRES(pB0, pB1); A2_SBAR(); }
    finishSM3(pB0, pB1, pa0, pa1, pa2, pa3); A3_LSUM(); A2_SBAR(); pv_tile<0>(o, vb0 + ((NT - 1) & 3) * SHM_V, pa0, pa1, pa2, pa3, A2_ACT(NT - 1));
    A2_SBAR();
    if ((lane & 15) < 2) { _Pragma("unroll") for (int e_ = 0; e_ < 4; ++e_) li_l[16 * (lane & 15) + 4 * (lane >> 4) + e_] = lacc[e_]; } asm volatile("s_waitcnt lgkmcnt(0)" ::: "memory");
    float rli[16];
#pragma unroll
    for (int r = 0; r < 16; ++r) rli[r] = __builtin_amdgcn_rcpf(li_l[crow(r, hi)]);
    A2_SBAR();
    asm volatile("s_waitcnt vmcnt(5)" ::: "memory");
    A2_SBAR();
    bf16* Ow = cur.O + (size_t)(wid * QBLK) * POUT;
    { unsigned short* stg = (unsigned short*)(lds + R_STG) + wid * 2048;
#pragma unroll
      for (int pass = 0; pass < 2; ++pass) {
#pragma unroll
          for (int r = 0; r < 16; r += 2) { const int ra = crow(r, hi), rb = crow(r + 1, hi);
#pragma unroll
              for (int dd = 0; dd < 2; ++dd) { const unsigned w = cvtpk(o[2 * pass + dd][r] * rli[r], o[2 * pass + dd][r + 1] * rli[r + 1]);
                  stg[ra * 64 + dd * 32 + r32] = (unsigned short)(w & 0xffffu); stg[rb * 64 + dd * 32 + r32] = (unsigned short)(w >> 16); } }
          asm volatile("s_waitcnt lgkmcnt(0)" ::: "memory");
#pragma unroll
          for (int i = 0; i < 4; ++i) { const int row = i * 8 + (lane >> 3), ch = lane & 7; const u32x4 v = *(const u32x4*)(stg + row * 64 + ch * 8);
              *(u32x4*)(Ow + (size_t)row * POUT + pass * 64 + ch * 8) = v; }
          asm volatile("s_waitcnt lgkmcnt(0)" ::: "memory");
      } }
    A2_SBAR();
    asm volatile("s_waitcnt lgkmcnt(0)\n\ts_barrier" ::: "memory");
    A3_DMA_V(Dn, 0, 0);
#undef A3_ROT
#undef A3_LS1
#undef A3_LSUM
#undef A2_LRES
#undef A2_ACT
#undef A2_VFR
#undef A2_VRD
#undef A2_PAK
#undef A2_GAP
#undef A2_PVSM
#undef A2_SG
#undef A3_FAST_STEP
#undef A2_PK4
#undef A3_KRD
#undef A3_EX
#undef A3_G1
#undef A3_R1
#undef A3_BAND_STEP
#undef B3_FAST_STEP
#undef B3_BAND_STEP
}
__device__ __forceinline__ BlockRef unit_hq(int hm, int qb, const bf16* P, bf16* O, int cq, int ck, int cv) {
    const int m = hm & 1, h = (hm >> 1) & 3, b = hm >> 3;
    const bf16* base = P + (size_t)b * SEQ * PIN;
    BlockRef r; r.Q = base + (size_t)qb * QB * PIN + cq + (2 * h + m) * 64; r.K = base + ck + (2 * h + m) * 64; r.V = base + cv + h * 128;
    r.O = O + ((size_t)b * SEQ + (size_t)qb * QB) * POUT + h * 256 + m * 128; r.P0 = qb * QB; return r;
}
__device__ __forceinline__ void attn_phase3(char* lds, const bf16* P, bf16* O, int vcu, int G, int cq, int ck, int cv, unsigned* qctr) {
    constexpr int NST = 4, NDYN = 1024;
    const int s_ = vcu & 7, g_ = vcu >> 3, x_ = (G == 256) ? (vcu >> 5) : 0;
    unsigned* qc = qctr; (void)x_;
    volatile __attribute__((address_space(3))) unsigned* qw = (volatile __attribute__((address_space(3))) unsigned*)((lds_cptr)lds + R_Q);
#define A3_STATIC(i) unit_hq(g_ + 32 * ((i) / 2), ((i) % 2 == 0) ? 31 - s_ : 16 + s_, P, O, cq, ck, cv)
#define A3_DYN(d) unit_hq((d) & 63, 15 - ((d) >> 6), P, O, cq, ck, cv)
    const bool lead_ = __builtin_amdgcn_readfirstlane((int)(threadIdx.x >> 6)) < 4;
    Seam3 S; BlockRef cur = A3_STATIC(0);
    prime3(cur, lds, S);
    int dn = NDYN;
    for (int i = 0;; ++i) {
        bool has_next; BlockRef nxt;
        if (i + 1 < NST) { has_next = true; nxt = A3_STATIC(i + 1); }
        else { has_next = (G == 256) && dn < NDYN; nxt = has_next ? A3_DYN(dn) : cur; }
        if (i + 2 >= NST && threadIdx.x == 0) qw[i & 1] = __hip_atomic_fetch_add(qc, 1u, __ATOMIC_RELAXED, __HIP_MEMORY_SCOPE_AGENT);
        if (lead_) block3<true>(cur, nxt, lds, S); else block3<false>(cur, nxt, lds, S);
        const int dn2 = (i + 2 >= NST) ? __builtin_amdgcn_readfirstlane((int)qw[i & 1]) : NDYN;
        if (!has_next) break;
        cur = nxt; dn = dn2;
    }
#undef A3_STATIC
#undef A3_DYN
    asm volatile("s_waitcnt vmcnt(0)\n\ts_barrier" ::: "memory");
}
#undef A2_KSWZ
#undef A2_SBAR
#undef A2_VMW
#undef A2_VMWN
#undef A2_SLOAD
#undef A2_SWRITE_K
#undef A2_SWRITE_V
}
#define GAS __attribute__((address_space(1)))
#define LAS __attribute__((address_space(3)))
typedef unsigned short bf16;
typedef unsigned v4u __attribute__((ext_vector_type(4)));
typedef float f32x4 __attribute__((ext_vector_type(4)));
typedef short bf16x8 __attribute__((ext_vector_type(8)));
typedef GAS unsigned gu32;
typedef GAS unsigned long long gu64;
#define RLX_AGENT __ATOMIC_RELAXED, __HIP_MEMORY_SCOPE_AGENT
#define LDS_WAIT() asm volatile("s_waitcnt lgkmcnt(0)" ::: "memory")
#define VM_WAIT() asm volatile("s_waitcnt vmcnt(0)" ::: "memory")
__device__ __forceinline__ unsigned long long rt() { return __builtin_amdgcn_s_memrealtime(); }
__device__ __forceinline__ unsigned f2bf(float f) { unsigned u = __builtin_bit_cast(unsigned, f); return (u + 0x7fffu + ((u >> 16) & 1u)) >> 16; }
__device__ __forceinline__ unsigned pk2(float lo, float hi) { return f2bf(lo) | (f2bf(hi) << 16); }

#define XB_TMO      128
#define XB_XCNT(j)  (256  + 64 * (j))
#define XB_XSUB(j)  (1280 + 64 * (j))
#define XB_XGEN(j)  (2304 + 64 * (j))
#define XB_TOP      3328
#define XB_TOPGEN   3392
#define XCD_BAR_WORDS 3456
#define XB_SPIN_CAP (1u << 18)

__device__ __forceinline__ unsigned xb_ld(unsigned* p)              { return __hip_atomic_load(p, __ATOMIC_RELAXED, __HIP_MEMORY_SCOPE_AGENT); }
__device__ __forceinline__ unsigned xb_add(unsigned* p, unsigned v) { return __hip_atomic_fetch_add(p, v, __ATOMIC_RELAXED, __HIP_MEMORY_SCOPE_AGENT); }
__device__ __forceinline__ unsigned xb_xcc_id() { return (unsigned)__builtin_amdgcn_s_getreg((3 << 11) | 20) & 0xFu; }
#define XB_SPIN(cond, bar) do { unsigned _sp = 0; while (cond) { __builtin_amdgcn_s_sleep(1); \
    if ((++_sp & 255u) == 0u) { if (xb_ld(&(bar)[XB_TMO])) break; if (_sp > XB_SPIN_CAP) { atomicAdd(&(bar)[XB_TMO], 1u); break; } } } } while (0)

struct XcdBarrier {
    unsigned* bar; unsigned x;
    volatile LAS unsigned* st;
};

__device__ __forceinline__ XcdBarrier xcd_barrier_post(unsigned* bar, volatile LAS unsigned* st) {
    XcdBarrier b; b.bar = bar; b.x = xb_xcc_id(); b.st = st;
    if (threadIdx.x == 0) (void)xb_add(&bar[XB_XCNT(b.x)], 1u);
    return b;
}
__device__ __forceinline__ void xcd_barrier_complete(unsigned* bar, unsigned x, unsigned& nloc, unsigned& nx) {
    const unsigned G = gridDim.x * gridDim.y * gridDim.z;
    unsigned sum, cnt, mine, sp = 0u;
    for (;;) {
        sum = 0u; cnt = 0u; mine = 0u;
#pragma unroll
        for (unsigned j = 0; j < 16; ++j) { const unsigned c = xb_ld(&bar[XB_XCNT(j)]); sum += c; cnt += (c > 0u) ? 1u : 0u; mine = (j == x) ? c : mine; }
        if (sum == G) break;
        __builtin_amdgcn_s_sleep(1);
        if ((++sp & 255u) == 0u) { if (xb_ld(&bar[XB_TMO])) break; if (sp > XB_SPIN_CAP) { atomicAdd(&bar[XB_TMO], 1u); break; } }
    }
    nloc = mine > 0u ? mine : 1u; nx = cnt > 0u ? cnt : 1u;
}

__device__ __forceinline__ void xcd_barrier(const XcdBarrier& b) {
    asm volatile("s_waitcnt vmcnt(0)" ::: "memory");
    __syncthreads();
    if (threadIdx.x == 0) {
        unsigned* bar = b.bar;
        __builtin_amdgcn_s_waitcnt(0);
        unsigned nloc = b.st[0], nx = b.st[1];
        if (nloc == 0u) { xcd_barrier_complete(bar, b.x, nloc, nx); b.st[0] = nloc; b.st[1] = nx; }
        const unsigned old = xb_add(&bar[XB_XSUB(b.x)], 1u);
        const unsigned gen = old / nloc;
        if (old + 1u == (gen + 1u) * nloc) {
            __builtin_amdgcn_fence(__ATOMIC_RELEASE, "agent");
            asm volatile("s_waitcnt vmcnt(0)" ::: "memory");
            const unsigned og = xb_add(&bar[XB_TOP], 1u);
            const unsigned tg = og / nx;
            if (og + 1u == (tg + 1u) * nx) xb_add(&bar[XB_TOPGEN], 1u);
            else XB_SPIN(xb_ld(&bar[XB_TOPGEN]) == tg, bar);
            __builtin_amdgcn_fence(__ATOMIC_ACQUIRE, "agent");
            xb_add(&bar[XB_XGEN(b.x)], 1u);
            asm volatile("s_waitcnt vmcnt(0)" ::: "memory");
        } else {
            XB_SPIN(xb_ld(&bar[XB_XGEN(b.x)]) == gen, bar);
            __builtin_amdgcn_fence(__ATOMIC_ACQUIRE, "agent");
            asm volatile("s_waitcnt vmcnt(0)" ::: "memory");
        }
    }
    __syncthreads();
}

constexpr int NWAVES = 8;
#ifndef MK_PER_PHASE
#define MK_PER_PHASE 0
#endif

constexpr int BATCH = 8, SEQ = 8192, D = 1024, FF = 4096, DEPTH = 2;
constexpr int M = BATCH * SEQ;
constexpr int CHUNK = 64, NCH = SEQ / CHUNK;
constexpr int NP_SRC = 2576;
constexpr int NP = 2816;
constexpr int C_POOL = 0, C_DQ = 256, C_DK = 768, C_DV = 1280, C_GQ = 1792, C_GK = 1920, C_GV = 2048, C_GR = 2304, C_GG = 2560;
constexpr float EPS = 1e-6f;
static_assert(NP == attn2::PIN && D == attn2::POUT && attn2::LDS_BYTES <= 131072 && attn2::LDS3_BYTES <= 131072, "attention body geometry");

constexpr size_t MiB = 1u << 20;
constexpr size_t WS_CTL = 0, CTL_ZERO_BYTES = 1 * MiB;
constexpr size_t WS_WPOOL = 1 * MiB;
constexpr size_t WS_W = 2 * MiB, W_LAYER = 24 * MiB;
constexpr size_t WO_IN = 0, WO_OUT = 6 * MiB, WO_1 = 8 * MiB, WO_2 = 16 * MiB;
constexpr size_t WS_SSA = 50 * MiB, WS_SSB = 54 * MiB;
constexpr size_t WS_GDEC = 58 * MiB;
constexpr size_t WS_GKV = 60 * MiB;
constexpr size_t WS_HB = 96 * MiB;
constexpr size_t WS_PROJ = 224 * MiB;
constexpr size_t WS_OATT = 576 * MiB;
constexpr size_t WS_MIX = 704 * MiB;
constexpr size_t WS_HID = 224 * MiB;
constexpr size_t WS_END = 832 * MiB;
static_assert(WS_W + DEPTH * W_LAYER <= WS_SSA && WS_GKV + (size_t)BATCH * 4 * NCH * 2048 * 4 <= WS_HB && WS_HB + (size_t)M * D * 2 <= WS_PROJ && WS_PROJ + (size_t)M * NP * 2 <= WS_OATT && WS_HID + (size_t)M * FF * 2 <= WS_END, "d_ws map");
constexpr int CW_TMO = 0, CW_CODE = 1;
constexpr int CW_BAR = 4096;
constexpr int CW_QUEUE = 20480;

constexpr int RING_OFF = 0, RING_BYTES = 131072;
constexpr int LDSCTL_OFF = RING_BYTES, MISC_OFF = LDSCTL_OFF + 320;
constexpr int RST_OFF = MISC_OFF + 128, RST_MAXU = 16;
constexpr int LDS_BYTES = 155648;
static_assert(RST_OFF % 16 == 0 && RST_OFF + RST_MAXU * 256 * 4 <= LDS_BYTES, "LDS map");

struct Frame {
    LAS unsigned char* lds;
    volatile LAS unsigned* MISC;
    gu32* ctl;
    int tid, lane, wave;
    int vcu, G;
};
typedef float f32x16 __attribute__((ext_vector_type(16)));
typedef unsigned u32x2v __attribute__((ext_vector_type(2)));
__device__ __forceinline__ float wave_sum(float v) {
#pragma unroll
    for (int o = 1; o < 64; o <<= 1) v += __shfl_xor(v, o);
    return v;
}
__device__ __forceinline__ float bf2f(unsigned short b) { return __uint_as_float((unsigned)b << 16); }
typedef float f32x2_c __attribute__((ext_vector_type(2))); typedef __bf16 bf16x2_c __attribute__((ext_vector_type(2)));
__device__ __forceinline__ unsigned cvtpk(float lo, float hi) { f32x2_c v = {lo, hi}; bf16x2_c b = __builtin_convertvector(v, bf16x2_c); return __builtin_bit_cast(unsigned, b); }
__device__ __forceinline__ bf16x8 pack8(const float (&v)[8]) { v4u w; w.x = cvtpk(v[0], v[1]); w.y = cvtpk(v[2], v[3]); w.z = cvtpk(v[4], v[5]); w.w = cvtpk(v[6], v[7]); return __builtin_bit_cast(bf16x8, w); }
__device__ __forceinline__ void unpack8(v4u w, float (&v)[8]) {
    v[0] = __uint_as_float(w.x << 16); v[1] = __uint_as_float(w.x & 0xffff0000u); v[2] = __uint_as_float(w.y << 16); v[3] = __uint_as_float(w.y & 0xffff0000u);
    v[4] = __uint_as_float(w.z << 16); v[5] = __uint_as_float(w.z & 0xffff0000u); v[6] = __uint_as_float(w.w << 16); v[7] = __uint_as_float(w.w & 0xffff0000u); }
__device__ __forceinline__ int crow(int r, int hi) { return (r & 3) + 8 * (r >> 2) + 4 * hi; }
__device__ __forceinline__ float ex2(float x) { return __builtin_amdgcn_exp2f(x); }
__device__ __forceinline__ float ls16(float x) { const float L2E = 1.4426950408889634f;
    return (__builtin_fminf(x, 0.f) * L2E - __builtin_amdgcn_logf(1.f + ex2(-__builtin_fabsf(x) * L2E))) * (1.0f / 16.0f); }

__device__ __forceinline__ void p0_item_out(bf16* WT, int K, int row_off, int k0, int n0, LAS float* scr, int lane) {
    LDS_WAIT(); asm volatile("" ::: "memory");
    const int c = lane & 7;
#pragma unroll
    for (int j = 0; j < 4; ++j) { const int n = (lane >> 3) + 8 * j; const LAS float* s = scr + (8 * c) * 33 + n;
        v4u o; o.x = pk2(s[0 * 33], s[1 * 33]); o.y = pk2(s[2 * 33], s[3 * 33]); o.z = pk2(s[4 * 33], s[5 * 33]); o.w = pk2(s[6 * 33], s[7 * 33]);
        *(GAS v4u*)(WT + (size_t)(row_off + n0 + n) * K + k0 + 8 * c) = o; }
    LDS_WAIT(); asm volatile("" ::: "memory");
}
__device__ __forceinline__ void p0_transpose_item(const float* W, int K, int ldw, int col_off, int ncols, const float* gk, bf16* WT, int row_off, LAS float* scr, int item, int lane) {
    const int nblk = ncols / 32, kb = item / nblk, nb = item % nblk, k0 = 64 * kb, n0 = 32 * nb;
    const int kr = lane >> 3, nc = (lane & 7) * 4;
    f32x4 v[8]; float g[8];
#pragma unroll
    for (int j = 0; j < 8; ++j) { v[j] = *(const GAS f32x4*)(W + (size_t)(k0 + 8 * j + kr) * ldw + col_off + n0 + nc); g[j] = gk ? gk[k0 + 8 * j + kr] : 1.f; }
#pragma unroll
    for (int j = 0; j < 8; ++j) { LAS float* d = scr + (8 * j + kr) * 33 + nc; d[0] = v[j][0] * g[j]; d[1] = v[j][1] * g[j]; d[2] = v[j][2] * g[j]; d[3] = v[j][3] * g[j]; }
    p0_item_out(WT, K, row_off, k0, n0, scr, lane);
}
__device__ __forceinline__ void p0_gate_item(const float* Win, const float* wg2, const float* gk, bf16* WT, int row_off, LAS float* scr, int item, int lane) {
    const int kb = item / 4, nb = item % 4, k0 = 64 * kb, n0 = 32 * nb; const int c = n0 + (lane & 31);
    float w2[16];
#pragma unroll
    for (int r = 0; r < 16; ++r) w2[r] = wg2[r * 128 + c];
#pragma unroll 4
    for (int i = 0; i < 32; ++i) { const int kk = 2 * i + (lane >> 5); const float* wr_ = Win + (size_t)(k0 + kk) * NP_SRC + C_GG; float a = 0.f;
#pragma unroll
        for (int r = 0; r < 16; ++r) a += wr_[r] * w2[r];
        scr[kk * 33 + (lane & 31)] = a * gk[k0 + kk]; }
    p0_item_out(WT, D, row_off, k0, n0, scr, lane);
}
template <int R> __device__ __forceinline__ void x_rows_to_bf16(const float* x, bf16* hb, float* ss, int row0, int rstride, int lane) {
    f32x4 v[R][4];
#pragma unroll
    for (int r = 0; r < R; ++r) { const GAS f32x4* xr = (const GAS f32x4*)(x + (size_t)(row0 + r * rstride) * D) + lane;
#pragma unroll
        for (int j = 0; j < 4; ++j) v[r][j] = xr[64 * j]; }
#pragma unroll
    for (int r = 0; r < R; ++r) { float s2 = 0.f;
#pragma unroll
        for (int j = 0; j < 4; ++j) s2 += (v[r][j].x * v[r][j].x + v[r][j].y * v[r][j].y) + (v[r][j].z * v[r][j].z + v[r][j].w * v[r][j].w);
        s2 = wave_sum(s2);
        GAS unsigned long long* o8 = (GAS unsigned long long*)(hb + (size_t)(row0 + r * rstride) * D) + lane;
#pragma unroll
        for (int j = 0; j < 4; ++j) o8[64 * j] = (unsigned long long)pk2(v[r][j].x, v[r][j].y) | ((unsigned long long)pk2(v[r][j].z, v[r][j].w) << 32);
        if (lane < 16) ss[(size_t)(row0 + r * rstride) * 16 + lane] = (lane == 0) ? s2 : 0.f; }
}

struct Inputs {
    const float *x, *norm1_g, *w_in, *pool_w, *pool_scale, *lq1, *lk1, *lq2, *lk2, *diff_norm_g, *w_gate2, *b_gate, *gla_norm_g, *w_out, *norm2_g, *w_mlp1, *w_mlp2, *final_g;
};

__device__ __forceinline__ void p0_prologue(Frame& F, const Inputs& I, unsigned char* ws) {
    LAS float* scr = (LAS float*)(F.lds + RING_OFF + F.wave * 16384);
    const int gw = F.vcu * NWAVES + F.wave, NGW = F.G * NWAVES;
    constexpr int I_IN = (D / 64) * (2560 / 32), I_G = (D / 64) * 4, I_O = (D / 64) * (D / 32), I_1 = (D / 64) * (FF / 32), I_2 = (FF / 64) * (D / 32);
    constexpr int NIT = I_IN + I_G + I_O + I_1 + I_2;
    for (int it = gw; it < DEPTH * NIT; it += NGW) {
        const int l = it / NIT; int r = it % NIT;
        unsigned char* wl = ws + WS_W + (size_t)l * W_LAYER;
        const float* win = I.w_in + (size_t)l * D * NP_SRC; const float* g1 = I.norm1_g + l * D; const float* g2 = I.norm2_g + l * D;
        if (r < I_IN) { p0_transpose_item(win, D, NP_SRC, 0, 2560, g1, (bf16*)(wl + WO_IN), 0, scr, r, F.lane); continue; } r -= I_IN;
        if (r < I_G) { p0_gate_item(win, I.w_gate2 + (size_t)l * 16 * 128, g1, (bf16*)(wl + WO_IN), C_GG, scr, r, F.lane); continue; } r -= I_G;
        if (r < I_O) { p0_transpose_item(I.w_out + (size_t)l * D * D, D, D, 0, D, nullptr, (bf16*)(wl + WO_OUT), 0, scr, r, F.lane); continue; } r -= I_O;
        if (r < I_1) { p0_transpose_item(I.w_mlp1 + (size_t)l * D * FF, D, FF, 0, FF, g2, (bf16*)(wl + WO_1), 0, scr, r, F.lane); continue; } r -= I_1;
        p0_transpose_item(I.w_mlp2 + (size_t)l * FF * D, FF, D, 0, D, nullptr, (bf16*)(wl + WO_2), 0, scr, r, F.lane);
    }
    { const int gt = F.vcu * (NWAVES * 64) + F.tid, NT_ = F.G * NWAVES * 64;
      for (int i = gt; i < DEPTH * 16384; i += NT_) { const int l = i / 16384, o = i % 16384;
          *(GAS v4u*)(ws + WS_W + (size_t)l * W_LAYER + WO_IN + (size_t)2688 * D * 2 + (size_t)o * 16) = (v4u){0u, 0u, 0u, 0u}; }
      for (int i = gt; i < DEPTH * 4 * 64 * 64; i += NT_) { const int ch = i & 63, d = (i >> 6) & 63, lg = i >> 12;
          ((bf16*)(ws + WS_WPOOL))[i] = (bf16)f2bf(I.pool_w[(size_t)lg * 4096 + ch * 64 + d] * I.pool_scale[(size_t)lg * 64 + d]); } }
    { int m = gw; for (; m + 3 * NGW < M; m += 4 * NGW) x_rows_to_bf16<4>(I.x, (bf16*)(ws + WS_HB), (float*)(ws + WS_SSB), m, NGW, F.lane);
      for (; m < M; m += NGW) x_rows_to_bf16<1>(I.x, (bf16*)(ws + WS_HB), (float*)(ws + WS_SSB), m, NGW, F.lane); }
}

__device__ __forceinline__ void gla_scan(float* GKV, const float* GDEC, int gtid, int nthreads) {
    for (int id = gtid; id < BATCH * 4 * 2048; id += nthreads) {
        const int bh = id >> 11, ed = id & 2047;
        float* p = GKV + (size_t)bh * NCH * 2048 + ed; const float* dp = GDEC + (size_t)bh * NCH * 32 + (ed & 31);
        float s = 0.f;
#pragma unroll 1
        for (int n0 = 0; n0 < NCH; n0 += 16) {
            float kv[16], dc[16];
#pragma unroll
            for (int i = 0; i < 16; ++i) { kv[i] = p[(size_t)(n0 + i) * 2048]; dc[i] = dp[(n0 + i) * 32]; }
#pragma unroll
            for (int i = 0; i < 16; ++i) { p[(size_t)(n0 + i) * 2048] = s; s = s * dc[i] + kv[i]; }
        }
    }
}
constexpr int PA_PP = 528, PA_GP = 272;
constexpr int PA_POOL = 0, PA_GATE = 80 * PA_PP, PA_GK = PA_GATE + 64 * PA_GP, PA_GV = PA_GK + 64 * PA_GP, PA_END = PA_GV + 64 * PA_PP;
static_assert(PA_END <= RING_BYTES, "phase A LDS");
constexpr int PA_NPIECE = 79 * 32 + 64 * 16 + 64 * 16 + 64 * 32, PA_NI = (PA_NPIECE + 511) / 512;
__device__ __forceinline__ void pa_piece(int p, int tb, int sb, long& goff, int& loff) {
    if (p < 79 * 32) { const int row = p >> 5, pc = p & 31; loff = PA_POOL + row * PA_PP + pc * 16; goff = (sb - 15 + row >= 0) ? ((long)(tb - 15 + row) * NP + C_POOL + pc * 8) : -1; return; }
    p -= 79 * 32;
    if (p < 64 * 16) { const int row = p >> 4, pc = p & 15; loff = PA_GATE + row * PA_GP + pc * 16; goff = (long)(tb + row) * NP + C_GG + pc * 8; return; }
    p -= 64 * 16;
    if (p < 64 * 16) { const int row = p >> 4, pc = p & 15; loff = PA_GK + row * PA_GP + pc * 16; goff = (long)(tb + row) * NP + C_GK + pc * 8; return; }
    p -= 64 * 16;
    if (p < 64 * 32) { const int row = p >> 5, pc = p & 31; loff = PA_GV + row * PA_PP + pc * 16; goff = (long)(tb + row) * NP + C_GV + pc * 8; return; }
    loff = -1; goff = -1;
}
struct StageA { v4u r[PA_NI]; };
__device__ __forceinline__ void stageA_load(StageA& S, const bf16* PROJ, int ck, int tid) {
    asm volatile("" : "+v"(tid)); tid &= 511;
    const int tb = ck * CHUNK, sb = (ck % NCH) * CHUNK;
#pragma unroll
    for (int i = 0; i < PA_NI; ++i) { long goff; int loff; pa_piece(tid + 512 * i, tb, sb, goff, loff);
        S.r[i] = (goff >= 0) ? *(const GAS v4u*)(PROJ + goff) : (v4u){0u, 0u, 0u, 0u}; }
}
__device__ __forceinline__ void stageA_store(const StageA& S, LAS unsigned char* lds, int ck, int tid) {
    asm volatile("" : "+v"(tid)); tid &= 511;
    const int tb = ck * CHUNK, sb = (ck % NCH) * CHUNK;
#pragma unroll
    for (int i = 0; i < PA_NI; ++i) { long goff; int loff; pa_piece(tid + 512 * i, tb, sb, goff, loff);
        if (loff >= 0) *(LAS v4u*)(lds + loff) = S.r[i]; }
}
struct PoolW { bf16x8 Af[2][4]; };
__device__ __forceinline__ void pool_w_load(PoolW& W, const bf16* WpT, int g, int lane) {
    const int c = lane & 31, hh = lane >> 5; const bf16* Wg = WpT + (size_t)g * 4096;
#pragma unroll
    for (int db = 0; db < 2; ++db)
#pragma unroll
        for (int ks = 0; ks < 4; ++ks) W.Af[db][ks] = *(const GAS bf16x8*)(Wg + (size_t)(32 * db + c) * 64 + 16 * ks + 8 * hh);
}
__device__ __forceinline__ void pool_task2(const LAS unsigned char* lds, const PoolW& W, bf16* MIX, int ck, int g, int tbk0, int tbk1, int lane) {
    const int c = lane & 31, hh = lane >> 5; const int tb = ck * CHUNK, sb = (ck % NCH) * CHUNK; const int w = 2 << g;
#pragma unroll 1
    for (int tbk = tbk0; tbk < tbk1; ++tbk) {
        bf16x8 Bf[4];
        const int s = sb + 32 * tbk + c; const int cnt = (s + 1 < w) ? (s + 1) : w; const float inv = __builtin_amdgcn_rcpf((float)cnt);
        const LAS unsigned char* rp = lds + PA_POOL + (15 + 32 * tbk + c) * PA_PP + (g * 64 + 8 * hh) * 2;
#pragma unroll
        for (int kp = 0; kp < 2; ++kp) {
            float cur[2][8], acc[2][8];
#pragma unroll
            for (int k2 = 0; k2 < 2; ++k2) { unpack8(*(const LAS v4u*)(rp + 32 * (2 * kp + k2)), cur[k2]);
#pragma unroll
                for (int j = 0; j < 8; ++j) acc[k2][j] = cur[k2][j]; }
#pragma unroll 2
            for (int i = 1; i < w; ++i) {
#pragma unroll
                for (int k2 = 0; k2 < 2; ++k2) { float v[8]; unpack8(*(const LAS v4u*)(rp - i * PA_PP + 32 * (2 * kp + k2)), v);
#pragma unroll
                    for (int j = 0; j < 8; ++j) acc[k2][j] += v[j]; }
            }
#pragma unroll
            for (int k2 = 0; k2 < 2; ++k2) { float p[8];
#pragma unroll
                for (int j = 0; j < 8; ++j) p[j] = acc[k2][j] * inv - cur[k2][j];
                Bf[2 * kp + k2] = pack8(p); }
        }
#pragma unroll
        for (int db = 0; db < 2; ++db) {
            f32x16 dacc = {};
#pragma unroll
            for (int ks = 0; ks < 4; ++ks) dacc = __builtin_amdgcn_mfma_f32_32x32x16_bf16(W.Af[db][ks], Bf[ks], dacc, 0, 0, 0);
            bf16* op = MIX + (size_t)(tb + 32 * tbk + c) * D + g * 64 + 32 * db + 4 * hh;
#pragma unroll
            for (int q = 0; q < 4; ++q) { u32x2v o; o.x = cvtpk(dacc[4 * q], dacc[4 * q + 1]); o.y = cvtpk(dacc[4 * q + 2], dacc[4 * q + 3]);
                *(GAS u32x2v*)(op + 8 * q) = o; }
        }
    }
}
__device__ __forceinline__ void gla_kv_task2(const LAS unsigned char* lds, float bg, float* GKV, float* GDEC, int ck, int h, int lane) {
    const int d = lane & 31, hh = lane >> 5; const int b = ck / NCH, n = ck % NCH; const int bhn = (b * 4 + h) * NCH + n;
    const LAS unsigned short* Gp = (const LAS unsigned short*)(lds + PA_GATE) + h * 32 + d;
    const LAS unsigned short* Kp = (const LAS unsigned short*)(lds + PA_GK) + h * 32 + d;
    float bc[4][8], gt[4];
#pragma unroll
    for (int ks = 0; ks < 4; ++ks) { float run = 0.f;
#pragma unroll
        for (int j = 0; j < 8; ++j) { const int t = 16 * ks + 8 * hh + j; run += ls16(bf2f(Gp[t * (PA_GP / 2)]) + bg); bc[ks][j] = run; }
        gt[ks] = run; }
    float base = 0.f, blast;
    {
        float pt[4];
#pragma unroll
        for (int ks = 0; ks < 4; ++ks) pt[ks] = __shfl_xor(gt[ks], 32);
#pragma unroll
        for (int ks = 0; ks < 4; ++ks) { const float lo = hh ? pt[ks] : gt[ks], hi_ = hh ? gt[ks] : pt[ks];
            const float off = base + (hh ? lo : 0.f);
#pragma unroll
            for (int j = 0; j < 8; ++j) bc[ks][j] += off;
            base += lo + hi_; }
        blast = base;
    }
    bf16x8 Af[4];
#pragma unroll
    for (int ks = 0; ks < 4; ++ks) { float v[8];
#pragma unroll
        for (int j = 0; j < 8; ++j) { const int t = 16 * ks + 8 * hh + j; v[j] = bf2f(Kp[t * (PA_GP / 2)]) * ex2(blast - bc[ks][j]); }
        Af[ks] = pack8(v); }
    const LAS unsigned short* Vp = (const LAS unsigned short*)(lds + PA_GV) + h * 64 + d;
#pragma unroll
    for (int nb = 0; nb < 2; ++nb) {
        f32x16 dacc = {};
#pragma unroll
        for (int ks = 0; ks < 4; ++ks) { v4u w;
            unsigned short e[8];
#pragma unroll
            for (int j = 0; j < 8; ++j) e[j] = Vp[(16 * ks + 8 * hh + j) * (PA_PP / 2) + 32 * nb];
            w.x = e[0] | ((unsigned)e[1] << 16); w.y = e[2] | ((unsigned)e[3] << 16); w.z = e[4] | ((unsigned)e[5] << 16); w.w = e[6] | ((unsigned)e[7] << 16);
            dacc = __builtin_amdgcn_mfma_f32_32x32x16_bf16(Af[ks], __builtin_bit_cast(bf16x8, w), dacc, 0, 0, 0); }
        float* op = GKV + ((size_t)bhn * 64 + 32 * nb + d) * 32 + 4 * hh;
#pragma unroll
        for (int q = 0; q < 4; ++q) *(GAS f32x4*)(op + 8 * q) = (f32x4){dacc[4 * q], dacc[4 * q + 1], dacc[4 * q + 2], dacc[4 * q + 3]};
    }
    if (hh == 0) GDEC[(size_t)bhn * 32 + d] = ex2(blast);
}
constexpr int PC_GATE = 0, PC_GQ = 64 * PA_GP, PC_GK = 2 * 64 * PA_GP, PC_GV = 3 * 64 * PA_GP, PC_SCR = PC_GV + 64 * PA_PP, PC_GN = PC_SCR + 4 * 8448, PC_END = PC_GN + 1024;
static_assert(PC_END <= RING_BYTES, "phase C LDS");
constexpr int PC_NPIECE = 3 * 64 * 16 + 64 * 32, PC_NI = PC_NPIECE / 512;
static_assert(PC_NPIECE % 512 == 0, "phase C pieces");
__device__ __forceinline__ void pc_piece(int p, int tb, long& goff, int& loff) {
    if (p < 3 * 64 * 16) { const int reg = p >> 10, q = p & 1023, row = q >> 4, pc = q & 15; loff = reg * 64 * PA_GP + row * PA_GP + pc * 16;
        goff = (long)(tb + row) * NP + (reg == 0 ? C_GG : reg == 1 ? C_GQ : C_GK) + pc * 8; return; }
    p -= 3 * 64 * 16; { const int row = p >> 5, pc = p & 31; loff = PC_GV + row * PA_PP + pc * 16; goff = (long)(tb + row) * NP + C_GV + pc * 8; }
}
struct StageC { v4u r[PC_NI]; };
__device__ __forceinline__ void stageC_load(StageC& S, const bf16* PROJ, int ck, int tid) {
    asm volatile("" : "+v"(tid)); tid &= 511;
#pragma unroll
    for (int i = 0; i < PC_NI; ++i) { long goff; int loff; pc_piece(tid + 512 * i, ck * CHUNK, goff, loff); S.r[i] = *(const GAS v4u*)(PROJ + goff); }
}
__device__ __forceinline__ void stageC_store(const StageC& S, LAS unsigned char* lds, int ck, int tid) {
    asm volatile("" : "+v"(tid)); tid &= 511;
#pragma unroll
    for (int i = 0; i < PC_NI; ++i) { long goff; int loff; pc_piece(tid + 512 * i, ck * CHUNK, goff, loff); *(LAS v4u*)(lds + loff) = S.r[i]; }
}
__device__ __forceinline__ void gla_out_task2(LAS unsigned char* lds, const bf16* PROJ, float bg, const float* GKV, bf16* MIX, int ck, int h, int ib, int lane) {
    const int c = lane & 31, hh = lane >> 5; const int tb = ck * CHUNK; const int b = ck / NCH, n = ck % NCH; const int bhn = (b * 4 + h) * NCH + n;
    LAS float* scr = (LAS float*)(lds + PC_SCR + h * 8448);
    const int tok = tb + 32 * ib + c;
    const float* Sp = GKV + (size_t)bhn * 2048;
    f32x4 sv[2][2][2];
#pragma unroll
    for (int eb = 0; eb < 2; ++eb)
#pragma unroll
        for (int ks = 0; ks < 2; ++ks) { const float* sp = Sp + (size_t)(32 * eb + c) * 32 + 16 * ks + 8 * hh; sv[eb][ks][0] = *(const GAS f32x4*)sp; sv[eb][ks][1] = *(const GAS f32x4*)(sp + 4); }
    const bf16* rp = PROJ + (size_t)tok * NP + C_GR + h * 64 + 4 * hh;
    u32x2v rw[2][4];
#pragma unroll
    for (int eb = 0; eb < 2; ++eb)
#pragma unroll
        for (int q = 0; q < 4; ++q) rw[eb][q] = *(const GAS u32x2v*)(rp + 32 * eb + 8 * q);
    {
        const LAS unsigned short* Gp = (const LAS unsigned short*)(lds + PC_GATE) + (32 * hh) * (PA_GP / 2) + h * 32 + c;
        float bc[32]; float run = 0.f;
#pragma unroll
        for (int i = 0; i < 32; ++i) { run += ls16(bf2f(Gp[i * (PA_GP / 2)]) + bg); bc[i] = run; }
        const float tot0 = __shfl(run, c);
        const float off = hh ? tot0 : 0.f;
#pragma unroll
        for (int i = 0; i < 32; ++i) scr[(32 * hh + i) * 33 + c] = bc[i] + off;
        LDS_WAIT(); asm volatile("" ::: "memory");
    }
    bf16x8 Qf[2], Kf[2][2];
    const float qs = 0.17677669529663687f;
#pragma unroll
    for (int ks = 0; ks < 2; ++ks) { const int i = 32 * ib + c, d0 = 16 * ks + 8 * hh; float q[8], qd[8];
        unpack8(*(const LAS v4u*)(lds + PC_GQ + i * PA_GP + (h * 32 + d0) * 2), q);
#pragma unroll
        for (int j = 0; j < 8; ++j) qd[j] = q[j] * qs * ex2(scr[i * 33 + d0 + j]);
        Qf[ks] = pack8(qd); }
#pragma unroll
    for (int jb = 0; jb < 2; ++jb)
#pragma unroll
        for (int ks = 0; ks < 2; ++ks) { const int i = 32 * jb + c, d0 = 16 * ks + 8 * hh; float k[8], ki[8];
            if (jb <= ib) {
                unpack8(*(const LAS v4u*)(lds + PC_GK + i * PA_GP + (h * 32 + d0) * 2), k);
#pragma unroll
                for (int j = 0; j < 8; ++j) ki[j] = k[j] * ex2(-scr[i * 33 + d0 + j]);
                Kf[jb][ks] = pack8(ki); } }
    const LAS unsigned short* Vp = (const LAS unsigned short*)(lds + PC_GV) + h * 64;
    const LAS float* gn = (const LAS float*)(lds + PC_GN) + h * 64;
    f32x16 o[2]; o[0] = f32x16{}; o[1] = f32x16{};
    for (int jb = 0; jb <= ib; ++jb) {
        f32x16 at = {};
#pragma unroll
        for (int ks = 0; ks < 2; ++ks) at = __builtin_amdgcn_mfma_f32_32x32x16_bf16(jb == 0 ? Kf[0][ks] : Kf[1][ks], Qf[ks], at, 0, 0, 0);
        if (jb == ib) {
#pragma unroll
            for (int r = 0; r < 16; ++r) if (crow(r, hh) > c) at[r] = 0.f;
        }
#pragma unroll
        for (int s = 0; s < 2; ++s) {
            float pv_[8];
#pragma unroll
            for (int jj = 0; jj < 8; ++jj) pv_[jj] = at[8 * s + jj];
            const bf16x8 Pf = pack8(pv_);
#pragma unroll
            for (int eb = 0; eb < 2; ++eb) { unsigned short e[8];
#pragma unroll
                for (int jj = 0; jj < 8; ++jj) { const int j = 32 * jb + 16 * s + 8 * (jj >> 2) + 4 * hh + (jj & 3); e[jj] = Vp[j * (PA_PP / 2) + 32 * eb + c]; }
                v4u w; w.x = e[0] | ((unsigned)e[1] << 16); w.y = e[2] | ((unsigned)e[3] << 16); w.z = e[4] | ((unsigned)e[5] << 16); w.w = e[6] | ((unsigned)e[7] << 16);
                o[eb] = __builtin_amdgcn_mfma_f32_32x32x16_bf16(__builtin_bit_cast(bf16x8, w), Pf, o[eb], 0, 0, 0); }
        }
    }
#pragma unroll
    for (int eb = 0; eb < 2; ++eb)
#pragma unroll
        for (int ks = 0; ks < 2; ++ks) { const f32x4 s0 = sv[eb][ks][0], s1 = sv[eb][ks][1];
            const float svv[8] = {s0[0], s0[1], s0[2], s0[3], s1[0], s1[1], s1[2], s1[3]};
            o[eb] = __builtin_amdgcn_mfma_f32_32x32x16_bf16(pack8(svv), Qf[ks], o[eb], 0, 0, 0); }
    float ssq = 0.f;
#pragma unroll
    for (int eb = 0; eb < 2; ++eb)
#pragma unroll
        for (int r = 0; r < 16; ++r) ssq += o[eb][r] * o[eb][r];
    ssq += __shfl_xor(ssq, 32);
    const float rstd = __builtin_amdgcn_rsqf(ssq * (1.0f / 64.0f) + EPS);
    bf16* op = MIX + (size_t)tok * D + 768 + h * 64 + 4 * hh;
#pragma unroll
    for (int eb = 0; eb < 2; ++eb)
#pragma unroll
        for (int q = 0; q < 4; ++q) { const int e0 = 32 * eb + 8 * q;
            const u32x2v rww = rw[eb][q]; const f32x4 g4 = *(const LAS f32x4*)(gn + e0 + 4 * hh);
            const float rg[4] = {__uint_as_float(rww.x << 16), __uint_as_float(rww.x & 0xffff0000u), __uint_as_float(rww.y << 16), __uint_as_float(rww.y & 0xffff0000u)};
            float y[4];
#pragma unroll
            for (int k = 0; k < 4; ++k) { const float sil = rg[k] * __builtin_amdgcn_rcpf(1.f + ex2(-1.4426950408889634f * rg[k])); y[k] = o[eb][4 * q + k] * rstd * g4[k] * sil; }
            u32x2v ow; ow.x = cvtpk(y[0], y[1]); ow.y = cvtpk(y[2], y[3]); *(GAS u32x2v*)(op + e0) = ow; }
    LDS_WAIT(); asm volatile("" ::: "memory");
}
template <int R> __device__ __forceinline__ void diff_fin_rows(const bf16* OATT, const float* dng, bf16* MIX, int tok0, int tstride, float lam, float oml, int lane) {
    const int hd = lane >> 4, e0 = (lane & 15) * 8;
    v4u w1[R], w2[R];
#pragma unroll
    for (int r = 0; r < R; ++r) { const size_t o = (size_t)(tok0 + r * tstride) * D + hd * 256 + e0; w1[r] = *(const GAS v4u*)(OATT + o); w2[r] = *(const GAS v4u*)(OATT + o + 128); }
    const f32x4 g0 = *(const f32x4*)(dng + hd * 128 + e0), g1 = *(const f32x4*)(dng + hd * 128 + e0 + 4);
#pragma unroll
    for (int r = 0; r < R; ++r) { float a1[8], a2[8], a[8]; unpack8(w1[r], a1); unpack8(w2[r], a2);
        float ss = 0.f;
#pragma unroll
        for (int j = 0; j < 8; ++j) { a[j] = a1[j] - lam * a2[j]; ss += a[j] * a[j]; }
        ss += __shfl_xor(ss, 1); ss += __shfl_xor(ss, 2); ss += __shfl_xor(ss, 4); ss += __shfl_xor(ss, 8);
        const float rstd = __builtin_amdgcn_rsqf(ss * (1.0f / 128.0f) + EPS) * oml;
        float y[8];
#pragma unroll
        for (int j = 0; j < 4; ++j) { y[j] = a[j] * rstd * g0[j]; y[4 + j] = a[4 + j] * rstd * g1[j]; }
        *(GAS bf16x8*)(MIX + (size_t)(tok0 + r * tstride) * D + 256 + hd * 128 + e0) = pack8(y); }
}
template <int R> __device__ __forceinline__ void final_norm_rows(const bf16* hb, float* out, const float* g, int row0, int rstride, int lane) {
    v4u w[R][2];
#pragma unroll
    for (int r = 0; r < R; ++r)
#pragma unroll
        for (int j = 0; j < 2; ++j) w[r][j] = *(const GAS v4u*)(hb + (size_t)(row0 + r * rstride) * D + j * 512 + lane * 8);
    f32x4 g4[2][2];
#pragma unroll
    for (int j = 0; j < 2; ++j) { g4[j][0] = *(const f32x4*)(g + j * 512 + lane * 8); g4[j][1] = *(const f32x4*)(g + j * 512 + lane * 8 + 4); }
#pragma unroll
    for (int r = 0; r < R; ++r) { float v[2][8]; float s2 = 0.f;
#pragma unroll
        for (int j = 0; j < 2; ++j) { unpack8(w[r][j], v[j]);
#pragma unroll
            for (int e = 0; e < 8; ++e) s2 += v[j][e] * v[j][e]; }
        const float rstd = __builtin_amdgcn_rsqf(wave_sum(s2) * (1.0f / D) + EPS);
        float* op = out + (size_t)(row0 + r * rstride) * D + lane * 8;
#pragma unroll
        for (int j = 0; j < 2; ++j) { f32x4 o0, o1;
#pragma unroll
            for (int e = 0; e < 4; ++e) { o0[e] = v[j][e] * rstd * g4[j][0][e]; o1[e] = v[j][4 + e] * rstd * g4[j][1][e]; }
            *(GAS f32x4*)(op + j * 512) = o0; *(GAS f32x4*)(op + j * 512 + 4) = o1; } }
}

template <class Sched> __device__ __forceinline__ void rs_table(LAS float* rst, const float* ss, const Sched& S, int tid) {
    asm volatile("" : "+v"(tid));
    const int row = tid >> 1, half = tid & 1;
    pg8::Unit u;
    for (int i = 0; i < RST_MAXU && S.next(i, u); ++i) {
        const f32x4 a = *(const GAS f32x4*)(ss + ((size_t)u.pm * 256 + row) * 16 + half * 8), b = *(const GAS f32x4*)(ss + ((size_t)u.pm * 256 + row) * 16 + half * 8 + 4);
        float s_ = ((a[0] + a[1]) + (a[2] + a[3])) + ((b[0] + b[1]) + (b[2] + b[3]));
        s_ += __shfl_xor(s_, 1);
        if (half == 0) rst[i * 256 + row] = __builtin_amdgcn_rsqf(s_ * (1.0f / 1024.0f) + EPS);
    }
    __syncthreads();
}
constexpr int PH_PER_LAYER = 7, N_PHASES = 1 + DEPTH * PH_PER_LAYER + 1;
struct Args { const float* in[18]; float* out; unsigned char* ws; int ph_lo, ph_hi; };
__global__ void __launch_bounds__(NWAVES * 64, 2) fwd_kernel(Args args) {
    extern __shared__ __attribute__((aligned(16))) unsigned char lds[];
    Frame F;
    F.lds = (LAS unsigned char*)lds;
    F.MISC = (volatile LAS unsigned*)(F.lds + MISC_OFF);
    F.tid = threadIdx.x; F.lane = F.tid & 63; F.wave = __builtin_amdgcn_readfirstlane(F.tid >> 6);
    F.G = gridDim.x; { const int bx = blockIdx.x; F.vcu = (F.G % 8 == 0) ? (bx % 8) * (F.G / 8) + bx / 8 : bx; }
    unsigned char* ws = args.ws;
    F.ctl = (gu32*)(ws + WS_CTL);
    Inputs I;
    I.x = args.in[0]; I.norm1_g = args.in[1]; I.w_in = args.in[2]; I.pool_w = args.in[3]; I.pool_scale = args.in[4]; I.lq1 = args.in[5]; I.lk1 = args.in[6]; I.lq2 = args.in[7]; I.lk2 = args.in[8];
    I.diff_norm_g = args.in[9]; I.w_gate2 = args.in[10]; I.b_gate = args.in[11]; I.gla_norm_g = args.in[12]; I.w_out = args.in[13]; I.norm2_g = args.in[14]; I.w_mlp1 = args.in[15]; I.w_mlp2 = args.in[16]; I.final_g = args.in[17];
    for (int u = F.tid; u < (LDS_BYTES - LDSCTL_OFF) / 4; u += NWAVES * 64) ((LAS unsigned*)(F.lds + LDSCTL_OFF))[u] = 0u;
    __syncthreads();
    XcdBarrier bar; bar.bar = (unsigned*)(F.ctl + CW_BAR); bar.x = 0; bar.st = nullptr;
    if (!MK_PER_PHASE) bar = xcd_barrier_post((unsigned*)(F.ctl + CW_BAR), F.MISC + 8);
#define GRID_BAR() do { if (!MK_PER_PHASE) xcd_barrier(bar); } while (0)
    const int lo = args.ph_lo, hi = args.ph_hi;
#define IN(k) (lo <= (k) && (k) < hi)
#define BOTH(k) (IN(k) && IN((k) + 1))
    bf16* const HB = (bf16*)(ws + WS_HB); bf16* const PROJ = (bf16*)(ws + WS_PROJ); bf16* const OATT = (bf16*)(ws + WS_OATT); bf16* const MIX = (bf16*)(ws + WS_MIX); bf16* const HID = (bf16*)(ws + WS_HID);
    float* const SSA = (float*)(ws + WS_SSA); float* const SSB = (float*)(ws + WS_SSB); float* const GKV = (float*)(ws + WS_GKV); float* const GDEC = (float*)(ws + WS_GDEC);
#define REFRESH() do { int t_ = threadIdx.x; asm volatile("" : "+v"(t_)); F.tid = t_; F.lane = t_ & 63; F.wave = __builtin_amdgcn_readfirstlane(t_ >> 6); } while (0)
    const int NGW = F.G * NWAVES;

    if (IN(0)) { p0_prologue(F, I, ws); if (BOTH(0)) GRID_BAR(); }

#pragma unroll 1
    for (int l = 0; l < DEPTH; ++l) {
        const int pb = 1 + l * PH_PER_LAYER;
        unsigned char* wl = ws + WS_W + (size_t)l * W_LAYER;
        const float lambda_init = (l == 0) ? 0.2f : 0.35550906759096927f;
        if (IN(pb + 0)) {
            pg8::Gemm g{HB, (const bf16*)(wl + WO_IN), M, NP, D}; pg8::StaticOrder S; S.init(M, NP, F.G, (int)blockIdx.x);
            rs_table((LAS float*)(F.lds + RST_OFF), SSB, S, threadIdx.x);
            pg8::EpiRs<0> E{PROJ, NP, (const LAS float*)(F.lds + RST_OFF), 1, 3, attn2::C2};
            pg8::gemm_phase<pg8::EpiRs<0>, pg8::StaticOrder, true, true>(F.lds + RING_OFF, g, S, E);
            if (BOTH(pb + 0)) GRID_BAR();
        }
        if (IN(pb + 1)) {
            REFRESH();
            {
                StageA SA; int ck = F.vcu;
                const float bgA = I.b_gate[l * 128 + (F.wave & 3) * 32 + (F.lane & 31)];
                PoolW PW; pool_w_load(PW, (const bf16*)(ws + WS_WPOOL) + (size_t)l * 4 * 4096, (F.wave < 2) ? 3 : (F.wave == 2) ? 2 : (F.wave == 3) ? 1 : 0, F.lane);
                stageA_load(SA, PROJ, ck, F.tid);
                for (; ck < M / CHUNK; ck += F.G) {
                    stageA_store(SA, F.lds + RING_OFF, ck, F.tid);
                    __syncthreads();
                    stageA_load(SA, PROJ, (ck + F.G < M / CHUNK) ? ck + F.G : ck, F.tid);
                    if (F.wave < 2) pool_task2(F.lds + RING_OFF, PW, MIX, ck, 3, F.wave, F.wave + 1, F.lane);
                    else if (F.wave == 2) pool_task2(F.lds + RING_OFF, PW, MIX, ck, 2, 0, 2, F.lane);
                    else if (F.wave == 3) pool_task2(F.lds + RING_OFF, PW, MIX, ck, 1, 0, 2, F.lane);
                    else { gla_kv_task2(F.lds + RING_OFF, bgA, GKV, GDEC, ck, F.wave - 4, F.lane);
                           if (F.wave < 6) pool_task2(F.lds + RING_OFF, PW, MIX, ck, 0, F.wave - 4, F.wave - 3, F.lane); }
                    __syncthreads();
                }
            }
            if (BOTH(pb + 1)) GRID_BAR();
        }
        if (IN(pb + 2)) {
            REFRESH();
            if (F.tid < 256) gla_scan(GKV, GDEC, F.vcu * 256 + F.tid, F.G * 256);
            __syncthreads();
            attn2::attn_phase3((char*)lds + RING_OFF, (const attn2::bf16*)PROJ, (attn2::bf16*)OATT, F.vcu, F.G, C_DQ, C_DK, C_DV, (unsigned*)(F.ctl + CW_QUEUE + l * 8 * 64));
            if (BOTH(pb + 2)) GRID_BAR();
        }
        if (IN(pb + 3)) {
            REFRESH(); const int gw = F.vcu * NWAVES + F.wave;
            {
                const float bgC = I.b_gate[l * 128 + (F.wave & 3) * 32 + (F.lane & 31)];
                if (F.tid < 256) ((LAS float*)(F.lds + RING_OFF + PC_GN))[F.tid] = I.gla_norm_g[l * 256 + F.tid];
                { StageC SC; int ck = F.vcu;
                  stageC_load(SC, PROJ, ck, F.tid);
                  for (; ck < M / CHUNK; ck += F.G) {
                      stageC_store(SC, F.lds + RING_OFF, ck, F.tid);
                      __syncthreads();
                      stageC_load(SC, PROJ, (ck + F.G < M / CHUNK) ? ck + F.G : ck, F.tid);
                      gla_out_task2(F.lds + RING_OFF, PROJ, bgC, GKV, MIX, ck, F.wave & 3, 1 - (F.wave >> 2), F.lane);
                      __syncthreads();
                  } }
                const float s1 = wave_sum(I.lq1[l * 64 + F.lane] * I.lk1[l * 64 + F.lane]), s2 = wave_sum(I.lq2[l * 64 + F.lane] * I.lk2[l * 64 + F.lane]);
                const float lam = __expf(s1) - __expf(s2) + lambda_init;
                int tok = gw;
                for (; tok + 3 * NGW < M; tok += 4 * NGW) diff_fin_rows<4>(OATT, I.diff_norm_g + l * 512, MIX, tok, NGW, lam, 1.0f - lambda_init, F.lane);
                for (; tok < M; tok += NGW) diff_fin_rows<1>(OATT, I.diff_norm_g + l * 512, MIX, tok, NGW, lam, 1.0f - lambda_init, F.lane);
            }
            if (BOTH(pb + 3)) GRID_BAR();
        }
        if (IN(pb + 4)) {
            pg8::Gemm g{MIX, (const bf16*)(wl + WO_OUT), M, D, D}; pg8::StaticOrder S; S.init(M, D, F.G, (int)blockIdx.x);
            pg8::EpiRes E{HB, SSA, D};
            pg8::gemm_phase<pg8::EpiRes, pg8::StaticOrder, true, true>(F.lds + RING_OFF, g, S, E);
            if (BOTH(pb + 4)) GRID_BAR();
        }
        if (IN(pb + 5)) {
            pg8::Gemm g{HB, (const bf16*)(wl + WO_1), M, FF, D}; pg8::StaticOrder S; S.init(M, FF, F.G, (int)blockIdx.x);
            rs_table((LAS float*)(F.lds + RST_OFF), SSA, S, threadIdx.x);
            pg8::EpiRs<2> E{HID, FF, (const LAS float*)(F.lds + RST_OFF), 0, 0, 1.f};
            pg8::gemm_phase<pg8::EpiRs<2>, pg8::StaticOrder, true, true>(F.lds + RING_OFF, g, S, E);
            if (BOTH(pb + 5)) GRID_BAR();
        }
        if (IN(pb + 6)) {
            pg8::Gemm g{HID, (const bf16*)(wl + WO_2), M, D, FF}; pg8::StaticOrder S; S.init(M, D, F.G, (int)blockIdx.x);
            pg8::EpiRes E{HB, SSB, D};
            pg8::gemm_phase<pg8::EpiRes, pg8::StaticOrder, true, true>(F.lds + RING_OFF, g, S, E);
            if (BOTH(pb + 6)) GRID_BAR();
        }
    }
    if (IN(N_PHASES - 1)) { REFRESH(); const int gw = F.vcu * NWAVES + F.wave; int m = gw; for (; m + 3 * NGW < M; m += 4 * NGW) final_norm_rows<4>(HB, args.out, I.final_g, m, NGW, F.lane);
        for (; m < M; m += NGW) final_norm_rows<1>(HB, args.out, I.final_g, m, NGW, F.lane); }
#undef IN
#undef BOTH
#undef GRID_BAR
#undef REFRESH
}

extern "C" void kernel_launch(void* const* d_in, const int* in_sizes, int n_in, void* d_out, int out_size, void* d_ws, size_t ws_size, hipStream_t stream) {
    static int grid = 0;
    if (grid == 0) {
        if (n_in != 18 || in_sizes[0] != M * D || out_size != M * D || ws_size < WS_END) { fprintf(stderr, "kernel_launch: unexpected shapes: n_in %d, in0 %d, out %d, ws %zu (need %zu); nothing launched\n", n_in, n_in > 0 ? in_sizes[0] : -1, out_size, ws_size, (size_t)WS_END); grid = -1; return; }
        int dev = 0, cus = 0, per_cu = 0;
        if (hipGetDevice(&dev) != hipSuccess || hipDeviceGetAttribute(&cus, hipDeviceAttributeMultiprocessorCount, dev) != hipSuccess) { grid = -1; return; }
        if (hipFuncSetAttribute((const void*)fwd_kernel, hipFuncAttributeMaxDynamicSharedMemorySize, LDS_BYTES) != hipSuccess) { fprintf(stderr, "kernel_launch: hipFuncSetAttribute failed\n"); grid = -1; return; }
        if (hipOccupancyMaxActiveBlocksPerMultiprocessor(&per_cu, (const void*)fwd_kernel, NWAVES * 64, LDS_BYTES) != hipSuccess || per_cu < 1) { fprintf(stderr, "kernel_launch: occupancy query reports %d workgroups per CU\n", per_cu); }
        (void)hipGetLastError();
        grid = cus;
    }
    if (grid < 0) return;
    if (hipMemsetAsync((char*)d_ws + WS_CTL, 0, CTL_ZERO_BYTES, stream) != hipSuccess) return;
    Args a{};
    for (int i = 0; i < 18; ++i) a.in[i] = (const float*)d_in[i];
    a.out = (float*)d_out; a.ws = (unsigned char*)d_ws;
#if MK_PER_PHASE
    for (int p = 0; p < N_PHASES; ++p) { a.ph_lo = p; a.ph_hi = p + 1; hipLaunchKernelGGL(fwd_kernel, dim3(grid), dim3(NWAVES * 64), LDS_BYTES, stream, a); }
#else
    a.ph_lo = 0; a.ph_hi = N_PHASES;
    hipLaunchKernelGGL(fwd_kernel, dim3(grid), dim3(NWAVES * 64), LDS_BYTES, stream, a);
#endif
}
```
